# Optimizing an MI355X kernel written in HIP

```python
import math
import jax, jax.numpy as jnp
from jax import lax
import numpy as np

D_MODEL = 1024
BATCH = 4
SEQ = 4096
DEPTH = 2

D_MIX = D_MODEL
D_GMLP = D_MIX // 2
GMLP_HEADS = 4
GMLP_HEAD_DIM = D_GMLP // GMLP_HEADS
CHUNK = 128
D_SSM = D_MIX - D_GMLP
SSM_GROUP = 16
SSM_GROUPS = D_SSM // SSM_GROUP
SSM_STATE = 64
DT_MIN = 0.001
DT_MAX = 0.1
D_IN_PROJ = 2 * D_GMLP + D_SSM
N_EXPERTS = 32
TOP_K = 4
D_EXPERT = D_MODEL
SWIGLU_LIMIT = 7.0
SWIGLU_ALPHA = 1.702
MOE_BLOCK = 128
EPS = 1e-5

kernel_name = "hybrid_sgu_s5_moe_trunk"


def rms_norm(x, w):
    xf = x.astype(jnp.float32)
    y = xf * lax.rsqrt(jnp.mean(xf * xf, axis=-1, keepdims=True) + EPS)
    return (y * w.astype(jnp.float32)).astype(x.dtype)


def layer_norm(x, w, b):
    xf = x.astype(jnp.float32)
    mu = jnp.mean(xf, axis=-1, keepdims=True)
    var = jnp.mean(jnp.square(xf - mu), axis=-1, keepdims=True)
    y = (xf - mu) * lax.rsqrt(var + EPS)
    return (y * w.astype(jnp.float32) + b.astype(jnp.float32)).astype(x.dtype)


def chunked_sgu(u, v, ln_w, ln_b, w_s, b_s):
    B, L, _ = u.shape
    u = jax.nn.gelu(u)
    v = layer_norm(jax.nn.gelu(v), ln_w, ln_b)
    v = v.reshape(B, L // CHUNK, CHUNK, GMLP_HEADS, GMLP_HEAD_DIM)
    causal = jnp.tril(jnp.ones((CHUNK, CHUNK), dtype=bool))
    w = jnp.where(causal[None], w_s, jnp.zeros_like(w_s)).astype(v.dtype)
    mixed = jnp.einsum('hts,bcshd->bcthd', w, v) + b_s.T.astype(v.dtype)[None, None, :, :, None]
    return u * mixed.reshape(B, L, D_GMLP)


def s5_mixer(u, a_re, a_im, b_re, b_im, c_re, c_im, d, log_dt, glu_w, glu_b):
    B, L, _ = u.shape
    f32 = jnp.float32
    uf = u.astype(f32).reshape(B, L, SSM_GROUPS, SSM_GROUP)
    a = lax.complex(a_re.astype(f32), a_im.astype(f32))
    dt = jnp.exp(log_dt.astype(f32))[:, None]
    a_bar = jnp.exp(dt * a)
    b = lax.complex(b_re.astype(f32), b_im.astype(f32))
    b_bar = ((a_bar - 1.0) / a)[..., None] * b
    bu = lax.complex(jnp.einsum('blgh,gph->blgp', uf, b_bar.real),
                     jnp.einsum('blgh,gph->blgp', uf, b_bar.imag))
    a_seq = jnp.broadcast_to(a_bar, bu.shape)

    def combine(left, right):
        a_l, s_l = left
        a_r, s_r = right
        return a_r * a_l, a_r * s_l + s_r

    _, states = lax.associative_scan(combine, (a_seq, bu), axis=1)
    c = lax.complex(c_re.astype(f32), c_im.astype(f32))
    y = jnp.einsum('blgp,ghp->blgh', states, c).real + d.astype(f32).reshape(SSM_GROUPS, SSM_GROUP) * uf
    y = jax.nn.gelu(y.reshape(B, L, D_SSM)).astype(u.dtype)
    return y * jax.nn.sigmoid(y @ glu_w + glu_b)


def moe(h, router_w, router_b, w_gu, b_gu, w_dn, b_dn):
    B, L, D = h.shape
    f32 = jnp.float32
    n_tok = B * L
    n_as = n_tok * TOP_K
    n_blocks = -(-n_as // MOE_BLOCK) + N_EXPERTS
    n_pad = n_blocks * MOE_BLOCK
    ht = h.reshape(n_tok, D)
    logits = ht.astype(f32) @ router_w.astype(f32) + router_b.astype(f32)
    top_val, top_idx = lax.top_k(logits, TOP_K)
    gates = jax.nn.softmax(top_val, axis=-1)
    flat_e = top_idx.reshape(-1).astype(jnp.int32)
    flat_tok = jnp.arange(n_as, dtype=jnp.int32) // TOP_K
    flat_g = gates.reshape(-1)
    order = jnp.argsort(flat_e, stable=True)
    sorted_e = flat_e[order]
    counts = jnp.zeros((N_EXPERTS,), jnp.int32).at[flat_e].add(1)
    padded = (counts + MOE_BLOCK - 1) // MOE_BLOCK * MOE_BLOCK
    start = jnp.cumsum(counts) - counts
    padded_end = jnp.cumsum(padded)
    padded_start = padded_end - padded
    rank = jnp.arange(n_as, dtype=jnp.int32) - start[sorted_e]
    dest = padded_start[sorted_e] + rank
    slot_tok = jnp.zeros((n_pad,), jnp.int32).at[dest].set(flat_tok[order])
    slot_w = jnp.zeros((n_pad,), f32).at[dest].set(flat_g[order])
    block_start = jnp.arange(n_blocks, dtype=padded_end.dtype) * MOE_BLOCK
    block_expert = jnp.minimum(jnp.searchsorted(padded_end, block_start, side='right'), N_EXPERTS - 1)
    xb = ht[slot_tok].reshape(n_blocks, MOE_BLOCK, D)

    def expert_block(args):
        xe, e = args
        gu = xe @ w_gu[e] + b_gu[e]
        glu, lin = jnp.split(gu, 2, axis=-1)
        glu = jnp.minimum(glu, SWIGLU_LIMIT)
        lin = jnp.clip(lin, -SWIGLU_LIMIT, SWIGLU_LIMIT)
        act = glu * jax.nn.sigmoid(SWIGLU_ALPHA * glu) * (lin + 1.0)
        return act @ w_dn[e] + b_dn[e]

    yb = lax.map(expert_block, (xb, block_expert))
    contrib = yb.reshape(n_pad, D) * slot_w[:, None].astype(yb.dtype)
    return jax.ops.segment_sum(contrib, slot_tok, num_segments=n_tok).reshape(B, L, D)


def setup_inputs(seed: int = 0) -> dict:
    key = jax.random.key(seed)
    ks = jax.random.split(key, 32)
    f32 = jnp.float32
    nrm = lambda k, shape, s: jax.random.normal(k, shape, f32) * s
    x = jax.random.normal(ks[0], (BATCH, SEQ, D_MODEL), f32)
    attn_norm_w = 1.0 + nrm(ks[1], (DEPTH, D_MODEL), 0.02)
    w_in = nrm(ks[2], (DEPTH, D_MODEL, D_IN_PROJ), D_MODEL ** -0.5)
    sgu_ln_w = 1.0 + nrm(ks[3], (DEPTH, D_GMLP), 0.02)
    sgu_ln_b = nrm(ks[4], (DEPTH, D_GMLP), 0.02)
    sgu_w = nrm(ks[5], (DEPTH, GMLP_HEADS, CHUNK, CHUNK), CHUNK ** -0.5)
    sgu_b = 1.0 + nrm(ks[6], (DEPTH, GMLP_HEADS, CHUNK), 0.02)
    n = jnp.arange(SSM_STATE, dtype=f32)
    ssm_a_re = -0.5 + nrm(ks[7], (DEPTH, SSM_GROUPS, SSM_STATE), 0.01)
    ssm_a_im = math.pi * n + nrm(ks[8], (DEPTH, SSM_GROUPS, SSM_STATE), 0.01)
    b_scale = (2.0 * SSM_GROUP) ** -0.5
    ssm_b_re = nrm(ks[9], (DEPTH, SSM_GROUPS, SSM_STATE, SSM_GROUP), b_scale)
    ssm_b_im = nrm(ks[10], (DEPTH, SSM_GROUPS, SSM_STATE, SSM_GROUP), b_scale)
    c_scale = (2.0 * SSM_STATE) ** -0.5
    ssm_c_re = nrm(ks[11], (DEPTH, SSM_GROUPS, SSM_GROUP, SSM_STATE), c_scale)
    ssm_c_im = nrm(ks[12], (DEPTH, SSM_GROUPS, SSM_GROUP, SSM_STATE), c_scale)
    ssm_d = nrm(ks[13], (DEPTH, D_SSM), 1.0)
    ssm_log_dt = jax.random.uniform(ks[14], (DEPTH, SSM_GROUPS), f32, math.log(DT_MIN), math.log(DT_MAX))
    ssm_glu_w = nrm(ks[15], (DEPTH, D_SSM, D_SSM), D_SSM ** -0.5)
    ssm_glu_b = nrm(ks[16], (DEPTH, D_SSM), 0.02)
    out_norm_a = 1.0 + nrm(ks[17], (DEPTH, D_GMLP), 0.02)
    out_norm_b = 1.0 + nrm(ks[18], (DEPTH, D_SSM), 0.02)
    w_out = nrm(ks[19], (DEPTH, D_MIX, D_MODEL), D_MIX ** -0.5)
    ffn_norm_w = 1.0 + nrm(ks[20], (DEPTH, D_MODEL), 0.02)
    router_w = nrm(ks[21], (DEPTH, D_MODEL, N_EXPERTS), D_MODEL ** -0.5)
    router_b = nrm(ks[22], (DEPTH, N_EXPERTS), 0.01)
    w_gate_up = nrm(ks[23], (DEPTH, N_EXPERTS, D_MODEL, 2 * D_EXPERT), D_MODEL ** -0.5)
    b_gate_up = nrm(ks[24], (DEPTH, N_EXPERTS, 2 * D_EXPERT), 0.02)
    w_down = nrm(ks[25], (DEPTH, N_EXPERTS, D_EXPERT, D_MODEL), D_EXPERT ** -0.5)
    b_down = nrm(ks[26], (DEPTH, N_EXPERTS, D_MODEL), 0.02)
    final_norm_w = 1.0 + nrm(ks[27], (D_MODEL,), 0.02)
    return {"x": x, "attn_norm_w": attn_norm_w, "w_in": w_in,
            "sgu_ln_w": sgu_ln_w, "sgu_ln_b": sgu_ln_b, "sgu_w": sgu_w, "sgu_b": sgu_b,
            "ssm_a_re": ssm_a_re, "ssm_a_im": ssm_a_im, "ssm_b_re": ssm_b_re, "ssm_b_im": ssm_b_im,
            "ssm_c_re": ssm_c_re, "ssm_c_im": ssm_c_im, "ssm_d": ssm_d, "ssm_log_dt": ssm_log_dt,
            "ssm_glu_w": ssm_glu_w, "ssm_glu_b": ssm_glu_b,
            "out_norm_a": out_norm_a, "out_norm_b": out_norm_b, "w_out": w_out,
            "ffn_norm_w": ffn_norm_w, "router_w": router_w, "router_b": router_b,
            "w_gate_up": w_gate_up, "b_gate_up": b_gate_up, "w_down": w_down, "b_down": b_down,
            "final_norm_w": final_norm_w}


def reference(x, attn_norm_w, w_in, sgu_ln_w, sgu_ln_b, sgu_w, sgu_b,
              ssm_a_re, ssm_a_im, ssm_b_re, ssm_b_im, ssm_c_re, ssm_c_im, ssm_d, ssm_log_dt,
              ssm_glu_w, ssm_glu_b, out_norm_a, out_norm_b, w_out,
              ffn_norm_w, router_w, router_b, w_gate_up, b_gate_up, w_down, b_down,
              final_norm_w):
    for layer in range(DEPTH):
        h = rms_norm(x, attn_norm_w[layer])
        proj = h @ w_in[layer]
        u_g, v_g, u_s = jnp.split(proj, [D_GMLP, 2 * D_GMLP], axis=-1)
        y_a = chunked_sgu(u_g, v_g, sgu_ln_w[layer], sgu_ln_b[layer], sgu_w[layer], sgu_b[layer])
        y_b = s5_mixer(u_s, ssm_a_re[layer], ssm_a_im[layer], ssm_b_re[layer], ssm_b_im[layer],
                       ssm_c_re[layer], ssm_c_im[layer], ssm_d[layer], ssm_log_dt[layer],
                       ssm_glu_w[layer], ssm_glu_b[layer])
        mix = jnp.concatenate([rms_norm(y_a, out_norm_a[layer]), rms_norm(y_b, out_norm_b[layer])], axis=-1)
        x = x + mix @ w_out[layer]
        h = rms_norm(x, ffn_norm_w[layer])
        x = x + moe(h, router_w[layer], router_b[layer], w_gate_up[layer], b_gate_up[layer],
                    w_down[layer], b_down[layer])
    return rms_norm(x, final_norm_w)
```

```cpp
#include <hip/hip_runtime.h>
#include <cstdio>
#include <cstdint>
#ifndef N_LAUNCH_MODE
#define N_LAUNCH_MODE 0
#endif
#ifndef SIMPLE_KLOOP
#define SIMPLE_KLOOP 0
#endif
namespace pg8 {
#define PG8_LAS __attribute__((address_space(3)))
typedef unsigned short bf16_t;
typedef short bf16x8 __attribute__((ext_vector_type(8)));
typedef float f32x4 __attribute__((ext_vector_type(4)));
typedef unsigned u32x4 __attribute__((ext_vector_type(4)));
constexpr int BM = 256, BK = 64, HALF = 128, HTB = HALF * BK * 2  , STAGE_BYTES = 8 * HTB, NXCD = 8, WGM = 8;

__host__ __device__ __forceinline__ int lds_byte(int r, int c) { const int st = (r >> 4) * 2 + (c >> 5), rr = r & 15, cc = c & 31, ob = rr * 64 + cc * 2; return st * 1024 + (ob ^ (((ob >> 9) & 1) << 5)); }
__host__ __device__ __forceinline__ void stage_rc(int b, int& R, int& C) { const int st = b / 1024, sb = b % 1024, swz = sb ^ (((sb >> 9) & 1) << 5); R = (st >> 1) * 16 + swz / 64; C = (st & 1) * 32 + (swz % 64) / 2; }
__host__ __device__ __forceinline__ int perm32(int rho) { const int n = rho >> 4, i = rho & 15; return 8 * (i >> 2) + 4 * n + (i & 3); }

struct Unit { int pm, pn; };
struct Gemm { const bf16_t* A; const bf16_t* Bt; int M, N, K; };

struct StaticOrder {
    int nM, nN, nwg, G, c;
    __host__ __device__ void init(int M, int N, int G_, int c_) { nM = M / BM; nN = N / BM; nwg = nM * nN; G = G_; c = c_; }
    __host__ __device__ bool next(int i, Unit& u) const {
        const long L = (long)i * G + c; if (L >= nwg) return false;
        int wgid = (int)L; { const int q = nwg / NXCD, r = nwg % NXCD, xcd = wgid % NXCD, off = wgid / NXCD; wgid = (xcd < r ? xcd * (q + 1) : r * (q + 1) + (xcd - r) * q) + off; }
        const int nig = WGM * nN, gid = wgid / nig, fm = gid * WGM, gsz = (nM - fm) < WGM ? (nM - fm) : WGM;
        u.pm = fm + ((wgid % nig) % gsz); u.pn = (wgid % nig) / gsz; return true;
    }
    __device__ __forceinline__ void a_ready(const Unit&) const {}
    __device__ __forceinline__ void done(const Unit&) const {}
};

__device__ __forceinline__ unsigned cvt_pk_bf16(float lo, float hi) { unsigned r; asm volatile("v_cvt_pk_bf16_f32 %0, %1, %2" : "=v"(r) : "v"(lo), "v"(hi)); return r; }
template <class Epi, class Sched>
__device__ __forceinline__ void gemm_phase_simple(const Gemm g, const Sched& S, const Epi& E) {
    int tid_ = threadIdx.x; asm volatile("" : "+v"(tid_));
    const int tid = tid_, wid = __builtin_amdgcn_readfirstlane(tid >> 6), lane = tid & 63, wr = wid >> 2, wc = wid & 3, fr = lane & 15, fq = lane >> 4;
    const int K = g.K;
    for (int ui = 0;; ++ui) {
        Unit cur; if (!S.next(ui, cur)) break;
        f32x4 acc[2][2][4][2];
#pragma unroll
        for (int a = 0; a < 2; ++a)
#pragma unroll
            for (int b = 0; b < 2; ++b)
#pragma unroll
                for (int m = 0; m < 4; ++m)
#pragma unroll
                    for (int n = 0; n < 2; ++n) acc[a][b][m][n] = (f32x4){0.f, 0.f, 0.f, 0.f};
        for (int k0 = 0; k0 < K; k0 += 32) {
            bf16x8 af[2][4], bfr[2][2];
#pragma unroll
            for (int ai = 0; ai < 2; ++ai)
#pragma unroll
                for (int m = 0; m < 4; ++m) af[ai][m] = *(const bf16x8*)(g.A + (size_t)(cur.pm * BM + ai * HALF + wr * 64 + m * 16 + fr) * K + k0 + fq * 8);
#pragma unroll
            for (int bj = 0; bj < 2; ++bj)
#pragma unroll
                for (int n = 0; n < 2; ++n) { const int slot = n * 16 + fr, cin = Epi::PERM ? perm32(slot) : slot;
                    bfr[bj][n] = *(const bf16x8*)(g.Bt + (size_t)(cur.pn * BM + bj * HALF + wc * 32 + cin) * K + k0 + fq * 8); }
#pragma unroll
            for (int ai = 0; ai < 2; ++ai)
#pragma unroll
                for (int bj = 0; bj < 2; ++bj)
#pragma unroll
                    for (int m = 0; m < 4; ++m)
#pragma unroll
                        for (int n = 0; n < 2; ++n) acc[ai][bj][m][n] = __builtin_amdgcn_mfma_f32_16x16x32_bf16(bfr[bj][n], af[ai][m], acc[ai][bj][m][n], 0, 0, 0);
        }
        E(acc, cur, wr, wc, fr, fq);
    }
}
template <class Epi, class Sched, bool ALIGN_EPI = false, bool SP2 = false>
__device__ __forceinline__ void gemm_phase(PG8_LAS unsigned char* lds, const Gemm g, const Sched& S, const Epi& E) {
    int tid_ = threadIdx.x; asm volatile("" : "+v"(tid_));
    const int tid = tid_, wid = __builtin_amdgcn_readfirstlane(tid >> 6), lane = tid & 63, wr = wid >> 2, wc = wid & 3, fr = lane & 15, fq = lane >> 4;
    const int K = g.K, nt = K / BK;
    unsigned voffA[2], voffB[2];
#pragma unroll
    for (int i = 0; i < 2; ++i) { int R, C; stage_rc(tid * 16 + i * 8192, R, C); const int Rb = Epi::PERM ? ((R & ~31) + perm32(R & 31)) : R;
        voffA[i] = (unsigned)(R * K + C) * 2u; voffB[i] = (unsigned)(Rb * K + C) * 2u; }
    const size_t kstep = (size_t)(BK * 2);
    const size_t hstep = (size_t)HALF * K * 2;
    const size_t tstep = 2 * hstep;
    const unsigned ldsw = (unsigned)wid * 1024u;
    const int aoff = lds_byte(wr * 64 + fr, fq * 8), boff = lds_byte(wc * 32 + fr, fq * 8);
#define PG8_SA(b, h) (((b) * 2 + (h)) * HTB)
#define PG8_SB(b, h) ((4 + (b) * 2 + (h)) * HTB)
#define PG8_STAGE(bufoff, gbase, voff) do { _Pragma("unroll") for (int _i = 0; _i < 2; ++_i) \
        __builtin_amdgcn_global_load_lds((const unsigned*)((const char*)(gbase) + (voff)[_i]), (PG8_LAS unsigned*)(lds + (bufoff) + ldsw + _i * 8192), 16, 0, 0); } while (0)
#define PG8_LDA(dst, b, h) do { _Pragma("unroll") for (int m = 0; m < 4; ++m) _Pragma("unroll") for (int k = 0; k < 2; ++k) dst[m][k] = *(const PG8_LAS bf16x8*)(lds + PG8_SA(b, h) + aoff + m * 2048 + k * 1024); } while (0)
#define PG8_LDB(dst, b, h) do { _Pragma("unroll") for (int n = 0; n < 2; ++n) _Pragma("unroll") for (int k = 0; k < 2; ++k) dst[n][k] = *(const PG8_LAS bf16x8*)(lds + PG8_SB(b, h) + boff + n * 2048 + k * 1024); } while (0)
#define PG8_MMA(ai, bj, At, Bt) do { __builtin_amdgcn_s_setprio(1); _Pragma("unroll") for (int m = 0; m < 4; ++m) _Pragma("unroll") for (int n = 0; n < 2; ++n) _Pragma("unroll") for (int k = 0; k < 2; ++k) \
        acc[ai][bj][m][n] = __builtin_amdgcn_mfma_f32_16x16x32_bf16(Bt[n][k], At[m][k], acc[ai][bj][m][n], 0, 0, 0); __builtin_amdgcn_s_setprio(0); } while (0)
#define PG8_WAIT_V(n) asm volatile("s_waitcnt vmcnt(" #n ")" ::: "memory")
#define PG8_WAIT_L(n) asm volatile("s_waitcnt lgkmcnt(" #n ")" ::: "memory")
#define PG8_BAR __builtin_amdgcn_s_barrier()
#define PG8_SCHED __builtin_amdgcn_sched_barrier(0)
    Unit cur, nxt; int ui = 0;
    if (!S.next(0, cur)) return;
    f32x4 acc[2][2][4][2];
#pragma unroll
    for (int a = 0; a < 2; ++a)
#pragma unroll
        for (int b = 0; b < 2; ++b)
#pragma unroll
            for (int m = 0; m < 4; ++m)
#pragma unroll
                for (int n = 0; n < 2; ++n) acc[a][b][m][n] = (f32x4){0.f, 0.f, 0.f, 0.f};
    bf16x8 At[4][2], B0[2][2], B1[2][2];
    const char* cA = (const char*)g.A + (size_t)cur.pm * tstep; const char* cB = (const char*)g.Bt + (size_t)cur.pn * tstep;
    S.a_ready(cur);
    if constexpr (SP2) {
        PG8_STAGE(PG8_SB(0, 0), cB, voffB); PG8_STAGE(PG8_SB(0, 1), cB + hstep, voffB); PG8_STAGE(PG8_SA(0, 0), cA, voffA); PG8_STAGE(PG8_SA(0, 1), cA + hstep, voffA);
        if (wr == 1) PG8_BAR;
        PG8_WAIT_V(2); PG8_BAR;
        PG8_STAGE(PG8_SB(1, 0), cB + kstep, voffB); PG8_STAGE(PG8_SA(1, 0), cA + kstep, voffA); PG8_STAGE(PG8_SB(1, 1), cB + hstep + kstep, voffB);
        PG8_WAIT_V(6); PG8_BAR;
    } else {
        PG8_STAGE(PG8_SB(0, 0), cB, voffB); PG8_STAGE(PG8_SA(0, 0), cA, voffA); PG8_STAGE(PG8_SB(0, 1), cB + hstep, voffB); PG8_STAGE(PG8_SA(0, 1), cA + hstep, voffA);
        if (wr == 1) PG8_BAR;
        PG8_WAIT_V(4); PG8_BAR;
        PG8_STAGE(PG8_SB(1, 0), cB + kstep, voffB); PG8_STAGE(PG8_SA(1, 0), cA + kstep, voffA); PG8_STAGE(PG8_SB(1, 1), cB + hstep + kstep, voffB);
        PG8_WAIT_V(6); PG8_BAR;
    }
    for (;;) {
        const bool has_next = S.next(ui + 1, nxt);
        const char* nA = has_next ? (const char*)g.A + (size_t)nxt.pm * tstep : cA; const char* nB = has_next ? (const char*)g.Bt + (size_t)nxt.pn * tstep : cB;
        for (int t = 0; t < nt; t += 2) {
            const bool last = (t == nt - 2);
            const char* a1 = cA + (size_t)(t + 1) * kstep;
            const char* a2 = last ? nA : cA + (size_t)(t + 2) * kstep; const char* b2 = last ? nB : cB + (size_t)(t + 2) * kstep;
            const char* a3 = a2 + kstep; const char* b3 = b2 + kstep;
            if (last && has_next) S.a_ready(nxt);
            if constexpr (SP2) {
            PG8_LDB(B0, 0, 0); PG8_LDB(B1, 0, 1); PG8_SCHED; PG8_LDA(At, 0, 0); PG8_STAGE(PG8_SA(1, 1), a1 + hstep, voffA);
            PG8_WAIT_V(8); PG8_WAIT_L(0); PG8_BAR; PG8_MMA(0, 0, At, B0); PG8_MMA(0, 1, At, B1); PG8_BAR; PG8_SCHED;
            PG8_LDA(At, 0, 1); PG8_STAGE(PG8_SB(0, 0), b2, voffB); PG8_STAGE(PG8_SB(0, 1), b2 + hstep, voffB); PG8_STAGE(PG8_SA(0, 0), a2, voffA);
            PG8_WAIT_V(8); PG8_WAIT_L(0); PG8_BAR; PG8_MMA(1, 0, At, B0); PG8_MMA(1, 1, At, B1); PG8_BAR; PG8_SCHED;
            PG8_LDB(B0, 1, 0); PG8_LDB(B1, 1, 1); PG8_SCHED; PG8_LDA(At, 1, 0); PG8_STAGE(PG8_SA(0, 1), a2 + hstep, voffA);
            PG8_WAIT_V(8); PG8_WAIT_L(0); PG8_BAR; PG8_MMA(0, 0, At, B0); PG8_MMA(0, 1, At, B1); PG8_BAR; PG8_SCHED;
            PG8_LDA(At, 1, 1); PG8_STAGE(PG8_SB(1, 0), b3, voffB); PG8_STAGE(PG8_SB(1, 1), b3 + hstep, voffB); PG8_STAGE(PG8_SA(1, 0), a3, voffA);
            PG8_WAIT_V(8); PG8_WAIT_L(0); PG8_BAR; PG8_MMA(1, 0, At, B0); PG8_MMA(1, 1, At, B1); PG8_BAR; PG8_SCHED;
            } else {
            PG8_LDB(B0, 0, 0); PG8_SCHED; PG8_LDA(At, 0, 0); PG8_STAGE(PG8_SA(1, 1), a1 + hstep, voffA);
            PG8_WAIT_L(8); PG8_BAR; PG8_WAIT_L(0); PG8_MMA(0, 0, At, B0); PG8_BAR; PG8_SCHED;
            PG8_LDB(B1, 0, 1); PG8_STAGE(PG8_SB(0, 0), b2, voffB);
            PG8_BAR; PG8_WAIT_L(0); PG8_MMA(0, 1, At, B1); PG8_BAR;
            PG8_LDA(At, 0, 1); PG8_STAGE(PG8_SA(0, 0), a2, voffA);
            PG8_BAR; PG8_WAIT_L(0); PG8_MMA(1, 0, At, B0); PG8_BAR; PG8_SCHED;
            PG8_STAGE(PG8_SB(0, 1), b2 + hstep, voffB);
            PG8_WAIT_V(6); PG8_BAR; PG8_MMA(1, 1, At, B1); PG8_BAR;
            PG8_LDB(B0, 1, 0); PG8_SCHED; PG8_LDA(At, 1, 0); PG8_STAGE(PG8_SA(0, 1), a2 + hstep, voffA);
            PG8_WAIT_L(8); PG8_BAR; PG8_WAIT_L(0); PG8_MMA(0, 0, At, B0); PG8_BAR; PG8_SCHED;
            PG8_LDB(B1, 1, 1); PG8_STAGE(PG8_SB(1, 0), b3, voffB);
            PG8_BAR; PG8_WAIT_L(0); PG8_MMA(0, 1, At, B1); PG8_BAR;
            PG8_LDA(At, 1, 1); PG8_STAGE(PG8_SA(1, 0), a3, voffA);
            PG8_BAR; PG8_WAIT_L(0); PG8_MMA(1, 0, At, B0); PG8_BAR; PG8_SCHED;
            PG8_STAGE(PG8_SB(1, 1), b3 + hstep, voffB);
            PG8_WAIT_V(6); PG8_BAR; PG8_MMA(1, 1, At, B1); PG8_BAR;
            }
        }
        if constexpr (ALIGN_EPI) { if (wr == 0) PG8_BAR; }
        if constexpr (!Epi::AFTER_DRAIN) { E(acc, cur, wr, wc, fr, fq); S.done(cur); }
        if (!has_next) break;
#pragma unroll
        for (int a = 0; a < 2; ++a)
#pragma unroll
            for (int b = 0; b < 2; ++b)
#pragma unroll
                for (int m = 0; m < 4; ++m)
#pragma unroll
                    for (int n = 0; n < 2; ++n) acc[a][b][m][n] = (f32x4){0.f, 0.f, 0.f, 0.f};
        cur = nxt; cA = nA; cB = nB; ++ui;
        if constexpr (ALIGN_EPI) { if (wr == 1) PG8_BAR; }
    }
    PG8_WAIT_V(0);
    if constexpr (!ALIGN_EPI) { if (wr == 0) PG8_BAR; }
    PG8_BAR;
    if constexpr (Epi::AFTER_DRAIN) { E.fused(acc, cur, wr, wc, fr, fq, lds, wid, lane); S.done(cur); }
#undef PG8_SA
#undef PG8_SB
#undef PG8_STAGE
#undef PG8_LDA
#undef PG8_LDB
#undef PG8_MMA
#undef PG8_WAIT_V
#undef PG8_WAIT_L
#undef PG8_BAR
#undef PG8_SCHED
}
}
#define GAS __attribute__((address_space(1)))
#define LAS __attribute__((address_space(3)))
typedef unsigned short bf16;
typedef unsigned v4u __attribute__((ext_vector_type(4)));
typedef float f32x4 __attribute__((ext_vector_type(4)));
typedef short bf16x8 __attribute__((ext_vector_type(8)));
typedef GAS unsigned gu32;
typedef GAS unsigned long long gu64;
#define RLX_AGENT __ATOMIC_RELAXED, __HIP_MEMORY_SCOPE_AGENT
#define LDS_WAIT() asm volatile("s_waitcnt lgkmcnt(0)" ::: "memory")
#define VM_WAIT() asm volatile("s_waitcnt vmcnt(0)" ::: "memory")
__device__ __forceinline__ unsigned long long rt() { return __builtin_amdgcn_s_memrealtime(); }
__device__ __forceinline__ unsigned f2bf(float f) { unsigned u = __builtin_bit_cast(unsigned, f); return (u + 0x7fffu + ((u >> 16) & 1u)) >> 16; }
__device__ __forceinline__ unsigned pk2(float lo, float hi) { return f2bf(lo) | (f2bf(hi) << 16); }

#define XB_TMO      128
#define XB_XCNT(j)  (256  + 64 * (j))
#define XB_XSUB(j)  (1280 + 64 * (j))
#define XB_XGEN(j)  (2304 + 64 * (j))
#define XB_TOP      3328
#define XB_TOPGEN   3392
#define XCD_BAR_WORDS 3456
#define XB_SPIN_CAP (1u << 18)

__device__ __forceinline__ unsigned xb_ld(unsigned* p)              { return __hip_atomic_load(p, __ATOMIC_RELAXED, __HIP_MEMORY_SCOPE_AGENT); }
__device__ __forceinline__ unsigned xb_add(unsigned* p, unsigned v) { return __hip_atomic_fetch_add(p, v, __ATOMIC_RELAXED, __HIP_MEMORY_SCOPE_AGENT); }
__device__ __forceinline__ unsigned xb_xcc_id() { return (unsigned)__builtin_amdgcn_s_getreg((3 << 11) | 20) & 0xFu; }
#define XB_SPIN(cond, bar) do { unsigned _sp = 0; while (cond) { __builtin_amdgcn_s_sleep(1); \
    if ((++_sp & 255u) == 0u) { if (xb_ld(&(bar)[XB_TMO])) break; if (_sp > XB_SPIN_CAP) { atomicAdd(&(bar)[XB_TMO], 1u); break; } } } } while (0)

struct XcdBarrier {
    unsigned* bar; unsigned x;
    volatile LAS unsigned* st;
};

__device__ __forceinline__ XcdBarrier xcd_barrier_post(unsigned* bar, volatile LAS unsigned* st) {
    XcdBarrier b; b.bar = bar; b.x = xb_xcc_id(); b.st = st;
    if (threadIdx.x == 0) (void)xb_add(&bar[XB_XCNT(b.x)], 1u);
    return b;
}
__device__ __forceinline__ void xcd_barrier_complete(unsigned* bar, unsigned x, unsigned& nloc, unsigned& nx) {
    const unsigned G = gridDim.x * gridDim.y * gridDim.z;
    unsigned sum, cnt, mine, sp = 0u;
    for (;;) {
        sum = 0u; cnt = 0u; mine = 0u;
#pragma unroll
        for (unsigned j = 0; j < 16; ++j) { const unsigned c = xb_ld(&bar[XB_XCNT(j)]); sum += c; cnt += (c > 0u) ? 1u : 0u; mine = (j == x) ? c : mine; }
        if (sum == G) break;
        __builtin_amdgcn_s_sleep(1);
        if ((++sp & 255u) == 0u) { if (xb_ld(&bar[XB_TMO])) break; if (sp > XB_SPIN_CAP) { atomicAdd(&bar[XB_TMO], 1u); break; } }
    }
    nloc = mine > 0u ? mine : 1u; nx = cnt > 0u ? cnt : 1u;
}

__device__ __forceinline__ void xcd_barrier(const XcdBarrier& b) {
    asm volatile("s_waitcnt vmcnt(0)" ::: "memory");
    __syncthreads();
    if (threadIdx.x == 0) {
        unsigned* bar = b.bar;
        __builtin_amdgcn_s_waitcnt(0);
        unsigned nloc = b.st[0], nx = b.st[1];
        if (nloc == 0u) { xcd_barrier_complete(bar, b.x, nloc, nx); b.st[0] = nloc; b.st[1] = nx; }
        const unsigned old = xb_add(&bar[XB_XSUB(b.x)], 1u);
        const unsigned gen = old / nloc;
        if (old + 1u == (gen + 1u) * nloc) {
            __builtin_amdgcn_fence(__ATOMIC_RELEASE, "agent");
            asm volatile("s_waitcnt vmcnt(0)" ::: "memory");
            const unsigned og = xb_add(&bar[XB_TOP], 1u);
            const unsigned tg = og / nx;
            if (og + 1u == (tg + 1u) * nx) xb_add(&bar[XB_TOPGEN], 1u);
            else XB_SPIN(xb_ld(&bar[XB_TOPGEN]) == tg, bar);
            __builtin_amdgcn_fence(__ATOMIC_ACQUIRE, "agent");
            xb_add(&bar[XB_XGEN(b.x)], 1u);
            asm volatile("s_waitcnt vmcnt(0)" ::: "memory");
        } else {
            XB_SPIN(xb_ld(&bar[XB_XGEN(b.x)]) == gen, bar);
            __builtin_amdgcn_fence(__ATOMIC_ACQUIRE, "agent");
            asm volatile("s_waitcnt vmcnt(0)" ::: "memory");
        }
    }
    __syncthreads();
}
constexpr int M = 16384, D = 1024, DH = 512, NPROJ = 1536, NE = 32, TOPK = 4, NAS = M * TOPK, SLOTS = NAS + NE * 256, SEQ = 4096, NBATCH = 4, NCH = 32, NG = 32, NP = 64, DEPTH = 2;
constexpr float EPS = 1e-5f;
constexpr int NWAVES = 8;
constexpr size_t MiB = 1u << 20;
constexpr size_t WS_CTL = 0, CTL_ZERO_BYTES = 512 * 1024;
constexpr int CW_BAR = 1024;
constexpr int CW_CNT = 8192;
constexpr int CW_SS = 16384;
static_assert((CW_SS + DEPTH * 2 * M) * 4 <= (int)CTL_ZERO_BYTES, "CTL words inside the memset region");
constexpr size_t WS_RE = 1 * MiB;
constexpr size_t WS_RK = WS_RE + (size_t)NAS * 4;
constexpr size_t WS_GW = WS_RK + (size_t)NAS * 4;
constexpr size_t WS_SO = WS_GW + (size_t)NAS * 4;
constexpr size_t WS_TGU = WS_SO + (size_t)NAS * 4;
constexpr size_t WS_TDN = WS_TGU + 288 * 8 * 8;
constexpr size_t WS_META = WS_TDN + 288 * 4 * 8;
constexpr size_t WS_SSMP = 3 * MiB;
constexpr size_t SSMP_ABAR = 0, SSMP_A128 = 16384, SSMP_BBAR = 32768, SSMP_CTAB = SSMP_BBAR + 262144, SSMP_STRIDE = SSMP_CTAB + 262144;
static_assert(WS_META + 256 <= WS_SSMP && WS_SSMP + DEPTH * SSMP_STRIDE <= 8 * MiB, "small tables");
constexpr size_t WS_W = 8 * MiB, W_IN = 0, W_OUT = 3 * MiB, W_GLU = 5 * MiB, W_GU = 6 * MiB, W_DN = 134 * MiB, W_STRIDE = 198 * MiB;
constexpr size_t WS_XB = WS_W + DEPTH * W_STRIDE;
constexpr size_t WS_P = WS_XB + 32 * MiB;
constexpr size_t WS_YG = WS_P + 48 * MiB;
constexpr size_t WS_MIX = WS_YG + 16 * MiB;
constexpr size_t WS_XA = WS_MIX + 32 * MiB;
constexpr size_t WS_XC = WS_XA + 64 * MiB;
constexpr size_t WS_H2 = WS_XC + 64 * MiB;
constexpr size_t WS_XS = WS_H2 + 32 * MiB;
constexpr size_t WS_ACT = WS_XS + 144 * MiB;
constexpr size_t WS_YB = WS_ACT + 144 * MiB;
constexpr size_t WS_EST = WS_YB + 144 * MiB;
constexpr size_t WS_END = WS_EST + 2 * MiB;
static_assert((size_t)SLOTS * D * 2 == 144 * MiB, "slot buffers");
constexpr int RING_OFF = 0, RING_BYTES = 131072;
constexpr int LDSCTL_OFF = 147456, MISC_OFF = LDSCTL_OFF + 4096;
constexpr int LDS_BYTES = 155648;
static_assert(MISC_OFF + 128 <= LDS_BYTES, "LDS map");
constexpr int PH_PER_LAYER = 11, N_PHASES = 1 + DEPTH * PH_PER_LAYER;
__device__ __forceinline__ float wave_sum(float v) {
#pragma unroll
    for (int o = 1; o < 64; o <<= 1) v += __shfl_xor(v, o);
    return v;
}
__device__ __forceinline__ float fast_sigmoid(float x) { return __builtin_amdgcn_rcpf(1.0f + __builtin_amdgcn_exp2f(-1.4426950409f * x)); }
__device__ __forceinline__ float gelu_tanh(float x) { const float u = x * (1.5957691216f + 0.0713548163f * x * x); return x * fast_sigmoid(u); }
__device__ __forceinline__ float bf2f(unsigned short b) { return __builtin_bit_cast(float, (unsigned)b << 16); }
__device__ __forceinline__ float bflo(unsigned w) { return __builtin_bit_cast(float, w << 16); }
__device__ __forceinline__ float bfhi(unsigned w) { return __builtin_bit_cast(float, w & 0xffff0000u); }
typedef unsigned v2u __attribute__((ext_vector_type(2)));

struct EpiInProj {
    static constexpr bool PERM = true, AFTER_DRAIN = false;
    bf16* P;
    __device__ __forceinline__ void operator()(const pg8::f32x4 (&acc)[2][2][4][2], const pg8::Unit& u, int wr, int wc, int fr, int fq) const {
        const int t = u.pn >> 1; const bool act = t < 2;
        bf16* base = P + (size_t)t * M * DH;
        const int row0 = u.pm * 256 + wr * 64 + fr, col0 = (u.pn & 1) * 256 + wc * 32 + 8 * fq;
#pragma unroll
        for (int ai = 0; ai < 2; ++ai)
#pragma unroll
            for (int m = 0; m < 4; ++m) { bf16* rowp = base + (size_t)(row0 + ai * 128 + m * 16) * DH + col0;
#pragma unroll
                for (int bj = 0; bj < 2; ++bj) { pg8::f32x4 v0 = acc[ai][bj][m][0], v1 = acc[ai][bj][m][1];
                    if (act) {
#pragma unroll
                        for (int j = 0; j < 4; ++j) { v0[j] = gelu_tanh(v0[j]); v1[j] = gelu_tanh(v1[j]); } }
                    v4u w; w.x = pg8::cvt_pk_bf16(v0[0], v0[1]); w.y = pg8::cvt_pk_bf16(v0[2], v0[3]); w.z = pg8::cvt_pk_bf16(v1[0], v1[1]); w.w = pg8::cvt_pk_bf16(v1[2], v1[3]);
                    *(v4u*)(rowp + bj * 128) = w; } }
    }
};
struct EpiGlu {
    static constexpr bool PERM = true, AFTER_DRAIN = false;
    const bf16* YG; bf16* MIX; const float* bias; float* ss;
    __device__ __forceinline__ void operator()(const pg8::f32x4 (&acc)[2][2][4][2], const pg8::Unit& u, int wr, int wc, int fr, int fq) const {
        const int row0 = u.pm * 256 + wr * 64 + fr, col0 = u.pn * 256 + wc * 32 + 8 * fq;
        pg8::f32x4 bv[2][2];
#pragma unroll
        for (int bj = 0; bj < 2; ++bj)
#pragma unroll
            for (int n = 0; n < 2; ++n) bv[bj][n] = *(const pg8::f32x4*)(bias + col0 + bj * 128 + 4 * n);
#pragma unroll
        for (int ai = 0; ai < 2; ++ai)
#pragma unroll
            for (int m = 0; m < 4; ++m) { const int row = row0 + ai * 128 + m * 16; float sq = 0.f;
#pragma unroll
                for (int bj = 0; bj < 2; ++bj) { const int col = col0 + bj * 128;
                    const v4u yw = *(const v4u*)(YG + (size_t)row * DH + col);
                    const pg8::f32x4 g0 = acc[ai][bj][m][0] + bv[bj][0], g1 = acc[ai][bj][m][1] + bv[bj][1];
                    float o[8];
                    o[0] = bflo(yw.x) * fast_sigmoid(g0[0]); o[1] = bfhi(yw.x) * fast_sigmoid(g0[1]); o[2] = bflo(yw.y) * fast_sigmoid(g0[2]); o[3] = bfhi(yw.y) * fast_sigmoid(g0[3]);
                    o[4] = bflo(yw.z) * fast_sigmoid(g1[0]); o[5] = bfhi(yw.z) * fast_sigmoid(g1[1]); o[6] = bflo(yw.w) * fast_sigmoid(g1[2]); o[7] = bfhi(yw.w) * fast_sigmoid(g1[3]);
#pragma unroll
                    for (int j = 0; j < 8; ++j) sq += o[j] * o[j];
                    v4u w; w.x = pg8::cvt_pk_bf16(o[0], o[1]); w.y = pg8::cvt_pk_bf16(o[2], o[3]); w.z = pg8::cvt_pk_bf16(o[4], o[5]); w.w = pg8::cvt_pk_bf16(o[6], o[7]);
                    *(v4u*)(MIX + (size_t)row * D + DH + col) = w; }
                sq += __shfl_xor(sq, 16); sq += __shfl_xor(sq, 32);
                if (fq == 0) atomicAdd(ss + row, sq); }
    }
};
struct EpiResid {
    static constexpr bool PERM = false, AFTER_DRAIN = false;
    const float* resid; float* out;
    __device__ __forceinline__ void operator()(const pg8::f32x4 (&acc)[2][2][4][2], const pg8::Unit& u, int wr, int wc, int fr, int fq) const {
        const int row0 = u.pm * 256 + wr * 64 + fr, col0 = u.pn * 256 + wc * 32 + 4 * fq;
#pragma unroll
        for (int ai = 0; ai < 2; ++ai)
#pragma unroll
            for (int m = 0; m < 4; ++m) { const size_t off = (size_t)(row0 + ai * 128 + m * 16) * D + col0;
#pragma unroll
                for (int bj = 0; bj < 2; ++bj)
#pragma unroll
                    for (int n = 0; n < 2; ++n) { const pg8::f32x4 r = *(const pg8::f32x4*)(resid + off + bj * 128 + n * 16); *(pg8::f32x4*)(out + off + bj * 128 + n * 16) = r + acc[ai][bj][m][n]; } }
    }
};
struct EpiSwiglu {
    static constexpr bool PERM = true, AFTER_DRAIN = false;
    bf16* ACT; const float* bgu;
    __device__ __forceinline__ void operator()(const pg8::f32x4 (&acc)[2][2][4][2], const pg8::Unit& u, int wr, int wc, int fr, int fq) const {
        const int e = u.pn >> 3, pn = u.pn & 7;
        const int row0 = u.pm * 256 + wr * 64 + fr, col0 = pn * 128 + wc * 32 + 8 * fq;
        const float* bg = bgu + (size_t)e * 2048 + col0;
        pg8::f32x4 bgl[2], bli[2];
#pragma unroll
        for (int n = 0; n < 2; ++n) { bgl[n] = *(const pg8::f32x4*)(bg + 4 * n); bli[n] = *(const pg8::f32x4*)(bg + 1024 + 4 * n); }
#pragma unroll
        for (int ai = 0; ai < 2; ++ai)
#pragma unroll
            for (int m = 0; m < 4; ++m) { float o[8];
#pragma unroll
                for (int n = 0; n < 2; ++n)
#pragma unroll
                    for (int j = 0; j < 4; ++j) { float gl = acc[ai][0][m][n][j] + bgl[n][j], li = acc[ai][1][m][n][j] + bli[n][j];
                        gl = fminf(gl, 7.0f); li = fminf(fmaxf(li, -7.0f), 7.0f);
                        o[4 * n + j] = gl * fast_sigmoid(1.702f * gl) * (li + 1.0f); }
                v4u w; w.x = pg8::cvt_pk_bf16(o[0], o[1]); w.y = pg8::cvt_pk_bf16(o[2], o[3]); w.z = pg8::cvt_pk_bf16(o[4], o[5]); w.w = pg8::cvt_pk_bf16(o[6], o[7]);
                *(v4u*)(ACT + (size_t)(row0 + ai * 128 + m * 16) * D + col0) = w; }
    }
};
struct EpiDown {
    static constexpr bool PERM = true, AFTER_DRAIN = false;
    bf16* YB; const float* bdn;
    __device__ __forceinline__ void operator()(const pg8::f32x4 (&acc)[2][2][4][2], const pg8::Unit& u, int wr, int wc, int fr, int fq) const {
        const int e = u.pn >> 2, pn = u.pn & 3;
        const int row0 = u.pm * 256 + wr * 64 + fr, col0 = pn * 256 + wc * 32 + 8 * fq;
        const float* bb = bdn + (size_t)e * D + col0;
        pg8::f32x4 bv[2][2];
#pragma unroll
        for (int bj = 0; bj < 2; ++bj)
#pragma unroll
            for (int n = 0; n < 2; ++n) bv[bj][n] = *(const pg8::f32x4*)(bb + bj * 128 + 4 * n);
#pragma unroll
        for (int ai = 0; ai < 2; ++ai)
#pragma unroll
            for (int m = 0; m < 4; ++m) { bf16* rowp = YB + (size_t)(row0 + ai * 128 + m * 16) * D + col0;
#pragma unroll
                for (int bj = 0; bj < 2; ++bj) { const pg8::f32x4 v0 = acc[ai][bj][m][0] + bv[bj][0], v1 = acc[ai][bj][m][1] + bv[bj][1];
                    v4u w; w.x = pg8::cvt_pk_bf16(v0[0], v0[1]); w.y = pg8::cvt_pk_bf16(v0[2], v0[3]); w.z = pg8::cvt_pk_bf16(v1[0], v1[1]); w.w = pg8::cvt_pk_bf16(v1[2], v1[3]);
                    *(v4u*)(rowp + bj * 128) = w; } }
    }
};
struct TableOrder {
    const int* tab; int n, G, c;
    __device__ __forceinline__ bool next(int i, pg8::Unit& u) const {
        const int per = G >> 3, L = (i * 8 + (c & 7)) * per + (c >> 3);
        if (L >= n) return false;
        u.pm = __builtin_amdgcn_readfirstlane(__hip_atomic_load(tab + 2 * L, __ATOMIC_RELAXED, __HIP_MEMORY_SCOPE_AGENT));
        u.pn = __builtin_amdgcn_readfirstlane(__hip_atomic_load(tab + 2 * L + 1, __ATOMIC_RELAXED, __HIP_MEMORY_SCOPE_AGENT));
        return true;
    }
    __device__ __forceinline__ void a_ready(const pg8::Unit&) const {}
    __device__ __forceinline__ void done(const pg8::Unit&) const {}
};
struct Frame {
    LAS unsigned char* lds;
    volatile LAS unsigned* MISC;
    gu32* ctl;
    unsigned char* ws;
    int tid, lane, wave, vcu, G;
};
struct Args { const float* in[28]; float* out; unsigned char* ws; int ph_lo, ph_hi; };
enum { I_X = 0, I_ANW, I_WIN, I_LNW, I_LNB, I_SGUW, I_SGUB, I_ARE, I_AIM, I_BRE, I_BIM, I_CRE, I_CIM, I_SD, I_LOGDT, I_GLUW, I_GLUB, I_ONA, I_ONB, I_WOUT, I_FNW, I_RW, I_RB, I_WGU, I_BGU, I_WDN, I_BDN, I_FINW };

__device__ __forceinline__ void tr_item(const float* W, int K, int N, bf16* WT, int k0, int n0, int drow0, const float* sc, LAS float* scr, int lane) {
#pragma unroll 8
    for (int i = 0; i < 32; ++i) { const int kk = 2 * i + (lane >> 5); float v = W[(size_t)(k0 + kk) * N + n0 + (lane & 31)]; if (sc) v *= sc[k0 + kk]; scr[kk * 33 + (lane & 31)] = v; }
    LDS_WAIT(); asm volatile("" ::: "memory");
    const int c = lane & 7;
#pragma unroll
    for (int j = 0; j < 4; ++j) { const int n = (lane >> 3) + 8 * j; const LAS float* s = scr + (8 * c) * 33 + n;
        v4u o; o.x = pk2(s[0 * 33], s[1 * 33]); o.y = pk2(s[2 * 33], s[3 * 33]); o.z = pk2(s[4 * 33], s[5 * 33]); o.w = pk2(s[6 * 33], s[7 * 33]);
        *(GAS v4u*)(WT + (size_t)(drow0 + n) * K + k0 + 8 * c) = o; }
    LDS_WAIT(); asm volatile("" ::: "memory");
}
__device__ __forceinline__ void rms_row_to_bf16(const float* xrow, bf16* orow, int lane) {
    const GAS f32x4* xr = (const GAS f32x4*)xrow + lane;
    f32x4 v[4]; float s = 0.f;
#pragma unroll
    for (int j = 0; j < 4; ++j) { v[j] = xr[64 * j]; s += (v[j].x * v[j].x + v[j].y * v[j].y) + (v[j].z * v[j].z + v[j].w * v[j].w); }
    const float rs = 1.0f / sqrtf(wave_sum(s) * (1.f / D) + EPS);
    GAS unsigned long long* o8 = (GAS unsigned long long*)orow + lane;
#pragma unroll
    for (int j = 0; j < 4; ++j) o8[64 * j] = (unsigned long long)pk2(v[j].x * rs, v[j].y * rs) | ((unsigned long long)pk2(v[j].z * rs, v[j].w * rs) << 32);
}
__device__ __forceinline__ void ph_prep(Frame& F, const Args& A) {
    LAS float* scr = (LAS float*)(F.lds + RING_OFF + F.wave * 16384);
    const int gw = F.vcu * NWAVES + F.wave, NGW = F.G * NWAVES;
    constexpr int I_IN = 16 * 48, I_OUT = 16 * 32, I_GLU = 8 * 16, I_GU = NE * 16 * 64, I_DN = NE * 16 * 32, PER_L = I_IN + I_OUT + I_GLU + I_GU + I_DN;
    for (int it = gw; it < DEPTH * PER_L; it += NGW) {
        const int l = it / PER_L; int r = it - l * PER_L;
        unsigned char* wb = F.ws + WS_W + (size_t)l * W_STRIDE;
        if (r < I_IN) { const int kb = r / 48, nb = r % 48; tr_item(A.in[I_WIN] + (size_t)l * D * NPROJ, D, NPROJ, (bf16*)(wb + W_IN), 64 * kb, 32 * nb, 32 * nb, A.in[I_ANW] + l * D, scr, F.lane); continue; } r -= I_IN;
        if (r < I_OUT) { const int kb = r / 32, nb = r % 32; const float* sc = (kb < 8) ? A.in[I_ONA] + l * DH : A.in[I_ONB] + l * DH - DH;
            tr_item(A.in[I_WOUT] + (size_t)l * D * D, D, D, (bf16*)(wb + W_OUT), 64 * kb, 32 * nb, 32 * nb, sc, scr, F.lane); continue; } r -= I_OUT;
        if (r < I_GLU) { const int kb = r / 16, nb = r % 16; tr_item(A.in[I_GLUW] + (size_t)l * DH * DH, DH, DH, (bf16*)(wb + W_GLU), 64 * kb, 32 * nb, 32 * nb, nullptr, scr, F.lane); continue; } r -= I_GLU;
        if (r < I_GU) { const int e = r / 1024, rr = r % 1024, kb = rr / 64, nb = rr % 64, n0 = 32 * nb, j = n0 & 1023, half = n0 >> 10, drow0 = (j >> 7) * 256 + half * 128 + (j & 127);
            tr_item(A.in[I_WGU] + ((size_t)l * NE + e) * D * 2048, D, 2048, (bf16*)(wb + W_GU) + (size_t)e * 2048 * D, 64 * kb, n0, drow0, A.in[I_FNW] + l * D, scr, F.lane); continue; } r -= I_GU;
        { const int e = r / 512, rr = r % 512, kb = rr / 32, nb = rr % 32;
            tr_item(A.in[I_WDN] + ((size_t)l * NE + e) * D * D, D, D, (bf16*)(wb + W_DN) + (size_t)e * D * D, 64 * kb, 32 * nb, 32 * nb, nullptr, scr, F.lane); }
    }
    for (int m = gw; m < M; m += NGW) rms_row_to_bf16(A.in[I_X] + (size_t)m * D, (bf16*)(F.ws + WS_XB) + (size_t)m * D, F.lane);
    for (int i = (F.vcu * NWAVES + F.wave) * 64 + F.lane; i < DEPTH * NG * NP; i += F.G * NWAVES * 64) {
        const int l = i / (NG * NP), gp = i % (NG * NP), g = gp / NP, p = gp % NP;
        unsigned char* sp = F.ws + WS_SSMP + (size_t)l * SSMP_STRIDE;
        const float dt = expf(A.in[I_LOGDT][l * NG + g]), ar = A.in[I_ARE][i], ai = A.in[I_AIM][i];
        const float ex = expf(dt * ar); float sn, cs; sincosf(dt * ai, &sn, &cs);
        const float abr = ex * cs, abi = ex * sn;
        const float nr = abr - 1.0f, ni = abi, den = ar * ar + ai * ai, cr = (nr * ar + ni * ai) / den, ci = (ni * ar - nr * ai) / den;
        ((float*)(sp + SSMP_ABAR))[gp * 2] = abr; ((float*)(sp + SSMP_ABAR))[gp * 2 + 1] = abi;
        float pr = abr, pi = abi;
#pragma unroll
        for (int k = 0; k < 7; ++k) { const float t = pr * pr - pi * pi; pi = 2.0f * pr * pi; pr = t; }
        ((float*)(sp + SSMP_A128))[gp * 2] = pr; ((float*)(sp + SSMP_A128))[gp * 2 + 1] = pi;
        float* bb = (float*)(sp + SSMP_BBAR) + (size_t)gp * 32;
        const float* bre = A.in[I_BRE] + (size_t)i * 16; const float* bim = A.in[I_BIM] + (size_t)i * 16;
#pragma unroll
        for (int h = 0; h < 16; ++h) { const float br = bre[h], bi = bim[h]; bb[h] = cr * br - ci * bi; bb[16 + h] = cr * bi + ci * br; }
        float* ct = (float*)(sp + SSMP_CTAB) + (size_t)g * 128 * 16;
        const float* cre = A.in[I_CRE] + (size_t)(l * NG + g) * 16 * NP; const float* cim = A.in[I_CIM] + (size_t)(l * NG + g) * 16 * NP;
#pragma unroll
        for (int h = 0; h < 16; ++h) { ct[p * 16 + h] = cre[h * NP + p]; ct[(64 + p) * 16 + h] = -cim[h * NP + p]; }
    }
}

__device__ __forceinline__ void sgu_chunk(Frame& F, const Args& A, int l, int c) {
    const bf16* UG = (const bf16*)(F.ws + WS_P); const bf16* VG = UG + (size_t)M * DH;
    bf16* MIX = (bf16*)(F.ws + WS_MIX);
    float* ssa = (float*)(F.ctl + CW_SS) + (size_t)(l * 2 + 0) * M;
    LAS bf16* vn = (LAS bf16*)(F.lds + RING_OFF);
    LAS float* ssl = (LAS float*)(F.lds + LDSCTL_OFF);
    const float* lnw = A.in[I_LNW] + l * DH; const float* lnb = A.in[I_LNB] + l * DH;
    if (F.tid < 128) ssl[F.tid] = 0.f;
    for (int r = F.wave * 16; r < F.wave * 16 + 16; ++r) {
        const v4u w = *(const GAS v4u*)(VG + (size_t)(c * 128 + r) * DH + 8 * F.lane);
        float v[8] = {bflo(w.x), bfhi(w.x), bflo(w.y), bfhi(w.y), bflo(w.z), bfhi(w.z), bflo(w.w), bfhi(w.w)};
        float s = 0.f, s2 = 0.f;
#pragma unroll
        for (int j = 0; j < 8; ++j) { s += v[j]; s2 += v[j] * v[j]; }
        s = wave_sum(s); s2 = wave_sum(s2);
        const float mean = s * (1.f / DH), var = fmaxf(s2 * (1.f / DH) - mean * mean, 0.f), rstd = 1.0f / sqrtf(var + EPS);
        const f32x4 w0 = *(const GAS f32x4*)(lnw + 8 * F.lane), w1 = *(const GAS f32x4*)(lnw + 8 * F.lane + 4), b0 = *(const GAS f32x4*)(lnb + 8 * F.lane), b1 = *(const GAS f32x4*)(lnb + 8 * F.lane + 4);
        const float ww[8] = {w0.x, w0.y, w0.z, w0.w, w1.x, w1.y, w1.z, w1.w}, bb[8] = {b0.x, b0.y, b0.z, b0.w, b1.x, b1.y, b1.z, b1.w};
        float o[8];
#pragma unroll
        for (int j = 0; j < 8; ++j) o[j] = (v[j] - mean) * rstd * ww[j] + bb[j];
        v4u ow; ow.x = pk2(o[0], o[1]); ow.y = pk2(o[2], o[3]); ow.z = pk2(o[4], o[5]); ow.w = pk2(o[6], o[7]);
        *(LAS v4u*)(vn + r * DH + 8 * F.lane) = ow;
    }
    __syncthreads();
    const int d = F.tid, h = __builtin_amdgcn_readfirstlane(d >> 7);
    const float* Wh = A.in[I_SGUW] + (size_t)(l * 4 + h) * 128 * 128; const float* bh = A.in[I_SGUB] + (size_t)(l * 4 + h) * 128;
    for (int t8 = 0; t8 < 16; ++t8) {
        float acc[8];
#pragma unroll
        for (int i = 0; i < 8; ++i) acc[i] = 0.f;
        for (int sb = 0; sb <= t8; ++sb) {
            float v[8];
#pragma unroll
            for (int j = 0; j < 8; ++j) v[j] = bf2f(vn[(sb * 8 + j) * DH + d]);
            const bool diag = (sb == t8);
#pragma unroll
            for (int i = 0; i < 8; ++i) { const float* wr = Wh + (size_t)(t8 * 8 + i) * 128 + sb * 8;
#pragma unroll
                for (int j = 0; j < 8; ++j) { const float w = (diag && j > i) ? 0.f : wr[j]; acc[i] += w * v[j]; } }
        }
#pragma unroll
        for (int i = 0; i < 8; ++i) { const int t = t8 * 8 + i; const size_t row = (size_t)c * 128 + t;
            const float y = bf2f(UG[row * DH + d]) * (acc[i] + bh[t]);
            MIX[row * D + d] = (bf16)f2bf(y);
            const float q = wave_sum(y * y);
            if (F.lane == 0) __hip_atomic_fetch_add(ssl + t, q, __ATOMIC_RELAXED, __HIP_MEMORY_SCOPE_WORKGROUP); }
    }
    __syncthreads();
    if (F.tid < 128) ssa[(size_t)c * 128 + F.tid] = ssl[F.tid];
    __syncthreads();
}

__device__ __forceinline__ void ssm_pass1_item(Frame& F, const Args& A, int l, int g, int b, int ch) {
    const unsigned char* sp = F.ws + WS_SSMP + (size_t)l * SSMP_STRIDE;
    const bf16* US = (const bf16*)(F.ws + WS_P) + (size_t)2 * M * DH;
    const int p = F.lane, gp = g * NP + p;
    const float abr = ((const float*)(sp + SSMP_ABAR))[gp * 2], abi = ((const float*)(sp + SSMP_ABAR))[gp * 2 + 1];
    float bb[32];
    { const GAS f32x4* bp = (const GAS f32x4*)((const float*)(sp + SSMP_BBAR) + (size_t)gp * 32);
#pragma unroll
      for (int q = 0; q < 8; ++q) { const f32x4 t = bp[q]; bb[4 * q] = t.x; bb[4 * q + 1] = t.y; bb[4 * q + 2] = t.z; bb[4 * q + 3] = t.w; } }
    float xr = 0.f, xi = 0.f;
    const bf16* up = US + ((size_t)b * SEQ + ch * 128) * DH + g * 16;
#pragma unroll 4
    for (int t = 0; t < 128; ++t) {
        const v4u u0 = *(const GAS v4u*)(up + (size_t)t * DH), u1 = *(const GAS v4u*)(up + (size_t)t * DH + 8);
        const float u[16] = {bflo(u0.x), bfhi(u0.x), bflo(u0.y), bfhi(u0.y), bflo(u0.z), bfhi(u0.z), bflo(u0.w), bfhi(u0.w), bflo(u1.x), bfhi(u1.x), bflo(u1.y), bfhi(u1.y), bflo(u1.z), bfhi(u1.z), bflo(u1.w), bfhi(u1.w)};
        float br = 0.f, bi = 0.f;
#pragma unroll
        for (int h = 0; h < 16; ++h) { br += bb[h] * u[h]; bi += bb[16 + h] * u[h]; }
        const float nr = abr * xr - abi * xi + br, ni = abr * xi + abi * xr + bi; xr = nr; xi = ni;
    }
    float* est = (float*)(F.ws + WS_EST) + ((((size_t)b * NG + g) * NCH + ch) * NP + p) * 2;
    est[0] = xr; est[1] = xi;
}
__device__ __forceinline__ void ssm_pass2_group(Frame& F, const Args& A, int l, int g, int b, int cq) {
    const unsigned char* sp = F.ws + WS_SSMP + (size_t)l * SSMP_STRIDE;
    const bf16* US = (const bf16*)(F.ws + WS_P) + (size_t)2 * M * DH;
    bf16* YG = (bf16*)(F.ws + WS_YG);
    LAS float* ctab = (LAS float*)(F.lds + RING_OFF);
    LAS float* xs = (LAS float*)(F.lds + RING_OFF + 8192 + F.wave * 8256);
    { const f32x4 t = ((const GAS f32x4*)((const float*)(sp + SSMP_CTAB) + (size_t)g * 2048))[F.tid]; ((LAS f32x4*)ctab)[F.tid] = t; }
    __syncthreads();
    const int ch = cq * 8 + F.wave, p = F.lane, gp = g * NP + p;
    const float abr = ((const float*)(sp + SSMP_ABAR))[gp * 2], abi = ((const float*)(sp + SSMP_ABAR))[gp * 2 + 1];
    const float a8r = ((const float*)(sp + SSMP_A128))[gp * 2], a8i = ((const float*)(sp + SSMP_A128))[gp * 2 + 1];
    float bb[32];
    { const GAS f32x4* bp = (const GAS f32x4*)((const float*)(sp + SSMP_BBAR) + (size_t)gp * 32);
#pragma unroll
      for (int q = 0; q < 8; ++q) { const f32x4 t = bp[q]; bb[4 * q] = t.x; bb[4 * q + 1] = t.y; bb[4 * q + 2] = t.z; bb[4 * q + 3] = t.w; } }
    float xr = 0.f, xi = 0.f;
    { const float* est = (const float*)(F.ws + WS_EST) + (((size_t)b * NG + g) * NCH * NP + p) * 2;
      for (int c2 = 0; c2 < ch; ++c2) { const float er = est[(size_t)c2 * NP * 2], ei = est[(size_t)c2 * NP * 2 + 1];
          const float nr = a8r * xr - a8i * xi + er, ni = a8r * xi + a8i * xr + ei; xr = nr; xi = ni; } }
    const size_t row0 = (size_t)b * SEQ + ch * 128;
    const bf16* up = US + row0 * DH + g * 16;
    const int tt = F.lane >> 2, hq = F.lane & 3;
    const f32x4 dv = *(const GAS f32x4*)(A.in[I_SD] + l * DH + g * 16 + 4 * hq);
    for (int tb = 0; tb < 8; ++tb) {
#pragma unroll 4
        for (int t2 = 0; t2 < 16; ++t2) { const int t = tb * 16 + t2;
            const v4u u0 = *(const GAS v4u*)(up + (size_t)t * DH), u1 = *(const GAS v4u*)(up + (size_t)t * DH + 8);
            const float u[16] = {bflo(u0.x), bfhi(u0.x), bflo(u0.y), bfhi(u0.y), bflo(u0.z), bfhi(u0.z), bflo(u0.w), bfhi(u0.w), bflo(u1.x), bfhi(u1.x), bflo(u1.y), bfhi(u1.y), bflo(u1.z), bfhi(u1.z), bflo(u1.w), bfhi(u1.w)};
            float br = 0.f, bi = 0.f;
#pragma unroll
            for (int h = 0; h < 16; ++h) { br += bb[h] * u[h]; bi += bb[16 + h] * u[h]; }
            const float nr = abr * xr - abi * xi + br, ni = abr * xi + abi * xr + bi; xr = nr; xi = ni;
            xs[t2 * 129 + p] = xr; xs[t2 * 129 + 64 + p] = xi; }
        LDS_WAIT(); asm volatile("" ::: "memory");
        f32x4 y = (f32x4){0.f, 0.f, 0.f, 0.f};
#pragma unroll 8
        for (int kk = 0; kk < 128; ++kk) { const float xv = xs[tt * 129 + kk]; const f32x4 c4 = *(const LAS f32x4*)(ctab + kk * 16 + 4 * hq); y += c4 * xv; }
        const size_t row = row0 + tb * 16 + tt;
        const v2u uw = *(const GAS v2u*)(US + row * DH + g * 16 + 4 * hq);
        y.x += dv.x * bflo(uw.x); y.y += dv.y * bfhi(uw.x); y.z += dv.z * bflo(uw.y); y.w += dv.w * bfhi(uw.y);
        v2u o; o.x = pk2(gelu_tanh(y.x), gelu_tanh(y.y)); o.y = pk2(gelu_tanh(y.z), gelu_tanh(y.w));
        *(GAS v2u*)(YG + row * DH + g * 16 + 4 * hq) = o;
        LDS_WAIT(); asm volatile("" ::: "memory");
    }
    __syncthreads();
}

__device__ __forceinline__ void ph_normb(Frame& F, const Args& A, int l) {
    bf16* MIX = (bf16*)(F.ws + WS_MIX);
    gu32* ssa = F.ctl + CW_SS + (size_t)(l * 2) * M; gu32* ssb = ssa + M;
    const int gw = F.vcu * NWAVES + F.wave, NGW = F.G * NWAVES;
    for (int m = gw; m < M; m += NGW) {
        const float sa = 1.0f / sqrtf(__builtin_bit_cast(float, __hip_atomic_load(ssa + m, RLX_AGENT)) * (1.f / DH) + EPS), sb = 1.0f / sqrtf(__builtin_bit_cast(float, __hip_atomic_load(ssb + m, RLX_AGENT)) * (1.f / DH) + EPS);
#pragma unroll
        for (int hf = 0; hf < 2; ++hf) { const float s = hf ? sb : sa; GAS v4u* p = (GAS v4u*)(MIX + (size_t)m * D + hf * DH + 8 * F.lane); const v4u w = *p;
            v4u o; o.x = pk2(bflo(w.x) * s, bfhi(w.x) * s); o.y = pk2(bflo(w.y) * s, bfhi(w.y) * s); o.z = pk2(bflo(w.z) * s, bfhi(w.z) * s); o.w = pk2(bflo(w.w) * s, bfhi(w.w) * s); *p = o; }
    }
}

__device__ __forceinline__ void ph_route(Frame& F, const Args& A, int l) {
    const float* XA = (const float*)(F.ws + WS_XA); bf16* H2 = (bf16*)(F.ws + WS_H2);
    int* RE = (int*)(F.ws + WS_RE); int* RK = (int*)(F.ws + WS_RK); float* GW = (float*)(F.ws + WS_GW);
    gu32* cnt = F.ctl + CW_CNT + l * NE;
    LAS float* tab = (LAS float*)(F.lds + RING_OFF);
    LAS int* lcnt = (LAS int*)(F.lds + LDSCTL_OFF); LAS int* lbase = lcnt + 32;
    LAS int* as_e = (LAS int*)(F.lds + LDSCTL_OFF + 1024); LAS int* as_lr = as_e + 256; LAS float* as_g = (LAS float*)(as_lr + 256);
    const float* rw = A.in[I_RW] + (size_t)l * D * NE; const float* fw = A.in[I_FNW] + l * D; const float* rb = A.in[I_RB] + l * NE;
    for (int i = F.tid; i < D * 8; i += NWAVES * 64) { const int k = i >> 3, c = i & 7; f32x4 w = *(const GAS f32x4*)(rw + (size_t)k * NE + 4 * c); const float s = fw[k]; w = w * s;
        const int pos = ((k >> 8) * 4 + (k & 3)) * 64 + ((k >> 2) & 63); *(LAS f32x4*)(tab + pos * 36 + 4 * c) = w; }
    for (int blk = F.vcu; blk < M / 64; blk += F.G) {
        if (F.tid < 32) lcnt[F.tid] = 0;
        __syncthreads();
#pragma unroll 1
        for (int bt = 0; bt < 4; ++bt) {
            const int lr0 = F.wave * 8 + bt * 2, r0 = blk * 64 + lr0;
            f32x4 v[2][4];
#pragma unroll
            for (int r = 0; r < 2; ++r) { const GAS f32x4* xr = (const GAS f32x4*)(XA + (size_t)(r0 + r) * D) + F.lane; float s = 0.f;
#pragma unroll
                for (int j = 0; j < 4; ++j) { v[r][j] = xr[64 * j]; s += (v[r][j].x * v[r][j].x + v[r][j].y * v[r][j].y) + (v[r][j].z * v[r][j].z + v[r][j].w * v[r][j].w); }
                const float rs = 1.0f / sqrtf(wave_sum(s) * (1.f / D) + EPS);
                GAS unsigned long long* o8 = (GAS unsigned long long*)(H2 + (size_t)(r0 + r) * D) + F.lane;
#pragma unroll
                for (int j = 0; j < 4; ++j) { v[r][j] = v[r][j] * rs; o8[64 * j] = (unsigned long long)pk2(v[r][j].x, v[r][j].y) | ((unsigned long long)pk2(v[r][j].z, v[r][j].w) << 32); } }
            typedef float f32x2 __attribute__((ext_vector_type(2)));
            f32x2 acc2[32];
#pragma unroll
            for (int e = 0; e < 32; ++e) acc2[e] = (f32x2){0.f, 0.f};
#pragma unroll
            for (int j = 0; j < 4; ++j)
#pragma unroll
                for (int i = 0; i < 4; ++i) { const LAS float* trow = tab + F.lane * 36 + (j * 4 + i) * 64 * 36;
                    const f32x2 xx = (f32x2){v[0][j][i], v[1][j][i]};
#pragma unroll
                    for (int c = 0; c < 8; ++c) { const f32x4 w = *(const LAS f32x4*)(trow + 4 * c);
                        acc2[4 * c] += xx * w.x; acc2[4 * c + 1] += xx * w.y; acc2[4 * c + 2] += xx * w.z; acc2[4 * c + 3] += xx * w.w; } }
            float acc[2][32];
#pragma unroll
            for (int e = 0; e < 32; ++e) { acc[0][e] = acc2[e].x; acc[1][e] = acc2[e].y; }
#pragma unroll
            for (int r = 0; r < 2; ++r) {
                const int L = F.lane;
#pragma unroll
                for (int i = 0; i < 16; ++i) { const bool hi = (L & 32) != 0; const float keep = hi ? acc[r][i + 16] : acc[r][i], send = hi ? acc[r][i] : acc[r][i + 16]; acc[r][i] = keep + __shfl_xor(send, 32); }
#pragma unroll
                for (int i = 0; i < 8; ++i) { const bool hi = (L & 16) != 0; const float keep = hi ? acc[r][i + 8] : acc[r][i], send = hi ? acc[r][i] : acc[r][i + 8]; acc[r][i] = keep + __shfl_xor(send, 16); }
#pragma unroll
                for (int i = 0; i < 4; ++i) { const bool hi = (L & 8) != 0; const float keep = hi ? acc[r][i + 4] : acc[r][i], send = hi ? acc[r][i] : acc[r][i + 4]; acc[r][i] = keep + __shfl_xor(send, 8); }
#pragma unroll
                for (int i = 0; i < 2; ++i) { const bool hi = (L & 4) != 0; const float keep = hi ? acc[r][i + 2] : acc[r][i], send = hi ? acc[r][i] : acc[r][i + 2]; acc[r][i] = keep + __shfl_xor(send, 4); }
                { const bool hi = (L & 2) != 0; const float keep = hi ? acc[r][1] : acc[r][0], send = hi ? acc[r][0] : acc[r][1]; acc[r][0] = keep + __shfl_xor(send, 2); }
                const int e = L >> 1;
                const float val = acc[r][0] + __shfl_xor(acc[r][0], 1) + rb[e];
                int rank = 0, sidx = L, oe = e;
#pragma unroll 1
                for (int dd = 1; dd < 32; ++dd) { sidx = (sidx + 2) & 63; oe = (oe + 1) & 31; const float ov = __shfl(val, sidx); rank += (ov > val || (ov == val && oe < e)) ? 1 : 0; }
                float mx = val;
#pragma unroll
                for (int o = 2; o < 64; o <<= 1) mx = fmaxf(mx, __shfl_xor(mx, o));
                const bool win = (rank < 4) && ((L & 1) == 0);
                const float ex = win ? __expf(val - mx) : 0.f;
                const float den = wave_sum(ex);
                if (win) { const int slr = __hip_atomic_fetch_add(lcnt + e, 1, __ATOMIC_RELAXED, __HIP_MEMORY_SCOPE_WORKGROUP);
                    const int ix = (lr0 + r) * 4 + rank; as_e[ix] = e; as_lr[ix] = slr; as_g[ix] = ex / den; }
            }
        }
        __syncthreads();
        if (F.tid < 32) lbase[F.tid] = (int)__hip_atomic_fetch_add(cnt + F.tid, (unsigned)lcnt[F.tid], RLX_AGENT);
        __syncthreads();
        if (F.tid < 256) { const int a = blk * 256 + F.tid, e = as_e[F.tid]; RE[a] = e; RK[a] = lbase[e] + as_lr[F.tid]; GW[a] = as_g[F.tid]; }
        __syncthreads();
    }
}

__device__ __forceinline__ void ph_gather(Frame& F, const Args& A, int l) {
    gu32* cnt = F.ctl + CW_CNT + l * NE;
    LAS int* off = (LAS int*)(F.lds + LDSCTL_OFF + 512);
    if (F.tid == 0) { int o = 0; for (int e = 0; e < NE; ++e) { off[e] = o; const int c = (int)__hip_atomic_load(cnt + e, RLX_AGENT); o += (c + 255) & ~255; } off[NE] = o; }
    __syncthreads();
    if (blockIdx.x == 0) {
        int* tgu = (int*)(F.ws + WS_TGU); int* tdn = (int*)(F.ws + WS_TDN); int* meta = (int*)(F.ws + WS_META);
        if (F.tid < NE) { const int e = F.tid, t0 = off[e] >> 8, mt = (off[e + 1] - off[e]) >> 8;
            { int idx = t0 * 8; for (int pg = 0; pg * 4 < mt; ++pg) { const int gs = (mt - pg * 4) < 4 ? (mt - pg * 4) : 4; for (int pn = 0; pn < 8; ++pn) for (int pi = 0; pi < gs; ++pi) { tgu[2 * idx] = t0 + pg * 4 + pi; tgu[2 * idx + 1] = e * 8 + pn; ++idx; } } }
            { int idx = t0 * 4; for (int pg = 0; pg * 8 < mt; ++pg) { const int gs = (mt - pg * 8) < 8 ? (mt - pg * 8) : 8; for (int pn = 0; pn < 4; ++pn) for (int pi = 0; pi < gs; ++pi) { tdn[2 * idx] = t0 + pg * 8 + pi; tdn[2 * idx + 1] = e * 4 + pn; ++idx; } } }
        }
        if (F.tid == 0) { meta[0] = (off[NE] >> 8) * 8; meta[1] = (off[NE] >> 8) * 4; }
    }
    const int* RE = (const int*)(F.ws + WS_RE); const int* RK = (const int*)(F.ws + WS_RK); int* SO = (int*)(F.ws + WS_SO);
    const bf16* H2 = (const bf16*)(F.ws + WS_H2); bf16* XS = (bf16*)(F.ws + WS_XS);
    const int gw = F.vcu * NWAVES + F.wave, NGW = F.G * NWAVES;
    for (int a = gw; a < NAS; a += NGW) {
        const int e = __hip_atomic_load(RE + a, RLX_AGENT), rk = __hip_atomic_load(RK + a, RLX_AGENT), slot = off[e] + rk, tok = a >> 2;
        if (F.lane == 0) SO[a] = slot;
        const GAS v4u* src = (const GAS v4u*)(H2 + (size_t)tok * D); GAS v4u* dst = (GAS v4u*)(XS + (size_t)slot * D);
        const v4u t0 = src[F.lane], t1 = src[64 + F.lane]; dst[F.lane] = t0; dst[64 + F.lane] = t1;
    }
}

__device__ __forceinline__ void ph_combine(Frame& F, const Args& A, int l) {
    const float* XA = (const float*)(F.ws + WS_XA); float* XC = (float*)(F.ws + WS_XC); bf16* XB = (bf16*)(F.ws + WS_XB);
    const bf16* YB = (const bf16*)(F.ws + WS_YB); const int* SO = (const int*)(F.ws + WS_SO); const float* GW = (const float*)(F.ws + WS_GW);
    const int gw = F.vcu * NWAVES + F.wave, NGW = F.G * NWAVES;
    const bool last = (l == DEPTH - 1);
    for (int m = gw; m < M; m += NGW) {
        const GAS f32x4* xr = (const GAS f32x4*)(XA + (size_t)m * D) + F.lane;
        f32x4 v[4];
#pragma unroll
        for (int j = 0; j < 4; ++j) v[j] = xr[64 * j];
#pragma unroll
        for (int k = 0; k < 4; ++k) { const int slot = __hip_atomic_load(SO + m * 4 + k, RLX_AGENT); const float g = __hip_atomic_load(GW + m * 4 + k, RLX_AGENT);
            const GAS v2u* yp = (const GAS v2u*)(YB + (size_t)slot * D) + F.lane;
#pragma unroll
            for (int j = 0; j < 4; ++j) { const v2u w = yp[64 * j]; v[j].x += g * bflo(w.x); v[j].y += g * bfhi(w.x); v[j].z += g * bflo(w.y); v[j].w += g * bfhi(w.y); } }
        float s = 0.f;
#pragma unroll
        for (int j = 0; j < 4; ++j) s += (v[j].x * v[j].x + v[j].y * v[j].y) + (v[j].z * v[j].z + v[j].w * v[j].w);
        const float rs = 1.0f / sqrtf(wave_sum(s) * (1.f / D) + EPS);
        if (!last) {
            GAS f32x4* xo = (GAS f32x4*)(XC + (size_t)m * D) + F.lane; GAS unsigned long long* o8 = (GAS unsigned long long*)(XB + (size_t)m * D) + F.lane;
#pragma unroll
            for (int j = 0; j < 4; ++j) { xo[64 * j] = v[j]; o8[64 * j] = (unsigned long long)pk2(v[j].x * rs, v[j].y * rs) | ((unsigned long long)pk2(v[j].z * rs, v[j].w * rs) << 32); }
        } else {
            GAS f32x4* oo = (GAS f32x4*)(A.out + (size_t)m * D) + F.lane; const GAS f32x4* fw = (const GAS f32x4*)A.in[I_FINW] + F.lane;
#pragma unroll
            for (int j = 0; j < 4; ++j) { const f32x4 w = fw[64 * j]; oo[64 * j] = v[j] * rs * w; }
        }
    }
}
template <class Epi, class Sched>
__device__ __forceinline__ void run_gemm(Frame& F, const pg8::Gemm& g, const Sched& S, const Epi& E) {
#if SIMPLE_KLOOP
    pg8::gemm_phase_simple<Epi, Sched>(g, S, E);
#else
    pg8::gemm_phase<Epi, Sched, true, true>(F.lds + RING_OFF, g, S, E);
#endif
}
__global__ void __launch_bounds__(NWAVES * 64, 2) mk_fwd(Args args) {
    extern __shared__ __attribute__((aligned(16))) unsigned char lds[];
    Frame F;
    F.lds = (LAS unsigned char*)lds;
    F.MISC = (volatile LAS unsigned*)(F.lds + MISC_OFF);
    F.tid = threadIdx.x; F.lane = F.tid & 63; F.wave = __builtin_amdgcn_readfirstlane(F.tid >> 6);
    F.G = gridDim.x; { const int bx = blockIdx.x; F.vcu = (F.G % 8 == 0) ? (bx % 8) * (F.G / 8) + bx / 8 : bx; }
    F.ws = args.ws; F.ctl = (gu32*)(args.ws + WS_CTL);
    for (int u = F.tid; u < (LDS_BYTES - LDSCTL_OFF) / 4; u += NWAVES * 64) ((LAS unsigned*)(F.lds + LDSCTL_OFF))[u] = 0u;
    __syncthreads();
#if N_LAUNCH_MODE == 1
    XcdBarrier bar = xcd_barrier_post((unsigned*)(F.ctl + CW_BAR), F.MISC + 8);
#define GRID_BAR() xcd_barrier(bar)
#else
#define GRID_BAR() do { } while (0)
#endif
    const int lo = args.ph_lo, hi = args.ph_hi;
#define IN(k) (lo <= (k) && (k) < hi)
#define SEAM(k) do { if (IN(k) && IN((k) + 1)) GRID_BAR(); } while (0)

#ifndef PH_MASK
#define PH_MASK 0xfff
#endif
#define PHX(k) (((PH_MASK) >> (k)) & 1)
    if (PHX(11) && IN(0)) { ph_prep(F, args); SEAM(0); }

#define LAUNDER() do { asm volatile("" : "+v"(F.tid)); F.lane = F.tid & 63; F.wave = __builtin_amdgcn_readfirstlane(F.tid >> 6); } while (0)
    for (int l = 0; l < DEPTH; ++l) {
        const int pb = 1 + l * PH_PER_LAYER;
        unsigned char* wb = F.ws + WS_W + (size_t)l * W_STRIDE;
        const float* xres = (l == 0) ? args.in[I_X] : (const float*)(F.ws + WS_XC);
        if (PHX(0) && IN(pb + 0)) {
            pg8::Gemm g{(const bf16*)(F.ws + WS_XB), (const bf16*)(wb + W_IN), M, NPROJ, D}; pg8::StaticOrder S; S.init(M, NPROJ, F.G, (int)blockIdx.x);
            EpiInProj E{(bf16*)(F.ws + WS_P)};
            run_gemm(F, g, S, E);
            SEAM(pb + 0);
        }
        if (PHX(1) && IN(pb + 1)) { LAUNDER();
            for (int u = (int)blockIdx.x; u < 128 + 512; u += F.G) {
                if (u < 128) sgu_chunk(F, args, l, u);
                else { const int grp = u - 128, g = grp >> 4, b = (grp >> 2) & 3, cq = grp & 3; ssm_pass1_item(F, args, l, g, b, cq * 8 + F.wave); }
            }
            SEAM(pb + 1);
        }
        if (PHX(2) && IN(pb + 2)) { LAUNDER();
            for (int grp = (int)blockIdx.x; grp < 512; grp += F.G) { const int g = grp >> 4, b = (grp >> 2) & 3, cq = grp & 3; ssm_pass2_group(F, args, l, g, b, cq); }
            SEAM(pb + 2);
        }
        if (PHX(3) && IN(pb + 3)) {
            pg8::Gemm g{(const bf16*)(F.ws + WS_YG), (const bf16*)(wb + W_GLU), M, DH, DH}; pg8::StaticOrder S; S.init(M, DH, F.G, (int)blockIdx.x);
            EpiGlu E{(const bf16*)(F.ws + WS_YG), (bf16*)(F.ws + WS_MIX), args.in[I_GLUB] + l * DH, (float*)(F.ctl + CW_SS) + (size_t)(l * 2 + 1) * M};
            run_gemm(F, g, S, E);
            SEAM(pb + 3);
        }
        if (PHX(4) && IN(pb + 4)) { LAUNDER(); ph_normb(F, args, l); SEAM(pb + 4); }
        if (PHX(5) && IN(pb + 5)) {
            pg8::Gemm g{(const bf16*)(F.ws + WS_MIX), (const bf16*)(wb + W_OUT), M, D, D}; pg8::StaticOrder S; S.init(M, D, F.G, (int)blockIdx.x);
            EpiResid E{xres, (float*)(F.ws + WS_XA)};
            run_gemm(F, g, S, E);
            SEAM(pb + 5);
        }
        if (PHX(6) && IN(pb + 6)) { LAUNDER(); ph_route(F, args, l); SEAM(pb + 6); }
        if (PHX(7) && IN(pb + 7)) { LAUNDER(); ph_gather(F, args, l); SEAM(pb + 7); }
        if (PHX(8) && IN(pb + 8)) {
            const int n = (int)__hip_atomic_load((const int*)(F.ws + WS_META), RLX_AGENT);
            pg8::Gemm g{(const bf16*)(F.ws + WS_XS), (const bf16*)(wb + W_GU), SLOTS, NE * 2048, D}; TableOrder S{(const int*)(F.ws + WS_TGU), n, F.G, (int)blockIdx.x};
            EpiSwiglu E{(bf16*)(F.ws + WS_ACT), args.in[I_BGU] + (size_t)l * NE * 2048};
            run_gemm(F, g, S, E);
            SEAM(pb + 8);
        }
        if (PHX(9) && IN(pb + 9)) {
            const int n = (int)__hip_atomic_load((const int*)(F.ws + WS_META) + 1, RLX_AGENT);
            pg8::Gemm g{(const bf16*)(F.ws + WS_ACT), (const bf16*)(wb + W_DN), SLOTS, NE * D, D}; TableOrder S{(const int*)(F.ws + WS_TDN), n, F.G, (int)blockIdx.x};
            EpiDown E{(bf16*)(F.ws + WS_YB), args.in[I_BDN] + (size_t)l * NE * D};
            run_gemm(F, g, S, E);
            SEAM(pb + 9);
        }
        if (PHX(10) && IN(pb + 10)) { LAUNDER(); ph_combine(F, args, l); SEAM(pb + 10); }
    }
#undef IN
#undef SEAM
}

extern "C" void kernel_launch(void* const* d_in, const int* in_sizes, int n_in, void* d_out, int out_size, void* d_ws, size_t ws_size, hipStream_t stream) {
    static int grid = 0;
    if (grid == 0) {
        if (n_in != 28 || in_sizes[0] != M * D || out_size != M * D || ws_size < WS_END) { fprintf(stderr, "kernel_launch: unexpected shapes (n_in %d, in0 %d, out %d, ws %zu < %zu); nothing launched\n", n_in, n_in > 0 ? in_sizes[0] : -1, out_size, ws_size, (size_t)WS_END); grid = -1; return; }
        int dev = 0, cus = 0, per_cu = 0;
        if (hipGetDevice(&dev) != hipSuccess || hipDeviceGetAttribute(&cus, hipDeviceAttributeMultiprocessorCount, dev) != hipSuccess) { grid = -1; return; }
        if (hipFuncSetAttribute((const void*)mk_fwd, hipFuncAttributeMaxDynamicSharedMemorySize, LDS_BYTES) != hipSuccess) { fprintf(stderr, "kernel_launch: hipFuncSetAttribute failed\n"); grid = -1; return; }
        if (hipOccupancyMaxActiveBlocksPerMultiprocessor(&per_cu, (const void*)mk_fwd, NWAVES * 64, LDS_BYTES) != hipSuccess || per_cu < 1) { fprintf(stderr, "kernel_launch: occupancy query reports %d workgroups per CU\n", per_cu); }
        (void)hipGetLastError();
        grid = cus;
        if (grid % 8 != 0 || grid < 8) { fprintf(stderr, "kernel_launch: %d CUs: unsupported\n", grid); grid = -1; return; }
    }
    if (grid < 0) return;
    if (hipMemsetAsync((char*)d_ws + WS_CTL, 0, CTL_ZERO_BYTES, stream) != hipSuccess) return;
    Args a{};
    for (int i = 0; i < 28; ++i) a.in[i] = (const float*)d_in[i];
    a.out = (float*)d_out; a.ws = (unsigned char*)d_ws;
#if N_LAUNCH_MODE == 1
    a.ph_lo = 0; a.ph_hi = N_PHASES;
    hipLaunchKernelGGL(mk_fwd, dim3(grid), dim3(NWAVES * 64), LDS_BYTES, stream, a);
#else
    for (int p = 0; p < N_PHASES; ++p) { a.ph_lo = p; a.ph_hi = p + 1; hipLaunchKernelGGL(mk_fwd, dim3(grid), dim3(NWAVES * 64), LDS_BYTES, stream, a); }
#endif
}
```

```cpp
#include <hip/hip_runtime.h>
#include <cstdio>
#include <cstdint>
#ifndef N_LAUNCH_MODE
#define N_LAUNCH_MODE 1
#endif
namespace pg8 {
#define PG8_LAS __attribute__((address_space(3)))
typedef unsigned short bf16_t;
typedef short bf16x8 __attribute__((ext_vector_type(8)));
typedef float f32x4 __attribute__((ext_vector_type(4)));
typedef unsigned u32x4 __attribute__((ext_vector_type(4)));
constexpr int BM = 256, BK = 64, HALF = 128, HTB = HALF * BK * 2  , STAGE_BYTES = 8 * HTB, NXCD = 8, WGM = 8;

__host__ __device__ __forceinline__ int lds_byte(int r, int c) { const int st = (r >> 4) * 2 + (c >> 5), rr = r & 15, cc = c & 31, ob = rr * 64 + cc * 2; return st * 1024 + (ob ^ (((ob >> 9) & 1) << 5)); }
__host__ __device__ __forceinline__ void stage_rc(int b, int& R, int& C) { const int st = b / 1024, sb = b % 1024, swz = sb ^ (((sb >> 9) & 1) << 5); R = (st >> 1) * 16 + swz / 64; C = (st & 1) * 32 + (swz % 64) / 2; }
__host__ __device__ __forceinline__ int perm32(int rho) { const int n = rho >> 4, i = rho & 15; return 8 * (i >> 2) + 4 * n + (i & 3); }

struct Unit { int pm, pn, li; };
struct Gemm { const bf16_t* A; const bf16_t* Bt; int M, N, K; };

struct StaticOrder {
    static constexpr bool GATHER = false;
    int nM, nN, nwg, G, c;
    __host__ __device__ void init(int M, int N, int G_, int c_) { nM = M / BM; nN = N / BM; nwg = nM * nN; G = G_; c = c_; }
    __host__ __device__ bool next(int i, Unit& u) const {
        const long L = (long)i * G + c; if (L >= nwg) return false;
        int wgid = (int)L; { const int q = nwg / NXCD, r = nwg % NXCD, xcd = wgid % NXCD, off = wgid / NXCD; wgid = (xcd < r ? xcd * (q + 1) : r * (q + 1) + (xcd - r) * q) + off; }
        const int nig = WGM * nN, gid = wgid / nig, fm = gid * WGM, gsz = (nM - fm) < WGM ? (nM - fm) : WGM;
        u.pm = fm + ((wgid % nig) % gsz); u.pn = (wgid % nig) / gsz; u.li = i; return true;
    }
    __device__ __forceinline__ void a_ready(const Unit&) const {}
    __device__ __forceinline__ void done(const Unit&) const {}
};

typedef __bf16 bf16x2_t __attribute__((ext_vector_type(2)));
typedef float f32x2c_t __attribute__((ext_vector_type(2)));
__device__ __forceinline__ unsigned cvt_pk_bf16(float lo, float hi) { const bf16x2_t r = __builtin_convertvector((f32x2c_t){lo, hi}, bf16x2_t); unsigned u = __builtin_bit_cast(unsigned, r); asm volatile("s_nop 1" : "+v"(u)); return u; }
__device__ __forceinline__ unsigned cvt_pk_bf16_raw(float lo, float hi) { const bf16x2_t r = __builtin_convertvector((f32x2c_t){lo, hi}, bf16x2_t); return __builtin_bit_cast(unsigned, r); }
template <class Epi, class Sched, bool ALIGN_EPI = true>
__device__ __forceinline__ void gemm_phase(PG8_LAS unsigned char* lds, const Gemm g, const Sched& S, const Epi& E) {
    int tid_ = threadIdx.x; asm volatile("" : "+v"(tid_));
    const int tid = tid_, wid = __builtin_amdgcn_readfirstlane(tid >> 6), lane = tid & 63, wr = wid >> 2, wc = wid & 3, fr = lane & 15, fq = lane >> 4;
    const int K = g.K, nt = K / BK;
    int RA[2]; unsigned cofA[2], voffB[2];
#pragma unroll
    for (int i = 0; i < 2; ++i) { int R, C; stage_rc(tid * 16 + i * 8192, R, C); const int Rb = Epi::PERM ? ((R & ~31) + perm32(R & 31)) : R;
        RA[i] = R; cofA[i] = (unsigned)C * 2u; voffB[i] = (unsigned)(Rb * K + C) * 2u; }
    const size_t kstep = (size_t)(BK * 2);
    const size_t hstep = (size_t)HALF * K * 2;
    const size_t tstep = 2 * hstep;
    const unsigned ldsw = (unsigned)wid * 1024u;
    const int aoff = lds_byte(wr * 64 + fr, fq * 8), boff = lds_byte(wc * 32 + fr, fq * 8);
    const char* gA = (const char*)g.A;
#define PG8_AOFF(dst, u) do { _Pragma("unroll") for (int _h = 0; _h < 2; ++_h) _Pragma("unroll") for (int _i = 0; _i < 2; ++_i) { \
        if constexpr (Sched::GATHER) dst[_h][_i] = S.arow((u), _h * HALF + RA[_i]) + cofA[_i]; \
        else dst[_h][_i] = (unsigned)(((u).pm * BM + _h * HALF + RA[_i]) * K) * 2u + cofA[_i]; } } while (0)
#define PG8_SA(b, h) (((b) * 2 + (h)) * HTB)
#define PG8_SB(b, h) ((4 + (b) * 2 + (h)) * HTB)
#define PG8_STAGE(bufoff, gbase, voff) do { _Pragma("unroll") for (int _i = 0; _i < 2; ++_i) \
        __builtin_amdgcn_global_load_lds((const unsigned*)((const char*)(gbase) + (voff)[_i]), (PG8_LAS unsigned*)(lds + (bufoff) + ldsw + _i * 8192), 16, 0, 0); } while (0)
#define PG8_LDA(dst, b, h) do { _Pragma("unroll") for (int m = 0; m < 4; ++m) _Pragma("unroll") for (int k = 0; k < 2; ++k) dst[m][k] = *(const PG8_LAS bf16x8*)(lds + PG8_SA(b, h) + aoff + m * 2048 + k * 1024); } while (0)
#define PG8_LDB(dst, b, h) do { _Pragma("unroll") for (int n = 0; n < 2; ++n) _Pragma("unroll") for (int k = 0; k < 2; ++k) dst[n][k] = *(const PG8_LAS bf16x8*)(lds + PG8_SB(b, h) + boff + n * 2048 + k * 1024); } while (0)
#define PG8_MMA(ai, bj, At, Bt) do { __builtin_amdgcn_s_setprio(1); _Pragma("unroll") for (int m = 0; m < 4; ++m) _Pragma("unroll") for (int n = 0; n < 2; ++n) _Pragma("unroll") for (int k = 0; k < 2; ++k) \
        acc[ai][bj][m][n] = __builtin_amdgcn_mfma_f32_16x16x32_bf16(Bt[n][k], At[m][k], acc[ai][bj][m][n], 0, 0, 0); __builtin_amdgcn_s_setprio(0); } while (0)
#define PG8_WAIT_V(n) asm volatile("s_waitcnt vmcnt(" #n ")" ::: "memory")
#define PG8_WAIT_L(n) asm volatile("s_waitcnt lgkmcnt(" #n ")" ::: "memory")
#define PG8_BAR __builtin_amdgcn_s_barrier()
#define PG8_SCHED __builtin_amdgcn_sched_barrier(0)
    Unit cur, nxt; int ui = 0;
    if (!S.next(0, cur)) return;
    f32x4 acc[2][2][4][2];
#pragma unroll
    for (int a = 0; a < 2; ++a)
#pragma unroll
        for (int b = 0; b < 2; ++b)
#pragma unroll
            for (int m = 0; m < 4; ++m)
#pragma unroll
                for (int n = 0; n < 2; ++n) acc[a][b][m][n] = (f32x4){0.f, 0.f, 0.f, 0.f};
    bf16x8 At[4][2], B0[2][2], B1[2][2];
    unsigned oC[2][2], oN[2][2];
    PG8_AOFF(oC, cur);
    const char* cB = (const char*)g.Bt + (size_t)cur.pn * tstep;
    S.a_ready(cur);
    PG8_STAGE(PG8_SB(0, 0), cB, voffB); PG8_STAGE(PG8_SB(0, 1), cB + hstep, voffB); PG8_STAGE(PG8_SA(0, 0), gA, oC[0]); PG8_STAGE(PG8_SA(0, 1), gA, oC[1]);
    if (wr == 1) PG8_BAR;
    PG8_WAIT_V(2); PG8_BAR;
    PG8_STAGE(PG8_SB(1, 0), cB + kstep, voffB); PG8_STAGE(PG8_SA(1, 0), gA + kstep, oC[0]); PG8_STAGE(PG8_SB(1, 1), cB + hstep + kstep, voffB);
    PG8_WAIT_V(6); PG8_BAR;
    for (;;) {
        const bool has_next = S.next(ui + 1, nxt);
        if (has_next) PG8_AOFF(oN, nxt);
        else {
#pragma unroll
            for (int _h = 0; _h < 2; ++_h)
#pragma unroll
                for (int _i = 0; _i < 2; ++_i) oN[_h][_i] = oC[_h][_i]; }
        const char* nB = has_next ? (const char*)g.Bt + (size_t)nxt.pn * tstep : cB;
        for (int t = 0; t < nt; t += 2) {
            const bool last = (t == nt - 2);
            if constexpr (Epi::MIDK) { if (t == (nt >> 1)) E.midk(acc, cur, wr, wc, fr, fq); }
            const char* a1 = gA + (size_t)(t + 1) * kstep;
            const char* a2 = last ? gA : gA + (size_t)(t + 2) * kstep; const char* b2 = last ? nB : cB + (size_t)(t + 2) * kstep;
            const char* a3 = a2 + kstep; const char* b3 = b2 + kstep;
            unsigned o2[2][2];
#pragma unroll
            for (int _h = 0; _h < 2; ++_h)
#pragma unroll
                for (int _i = 0; _i < 2; ++_i) o2[_h][_i] = last ? oN[_h][_i] : oC[_h][_i];
            if (last && has_next) S.a_ready(nxt);
            PG8_LDB(B0, 0, 0); PG8_LDB(B1, 0, 1); PG8_SCHED; PG8_LDA(At, 0, 0); PG8_STAGE(PG8_SA(1, 1), a1, oC[1]);
            PG8_WAIT_V(8); PG8_WAIT_L(0); PG8_BAR; PG8_MMA(0, 0, At, B0); PG8_MMA(0, 1, At, B1); PG8_BAR; PG8_SCHED;
            PG8_LDA(At, 0, 1); PG8_STAGE(PG8_SB(0, 0), b2, voffB); PG8_STAGE(PG8_SB(0, 1), b2 + hstep, voffB); PG8_STAGE(PG8_SA(0, 0), a2, o2[0]);
            PG8_WAIT_V(8); PG8_WAIT_L(0); PG8_BAR; PG8_MMA(1, 0, At, B0); PG8_MMA(1, 1, At, B1); PG8_BAR; PG8_SCHED;
            PG8_LDB(B0, 1, 0); PG8_LDB(B1, 1, 1); PG8_SCHED; PG8_LDA(At, 1, 0); PG8_STAGE(PG8_SA(0, 1), a2, o2[1]);
            PG8_WAIT_V(8); PG8_WAIT_L(0); PG8_BAR; PG8_MMA(0, 0, At, B0); PG8_MMA(0, 1, At, B1); PG8_BAR; PG8_SCHED;
            PG8_LDA(At, 1, 1); PG8_STAGE(PG8_SB(1, 0), b3, voffB); PG8_STAGE(PG8_SB(1, 1), b3 + hstep, voffB); PG8_STAGE(PG8_SA(1, 0), a3, o2[0]);
            PG8_WAIT_V(8); PG8_WAIT_L(0); PG8_BAR; PG8_MMA(1, 0, At, B0); PG8_MMA(1, 1, At, B1); PG8_BAR; PG8_SCHED;
        }
        if constexpr (ALIGN_EPI) { if (wr == 0) PG8_BAR; }
        E(acc, cur, wr, wc, fr, fq); S.done(cur);
        if (!has_next) break;
#pragma unroll
        for (int a = 0; a < 2; ++a)
#pragma unroll
            for (int b = 0; b < 2; ++b)
#pragma unroll
                for (int m = 0; m < 4; ++m)
#pragma unroll
                    for (int n = 0; n < 2; ++n) acc[a][b][m][n] = (f32x4){0.f, 0.f, 0.f, 0.f};
        cur = nxt; cB = nB; ++ui;
#pragma unroll
        for (int _h = 0; _h < 2; ++_h)
#pragma unroll
            for (int _i = 0; _i < 2; ++_i) oC[_h][_i] = oN[_h][_i];
        if constexpr (ALIGN_EPI) { if (wr == 1) PG8_BAR; }
    }
    PG8_WAIT_V(0);
    if constexpr (!ALIGN_EPI) { if (wr == 0) PG8_BAR; }
    PG8_BAR;
#undef PG8_AOFF
#undef PG8_SA
#undef PG8_SB
#undef PG8_STAGE
#undef PG8_LDA
#undef PG8_LDB
#undef PG8_MMA
#undef PG8_WAIT_V
#undef PG8_WAIT_L
#undef PG8_BAR
#undef PG8_SCHED
}
}
#define GAS __attribute__((address_space(1)))
#define LAS __attribute__((address_space(3)))
typedef unsigned short bf16;
typedef unsigned v4u __attribute__((ext_vector_type(4)));
typedef float f32x4 __attribute__((ext_vector_type(4)));
typedef short bf16x8 __attribute__((ext_vector_type(8)));
typedef GAS unsigned gu32;
typedef GAS unsigned long long gu64;
#define RLX_AGENT __ATOMIC_RELAXED, __HIP_MEMORY_SCOPE_AGENT
#define LDS_WAIT() asm volatile("s_waitcnt lgkmcnt(0)" ::: "memory")
#define VM_WAIT() asm volatile("s_waitcnt vmcnt(0)" ::: "memory")
__device__ __forceinline__ unsigned long long rt() { return __builtin_amdgcn_s_memrealtime(); }
__device__ __forceinline__ unsigned f2bf(float f) { unsigned u = __builtin_bit_cast(unsigned, f); return (u + 0x7fffu + ((u >> 16) & 1u)) >> 16; }
__device__ __forceinline__ unsigned pk2(float lo, float hi) { return f2bf(lo) | (f2bf(hi) << 16); }

#define XB_TMO      128
#define XB_XCNT(j)  (256  + 64 * (j))
#define XB_XSUB(j)  (1280 + 64 * (j))
#define XB_XGEN(j)  (2304 + 64 * (j))
#define XB_TOP      3328
#define XB_TOPGEN   3392
#define XCD_BAR_WORDS 3456
#define XB_SPIN_CAP (1u << 18)

__device__ __forceinline__ unsigned xb_ld(unsigned* p)              { return __hip_atomic_load(p, __ATOMIC_RELAXED, __HIP_MEMORY_SCOPE_AGENT); }
__device__ __forceinline__ unsigned xb_add(unsigned* p, unsigned v) { return __hip_atomic_fetch_add(p, v, __ATOMIC_RELAXED, __HIP_MEMORY_SCOPE_AGENT); }
__device__ __forceinline__ unsigned xb_xcc_id() { return (unsigned)__builtin_amdgcn_s_getreg((3 << 11) | 20) & 0xFu; }
#define XB_SPIN(cond, bar) do { unsigned _sp = 0; while (cond) { __builtin_amdgcn_s_sleep(1); \
    if ((++_sp & 255u) == 0u) { if (xb_ld(&(bar)[XB_TMO])) break; if (_sp > XB_SPIN_CAP) { atomicAdd(&(bar)[XB_TMO], 1u); break; } } } } while (0)

struct XcdBarrier {
    unsigned* bar; unsigned x;
    volatile LAS unsigned* st;
};

__device__ __forceinline__ XcdBarrier xcd_barrier_post(unsigned* bar, volatile LAS unsigned* st) {
    XcdBarrier b; b.bar = bar; b.x = xb_xcc_id(); b.st = st;
    if (threadIdx.x == 0) (void)xb_add(&bar[XB_XCNT(b.x)], 1u);
    return b;
}
__device__ __forceinline__ void xcd_barrier_complete(unsigned* bar, unsigned x, unsigned& nloc, unsigned& nx) {
    const unsigned G = gridDim.x * gridDim.y * gridDim.z;
    unsigned sum, cnt, mine, sp = 0u;
    for (;;) {
        sum = 0u; cnt = 0u; mine = 0u;
#pragma unroll
        for (unsigned j = 0; j < 16; ++j) { const unsigned c = xb_ld(&bar[XB_XCNT(j)]); sum += c; cnt += (c > 0u) ? 1u : 0u; mine = (j == x) ? c : mine; }
        if (sum == G) break;
        __builtin_amdgcn_s_sleep(1);
        if ((++sp & 255u) == 0u) { if (xb_ld(&bar[XB_TMO])) break; if (sp > XB_SPIN_CAP) { atomicAdd(&bar[XB_TMO], 1u); break; } }
    }
    nloc = mine > 0u ? mine : 1u; nx = cnt > 0u ? cnt : 1u;
}

__device__ __forceinline__ void xcd_barrier(const XcdBarrier& b) {
    asm volatile("s_waitcnt vmcnt(0)" ::: "memory");
    __syncthreads();
    if (threadIdx.x == 0) {
        unsigned* bar = b.bar;
        __builtin_amdgcn_s_waitcnt(0);
        unsigned nloc = b.st[0], nx = b.st[1];
        if (nloc == 0u) { xcd_barrier_complete(bar, b.x, nloc, nx); b.st[0] = nloc; b.st[1] = nx; }
        const unsigned old = xb_add(&bar[XB_XSUB(b.x)], 1u);
        const unsigned gen = old / nloc;
        if (old + 1u == (gen + 1u) * nloc) {
            __builtin_amdgcn_fence(__ATOMIC_RELEASE, "agent");
            asm volatile("s_waitcnt vmcnt(0)" ::: "memory");
            const unsigned og = xb_add(&bar[XB_TOP], 1u);
            const unsigned tg = og / nx;
            if (og + 1u == (tg + 1u) * nx) xb_add(&bar[XB_TOPGEN], 1u);
            else XB_SPIN(xb_ld(&bar[XB_TOPGEN]) == tg, bar);
            __builtin_amdgcn_fence(__ATOMIC_ACQUIRE, "agent");
            xb_add(&bar[XB_XGEN(b.x)], 1u);
            asm volatile("s_waitcnt vmcnt(0)" ::: "memory");
        } else {
            XB_SPIN(xb_ld(&bar[XB_XGEN(b.x)]) == gen, bar);
            __builtin_amdgcn_fence(__ATOMIC_ACQUIRE, "agent");
            asm volatile("s_waitcnt vmcnt(0)" ::: "memory");
        }
    }
    __syncthreads();
}
constexpr int M = 16384, D = 1024, DH = 512, NPROJ = 1536, NE = 32, TOPK = 4, NAS = M * TOPK, SLOTS = NAS + NE * 256, SEQ = 4096, NBATCH = 4, NCH = 32, NG = 32, NP = 64, DEPTH = 2;
constexpr float EPS = 1e-5f;
constexpr int NWAVES = 8;
constexpr size_t MiB = 1u << 20;
constexpr size_t WS_CTL = 0, CTL_ZERO_BYTES = 512 * 1024;
constexpr int CW_BAR = 1024;
constexpr int CW_Q = 6144;
constexpr int CW_CNT = 8192;
constexpr int CW_SS = 16384;
static_assert((CW_SS + DEPTH * 2 * M) * 4 <= (int)CTL_ZERO_BYTES, "CTL words inside the memset region");
constexpr size_t WS_RE = 1 * MiB;
constexpr size_t WS_RK = WS_RE + (size_t)NAS * 4;
constexpr size_t WS_GW = WS_RK + (size_t)NAS * 4;
constexpr size_t WS_SO = WS_GW + (size_t)NAS * 4;
constexpr size_t WS_TGU = WS_SO + (size_t)NAS * 4;
constexpr size_t WS_TDN = WS_TGU + 288 * 8 * 8;
constexpr size_t WS_META = WS_TDN + 288 * 4 * 8;
constexpr size_t WS_SSMP = 3 * MiB;
constexpr size_t SSMP_ABAR = 0, SSMP_A128 = 16384, SSMP_BBAR = 32768, SSMP_CTAB = SSMP_BBAR + 262144, SSMP_STRIDE = SSMP_CTAB + 262144;
constexpr size_t WS_BB16 = 5 * MiB;
constexpr size_t WS_CT16 = WS_BB16 + 512 * 1024;
constexpr size_t WS_RWT = 6 * MiB + 512 * 1024;
constexpr size_t WS_RSI = 7 * MiB;
constexpr size_t WS_WM = 6 * MiB;
static_assert(WS_META + 256 <= WS_SSMP && WS_SSMP + DEPTH * SSMP_STRIDE <= WS_BB16 && WS_WM + DEPTH * 4 * 128 * 128 * 2 <= 8 * MiB, "small tables");
constexpr size_t WS_W = 8 * MiB, W_IN = 0, W_OUT = 3 * MiB, W_GLU = 5 * MiB, W_GU = 6 * MiB, W_DN = 134 * MiB, W_STRIDE = 198 * MiB;
constexpr size_t WS_XB = WS_W + DEPTH * W_STRIDE;
constexpr size_t WS_P = WS_XB + 32 * MiB;
constexpr size_t WS_YG = WS_P + 48 * MiB;
constexpr size_t WS_MIX = WS_YG + 16 * MiB;
constexpr size_t WS_XA = WS_MIX + 32 * MiB;
constexpr size_t WS_XC = WS_XA + 64 * MiB;
constexpr size_t WS_H2 = WS_XC + 64 * MiB;
constexpr size_t WS_XS = WS_H2 + 32 * MiB;
constexpr size_t WS_ACT = WS_XS + 144 * MiB;
constexpr size_t WS_YB = WS_ACT + 144 * MiB;
constexpr size_t WS_EST = WS_YB + 144 * MiB;
constexpr size_t WS_SSP = WS_EST + 2 * MiB;
constexpr size_t WS_END = WS_SSP + 1 * MiB;
static_assert((size_t)SLOTS * D * 2 == 144 * MiB, "slot buffers");
constexpr int RING_OFF = 0, RING_BYTES = 131072;
constexpr int TAB_OFF = 131072;
constexpr int LDSCTL_OFF = 151552, MISC_OFF = LDSCTL_OFF + 6144;
constexpr int LDS_BYTES = 159744;
static_assert(MISC_OFF + 128 <= LDS_BYTES, "LDS map");
constexpr int PH_PER_LAYER = 10, N_PHASES = 1 + DEPTH * PH_PER_LAYER;
__device__ __forceinline__ float wave_sum(float v) {
#pragma unroll
    for (int o = 1; o < 64; o <<= 1) v += __shfl_xor(v, o);
    return v;
}
__device__ __forceinline__ float fast_sigmoid(float x) { return __builtin_amdgcn_rcpf(1.0f + __builtin_amdgcn_exp2f(-1.4426950409f * x)); }
__device__ __forceinline__ float gelu_tanh(float x) { const float u = x * (1.5957691216f + 0.0713548163f * x * x); return x * fast_sigmoid(u); }
__device__ __forceinline__ float bf2f(unsigned short b) { return __builtin_bit_cast(float, (unsigned)b << 16); }
__device__ __forceinline__ float bflo(unsigned w) { return __builtin_bit_cast(float, w << 16); }
__device__ __forceinline__ float bfhi(unsigned w) { return __builtin_bit_cast(float, w & 0xffff0000u); }
typedef unsigned v2u __attribute__((ext_vector_type(2)));
typedef float f32x2_t __attribute__((ext_vector_type(2)));

struct EpiInProj {
    static constexpr bool PERM = true, MIDK = false;
    bf16* P; const float* rs;
    __device__ __forceinline__ void operator()(const pg8::f32x4 (&acc)[2][2][4][2], const pg8::Unit& u, int wr, int wc, int fr, int fq) const {
        const int t = u.pn >> 1; const bool act = t < 2;
        bf16* base = P + (size_t)t * M * DH;
        const int row0 = u.pm * 256 + wr * 64 + fr, col0 = (u.pn & 1) * 256 + wc * 32 + 8 * fq;
#pragma unroll
        for (int ai = 0; ai < 2; ++ai)
#pragma unroll
            for (int m = 0; m < 4; ++m) { bf16* rowp = base + (size_t)(row0 + ai * 128 + m * 16) * DH + col0; const float rsv = rs[row0 + ai * 128 + m * 16];
#pragma unroll
                for (int bj = 0; bj < 2; ++bj) { pg8::f32x4 v0 = acc[ai][bj][m][0] * rsv, v1 = acc[ai][bj][m][1] * rsv;
                    if (act) {
#pragma unroll
                        for (int j = 0; j < 4; ++j) { v0[j] = gelu_tanh(v0[j]); v1[j] = gelu_tanh(v1[j]); } }
                    v4u w; w.x = pg8::cvt_pk_bf16(v0[0], v0[1]); w.y = pg8::cvt_pk_bf16(v0[2], v0[3]); w.z = pg8::cvt_pk_bf16(v1[0], v1[1]); w.w = pg8::cvt_pk_bf16(v1[2], v1[3]);
                    *(v4u*)(rowp + bj * 128) = w; } }
    }
};
struct EpiGlu {
    static constexpr bool PERM = true, MIDK = false;
    const bf16* YG; bf16* MIX; const float* bias; float* ss;
    __device__ __forceinline__ void operator()(const pg8::f32x4 (&acc)[2][2][4][2], const pg8::Unit& u, int wr, int wc, int fr, int fq) const {
        const int row0 = u.pm * 256 + wr * 64 + fr, col0 = u.pn * 256 + wc * 32 + 8 * fq;
        pg8::f32x4 bv[2][2];
#pragma unroll
        for (int bj = 0; bj < 2; ++bj)
#pragma unroll
            for (int n = 0; n < 2; ++n) bv[bj][n] = *(const pg8::f32x4*)(bias + col0 + bj * 128 + 4 * n);
#pragma unroll
        for (int ai = 0; ai < 2; ++ai)
#pragma unroll
            for (int m = 0; m < 4; ++m) { const int row = row0 + ai * 128 + m * 16; float sq = 0.f;
#pragma unroll
                for (int bj = 0; bj < 2; ++bj) { const int col = col0 + bj * 128;
                    const v4u yw = *(const v4u*)(YG + (size_t)row * DH + col);
                    const pg8::f32x4 g0 = acc[ai][bj][m][0] + bv[bj][0], g1 = acc[ai][bj][m][1] + bv[bj][1];
                    float o[8];
                    o[0] = bflo(yw.x) * fast_sigmoid(g0[0]); o[1] = bfhi(yw.x) * fast_sigmoid(g0[1]); o[2] = bflo(yw.y) * fast_sigmoid(g0[2]); o[3] = bfhi(yw.y) * fast_sigmoid(g0[3]);
                    o[4] = bflo(yw.z) * fast_sigmoid(g1[0]); o[5] = bfhi(yw.z) * fast_sigmoid(g1[1]); o[6] = bflo(yw.w) * fast_sigmoid(g1[2]); o[7] = bfhi(yw.w) * fast_sigmoid(g1[3]);
#pragma unroll
                    for (int j = 0; j < 8; ++j) sq += o[j] * o[j];
                    v4u w; w.x = pg8::cvt_pk_bf16(o[0], o[1]); w.y = pg8::cvt_pk_bf16(o[2], o[3]); w.z = pg8::cvt_pk_bf16(o[4], o[5]); w.w = pg8::cvt_pk_bf16(o[6], o[7]);
                    *(v4u*)(MIX + (size_t)row * D + DH + col) = w; }
                sq += __shfl_xor(sq, 16); sq += __shfl_xor(sq, 32);
                if (fq == 0) ss[(size_t)row * 8 + u.pn * 4 + wc] = sq; }
    }
};
struct EpiResid {
    static constexpr bool PERM = true, MIDK = false;
    const bf16* resid; bf16* out;
    __device__ __forceinline__ void operator()(const pg8::f32x4 (&acc)[2][2][4][2], const pg8::Unit& u, int wr, int wc, int fr, int fq) const {
        const int row0 = u.pm * 256 + wr * 64 + fr, col0 = u.pn * 256 + wc * 32 + 8 * fq;
#pragma unroll
        for (int ai = 0; ai < 2; ++ai)
#pragma unroll
            for (int m = 0; m < 4; ++m) { const size_t off = (size_t)(row0 + ai * 128 + m * 16) * D + col0;
#pragma unroll
                for (int bj = 0; bj < 2; ++bj) { const v4u r = *(const v4u*)(resid + off + bj * 128); const pg8::f32x4 a0 = acc[ai][bj][m][0], a1 = acc[ai][bj][m][1];
                    v4u w; w.x = pg8::cvt_pk_bf16(bflo(r.x) + a0[0], bfhi(r.x) + a0[1]); w.y = pg8::cvt_pk_bf16(bflo(r.y) + a0[2], bfhi(r.y) + a0[3]);
                    w.z = pg8::cvt_pk_bf16(bflo(r.z) + a1[0], bfhi(r.z) + a1[1]); w.w = pg8::cvt_pk_bf16(bflo(r.w) + a1[2], bfhi(r.w) + a1[3]);
                    *(v4u*)(out + off + bj * 128) = w; } }
    }
};
struct EpiSwiglu {
    static constexpr bool PERM = true, MIDK = false;
    bf16* ACT; const float* bgu;
    __device__ __forceinline__ void operator()(const pg8::f32x4 (&acc)[2][2][4][2], const pg8::Unit& u, int wr, int wc, int fr, int fq) const {
        const int e = u.pn >> 3, pn = u.pn & 7;
        const int row0 = u.pm * 256 + wr * 64 + fr, col0 = pn * 128 + wc * 32 + 8 * fq;
        const float* bg = bgu + (size_t)e * 2048 + col0;
        pg8::f32x4 bgl[2], bli[2];
#pragma unroll
        for (int n = 0; n < 2; ++n) { bgl[n] = *(const pg8::f32x4*)(bg + 4 * n); bli[n] = *(const pg8::f32x4*)(bg + 1024 + 4 * n); }
#pragma unroll
        for (int ai = 0; ai < 2; ++ai)
#pragma unroll
            for (int m = 0; m < 4; ++m) { float o[8];
#pragma unroll
                for (int n = 0; n < 2; ++n)
#pragma unroll
                    for (int j = 0; j < 4; ++j) { float gl = acc[ai][0][m][n][j] + bgl[n][j], li = acc[ai][1][m][n][j] + bli[n][j];
                        gl = fminf(gl, 7.0f); li = fminf(fmaxf(li, -7.0f), 7.0f);
                        o[4 * n + j] = gl * fast_sigmoid(1.702f * gl) * (li + 1.0f); }
                v4u w; w.x = pg8::cvt_pk_bf16(o[0], o[1]); w.y = pg8::cvt_pk_bf16(o[2], o[3]); w.z = pg8::cvt_pk_bf16(o[4], o[5]); w.w = pg8::cvt_pk_bf16(o[6], o[7]);
                *(v4u*)(ACT + (size_t)(row0 + ai * 128 + m * 16) * D + col0) = w; }
    }
};
struct EpiDown {
    static constexpr bool PERM = true, MIDK = false;
    bf16* YB; const float* bdn;
    __device__ __forceinline__ void operator()(const pg8::f32x4 (&acc)[2][2][4][2], const pg8::Unit& u, int wr, int wc, int fr, int fq) const {
        const int e = u.pn >> 2, pn = u.pn & 3;
        const int row0 = u.pm * 256 + wr * 64 + fr, col0 = pn * 256 + wc * 32 + 8 * fq;
        const float* bb = bdn + (size_t)e * D + col0;
        pg8::f32x4 bv[2][2];
#pragma unroll
        for (int bj = 0; bj < 2; ++bj)
#pragma unroll
            for (int n = 0; n < 2; ++n) bv[bj][n] = *(const pg8::f32x4*)(bb + bj * 128 + 4 * n);
#pragma unroll
        for (int ai = 0; ai < 2; ++ai)
#pragma unroll
            for (int m = 0; m < 4; ++m) { bf16* rowp = YB + (size_t)(row0 + ai * 128 + m * 16) * D + col0;
#pragma unroll
                for (int bj = 0; bj < 2; ++bj) { const pg8::f32x4 v0 = acc[ai][bj][m][0] + bv[bj][0], v1 = acc[ai][bj][m][1] + bv[bj][1];
                    v4u w; w.x = pg8::cvt_pk_bf16(v0[0], v0[1]); w.y = pg8::cvt_pk_bf16(v0[2], v0[3]); w.z = pg8::cvt_pk_bf16(v1[0], v1[1]); w.w = pg8::cvt_pk_bf16(v1[2], v1[3]);
                    *(v4u*)(rowp + bj * 128) = w; } }
    }
};
template <bool GATHER_>
struct LdsOrder {
    static constexpr bool GATHER = GATHER_;
    const LAS unsigned* tab; int n, G, c;
    const LAS int* offL; const LAS int* cntL; const int* tok; const LAS unsigned* rows;
    __device__ __forceinline__ bool next(int i, pg8::Unit& u) const {
        const int per = G >> 3, L = (i * 8 + (c & 7)) * per + (c >> 3);
        if (L >= n) return false;
        const unsigned e = (unsigned)__builtin_amdgcn_readfirstlane((int)tab[L]);
        u.pm = (int)(e & 0xfffu); u.pn = (int)(e >> 12); u.li = i;
        return true;
    }
    __device__ __forceinline__ unsigned arow(const pg8::Unit& u, int r) const { return rows[u.li * 256 + r]; }
    __device__ __forceinline__ void fill_rows(LAS unsigned* rw, int tid) const {
        pg8::Unit u;
        for (int i = 0; i < 10 && next(i, u); ++i)
            for (int r = tid; r < 256; r += NWAVES * 64) { const int e = u.pn >> 3, rank = u.pm * 256 + r - offL[e], cn = cntL[e], idx = rank < cn ? rank : cn - 1;
                rw[i * 256 + r] = (unsigned)tok[e * NAS + idx] * (unsigned)(D * 2); }
    }
    __device__ __forceinline__ void a_ready(const pg8::Unit&) const {}
    __device__ __forceinline__ void done(const pg8::Unit&) const {}
};
struct Frame {
    LAS unsigned char* lds;
    volatile LAS unsigned* MISC;
    gu32* ctl;
    unsigned char* ws;
    int tid, lane, wave, vcu, G;
};
struct Args { const float* in[28]; float* out; unsigned char* ws; int ph_lo, ph_hi; };
enum { I_X = 0, I_ANW, I_WIN, I_LNW, I_LNB, I_SGUW, I_SGUB, I_ARE, I_AIM, I_BRE, I_BIM, I_CRE, I_CIM, I_SD, I_LOGDT, I_GLUW, I_GLUB, I_ONA, I_ONB, I_WOUT, I_FNW, I_RW, I_RB, I_WGU, I_BGU, I_WDN, I_BDN, I_FINW };

__device__ __forceinline__ void tr_item(const float* W, int K, int N, bf16* WT, int k0, int n0, int drow0, const float* sc, LAS float* scr, int lane) {
    const int c4 = lane & 15, kr = lane >> 4;
    f32x4 v[16];
#pragma unroll
    for (int i = 0; i < 16; ++i) v[i] = __builtin_nontemporal_load((const GAS f32x4*)(W + (size_t)(k0 + 4 * i + kr) * N + n0 + 4 * c4));
#pragma unroll
    for (int i = 0; i < 16; ++i) { const int k = 4 * i + kr; const float s = sc ? sc[k0 + k] : 1.0f; LAS float* d = scr + k * 65 + 4 * c4;
        d[0] = v[i].x * s; d[1] = v[i].y * s; d[2] = v[i].z * s; d[3] = v[i].w * s; }
    LDS_WAIT(); asm volatile("" ::: "memory");
    const int nl = lane & 7, kc = lane >> 3;
#pragma unroll
    for (int j = 0; j < 8; ++j) { const int n = nl + 8 * j; const LAS float* s = scr + (8 * kc) * 65 + n;
        v4u o; o.x = pk2(s[0 * 65], s[1 * 65]); o.y = pk2(s[2 * 65], s[3 * 65]); o.z = pk2(s[4 * 65], s[5 * 65]); o.w = pk2(s[6 * 65], s[7 * 65]);
        __builtin_nontemporal_store(o, (GAS v4u*)(WT + (size_t)(drow0 + n) * K + k0 + 8 * kc)); }
    LDS_WAIT(); asm volatile("" ::: "memory");
}
__device__ __forceinline__ void rms_row_to_bf16(const float* xrow, bf16* orow, float* rsp, int lane) {
    const GAS f32x4* xr = (const GAS f32x4*)xrow + lane;
    f32x4 v[4]; float s = 0.f;
#pragma unroll
    for (int j = 0; j < 4; ++j) { v[j] = xr[64 * j]; s += (v[j].x * v[j].x + v[j].y * v[j].y) + (v[j].z * v[j].z + v[j].w * v[j].w); }
    const float rs = 1.0f / sqrtf(wave_sum(s) * (1.f / D) + EPS);
    GAS unsigned long long* o8 = (GAS unsigned long long*)orow + lane;
#pragma unroll
    for (int j = 0; j < 4; ++j) o8[64 * j] = (unsigned long long)pk2(v[j].x, v[j].y) | ((unsigned long long)pk2(v[j].z, v[j].w) << 32);
    if (lane == 0) *rsp = rs;
}
constexpr int I_IN = 16 * 24, I_OUT = 16 * 16, I_GLU = 8 * 8, I_GU = NE * 16 * 32, I_DN = NE * 16 * 16;
constexpr int Q_L0GU = I_GU, Q_L0DN = Q_L0GU + I_DN, Q_L1GU = Q_L0DN + I_GU, QN = Q_L1GU + I_DN;
__device__ __forceinline__ void conv_gu_item(Frame& F, const Args& A, int l, int r, LAS float* scr) {
    unsigned char* wb = F.ws + WS_W + (size_t)l * W_STRIDE;
    const int e = r / 512, rr = r % 512, kb = rr / 32, nb = rr % 32, n0 = 64 * nb, j = n0 & 1023, half = n0 >> 10, drow0 = (j >> 7) * 256 + half * 128 + (j & 127);
    tr_item(A.in[I_WGU] + ((size_t)l * NE + e) * D * 2048, D, 2048, (bf16*)(wb + W_GU) + (size_t)e * 2048 * D, 64 * kb, n0, drow0, A.in[I_FNW] + l * D, scr, F.lane);
}
__device__ __forceinline__ void conv_dn_item(Frame& F, const Args& A, int l, int r, LAS float* scr) {
    unsigned char* wb = F.ws + WS_W + (size_t)l * W_STRIDE;
    const int e = r / 256, rr = r % 256, kb = rr / 16, nb = rr % 16;
    tr_item(A.in[I_WDN] + ((size_t)l * NE + e) * D * D, D, D, (bf16*)(wb + W_DN) + (size_t)e * D * D, 64 * kb, 64 * nb, 64 * nb, nullptr, scr, F.lane);
}
__device__ __forceinline__ void conv_pull(Frame& F, const Args& A, int nb, int until) {
    LAS float* scr = (LAS float*)(F.lds + RING_OFF + F.wave * 16640);
    LAS int* qb = (LAS int*)(F.lds + LDSCTL_OFF + 768);
    for (int b = 0; b < nb; ++b) {
        if (F.tid == 0) qb[0] = (int)__hip_atomic_fetch_add(F.ctl + CW_Q, 8u, RLX_AGENT);
        __syncthreads();
        const int base = qb[0];
        __syncthreads();
        if (base >= QN) break;
        const int q = base + F.wave;
        if (q < Q_L0GU) conv_gu_item(F, A, 0, q, scr);
        else if (q < Q_L0DN) conv_dn_item(F, A, 0, q - Q_L0GU, scr);
        else if (q < Q_L1GU) conv_gu_item(F, A, 1, q - Q_L0DN, scr);
        else if (q < QN) conv_dn_item(F, A, 1, q - Q_L1GU, scr);
        if (base >= until) break;
    }
}
__device__ __forceinline__ void ph_prep(Frame& F, const Args& A) {
    LAS float* scr = (LAS float*)(F.lds + RING_OFF + F.wave * 16640);
    const int gw = F.vcu * NWAVES + F.wave, NGW = F.G * NWAVES;
    constexpr int PER_S = I_IN + I_OUT + I_GLU;
    for (int it = gw; it < DEPTH * PER_S; it += NGW) {
        const int l = it / PER_S; int r = it - l * PER_S;
        unsigned char* wb = F.ws + WS_W + (size_t)l * W_STRIDE;
        if (r < I_IN) { const int kb = r / 24, nb = r % 24; tr_item(A.in[I_WIN] + (size_t)l * D * NPROJ, D, NPROJ, (bf16*)(wb + W_IN), 64 * kb, 64 * nb, 64 * nb, A.in[I_ANW] + l * D, scr, F.lane); continue; } r -= I_IN;
        if (r < I_OUT) { const int kb = r / 16, nb = r % 16; const float* sc = (kb < 8) ? A.in[I_ONA] + l * DH : A.in[I_ONB] + l * DH - DH;
            tr_item(A.in[I_WOUT] + (size_t)l * D * D, D, D, (bf16*)(wb + W_OUT), 64 * kb, 64 * nb, 64 * nb, sc, scr, F.lane); continue; } r -= I_OUT;
        { const int kb = r / 8, nb = r % 8; tr_item(A.in[I_GLUW] + (size_t)l * DH * DH, DH, DH, (bf16*)(wb + W_GLU), 64 * kb, 64 * nb, 64 * nb, nullptr, scr, F.lane); }
    }
    for (int m = gw; m < M; m += NGW) rms_row_to_bf16(A.in[I_X] + (size_t)m * D, (bf16*)(F.ws + WS_XB) + (size_t)m * D, (float*)(F.ws + WS_RSI) + m, F.lane);
    for (int i = (F.vcu * NWAVES + F.wave) * 64 + F.lane; i < DEPTH * NG * NP; i += F.G * NWAVES * 64) {
        const int l = i / (NG * NP), gp = i % (NG * NP), g = gp / NP, p = gp % NP;
        unsigned char* sp = F.ws + WS_SSMP + (size_t)l * SSMP_STRIDE;
        const float dt = expf(A.in[I_LOGDT][l * NG + g]), ar = A.in[I_ARE][i], ai = A.in[I_AIM][i];
        const float ex = expf(dt * ar); float sn, cs; sincosf(dt * ai, &sn, &cs);
        const float abr = ex * cs, abi = ex * sn;
        const float nr = abr - 1.0f, ni = abi, den = ar * ar + ai * ai, cr = (nr * ar + ni * ai) / den, ci = (ni * ar - nr * ai) / den;
        ((float*)(sp + SSMP_ABAR))[gp * 2] = abr; ((float*)(sp + SSMP_ABAR))[gp * 2 + 1] = abi;
        float pr = abr, pi = abi;
#pragma unroll
        for (int k = 0; k < 7; ++k) { const float t = pr * pr - pi * pi; pi = 2.0f * pr * pi; pr = t; }
        ((float*)(sp + SSMP_A128))[gp * 2] = pr; ((float*)(sp + SSMP_A128))[gp * 2 + 1] = pi;
        float* bb = (float*)(sp + SSMP_BBAR) + (size_t)gp * 32;
        const float* bre = A.in[I_BRE] + (size_t)i * 16; const float* bim = A.in[I_BIM] + (size_t)i * 16;
#pragma unroll
        for (int h = 0; h < 16; ++h) { const float br = bre[h], bi = bim[h]; bb[h] = cr * br - ci * bi; bb[16 + h] = cr * bi + ci * br; }
        float* ct = (float*)(sp + SSMP_CTAB) + (size_t)g * 128 * 16;
        const float* cre = A.in[I_CRE] + (size_t)(l * NG + g) * 16 * NP; const float* cim = A.in[I_CIM] + (size_t)(l * NG + g) * 16 * NP;
#pragma unroll
        for (int h = 0; h < 16; ++h) { ct[p * 16 + h] = cre[h * NP + p]; ct[(64 + p) * 16 + h] = -cim[h * NP + p]; }
        bf16* bb16 = (bf16*)(F.ws + WS_BB16) + (size_t)(l * NG + g) * 2048; bf16* ct16 = (bf16*)(F.ws + WS_CT16) + (size_t)(l * NG + g) * 2048;
#pragma unroll
        for (int h = 0; h < 16; ++h) { bb16[((p >> 5) * 32 + (p & 31)) * 16 + h] = (bf16)f2bf(bb[h]); bb16[((2 + (p >> 5)) * 32 + (p & 31)) * 16 + h] = (bf16)f2bf(bb[16 + h]);
            ct16[h * 128 + p] = (bf16)f2bf(cre[h * NP + p]); ct16[h * 128 + 64 + p] = (bf16)f2bf(-cim[h * NP + p]); }
    }
    for (int i = (F.vcu * NWAVES + F.wave) * 64 + F.lane; i < DEPTH * D * NE; i += F.G * NWAVES * 64) { const int l = i / (D * NE), k = (i / NE) % D, e = i % NE;
        const float w = A.in[I_RW][i] * A.in[I_FNW][l * D + k]; const unsigned hi = f2bf(w); const float lo = w - __builtin_bit_cast(float, hi << 16);
        bf16* t = (bf16*)(F.ws + WS_RWT) + (size_t)l * 2 * NE * D; t[e * D + k] = (bf16)hi; t[(NE + e) * D + k] = (bf16)f2bf(lo); }
    for (int i = (F.vcu * NWAVES + F.wave) * 64 + F.lane; i < DEPTH * 4 * 128 * 128; i += F.G * NWAVES * 64) { const int t = (i >> 7) & 127, sx = i & 127;
        ((bf16*)(F.ws + WS_WM))[i] = (sx <= t) ? (bf16)f2bf(A.in[I_SGUW][i]) : (bf16)0; }
}

typedef short v4i16_t __attribute__((ext_vector_type(4)));
__device__ __forceinline__ void sgu_chunk_mfma(Frame& F, const Args& A, int l, int c) {
    const bf16* UG = (const bf16*)(F.ws + WS_P); const bf16* VG = UG + (size_t)M * DH;
    bf16* MIX = (bf16*)(F.ws + WS_MIX);
    const bf16* Wm = (const bf16*)(F.ws + WS_WM) + (size_t)l * 4 * 128 * 128;
    constexpr int PITCH = 1056;
    LAS unsigned char* vn = F.lds + RING_OFF;
    const float* lnw = A.in[I_LNW] + l * DH; const float* lnb = A.in[I_LNB] + l * DH;
    {
        const f32x4 w0 = *(const GAS f32x4*)(lnw + 8 * F.lane), w1 = *(const GAS f32x4*)(lnw + 8 * F.lane + 4), b0 = *(const GAS f32x4*)(lnb + 8 * F.lane), b1 = *(const GAS f32x4*)(lnb + 8 * F.lane + 4);
        const float ww[8] = {w0.x, w0.y, w0.z, w0.w, w1.x, w1.y, w1.z, w1.w}, bb[8] = {b0.x, b0.y, b0.z, b0.w, b1.x, b1.y, b1.z, b1.w};
#pragma unroll 4
        for (int r = F.wave * 16; r < F.wave * 16 + 16; ++r) {
            const v4u w = *(const GAS v4u*)(VG + (size_t)(c * 128 + r) * DH + 8 * F.lane);
            float v[8] = {bflo(w.x), bfhi(w.x), bflo(w.y), bfhi(w.y), bflo(w.z), bfhi(w.z), bflo(w.w), bfhi(w.w)};
            float s = 0.f, s2 = 0.f;
#pragma unroll
            for (int j = 0; j < 8; ++j) { s += v[j]; s2 += v[j] * v[j]; }
            s = wave_sum(s); s2 = wave_sum(s2);
            const float mean = s * (1.f / DH), var = fmaxf(s2 * (1.f / DH) - mean * mean, 0.f), rstd = 1.0f / sqrtf(var + EPS);
            float o[8];
#pragma unroll
            for (int j = 0; j < 8; ++j) o[j] = (v[j] - mean) * rstd * ww[j] + bb[j];
            v4u ow; ow.x = pk2(o[0], o[1]); ow.y = pk2(o[2], o[3]); ow.z = pk2(o[4], o[5]); ow.w = pk2(o[6], o[7]);
            *(LAS v4u*)(vn + r * PITCH + 16 * F.lane) = ow;
        }
    }
    __syncthreads();
    const int w = F.wave, fr = F.lane & 15, G = F.lane >> 4, rr = (F.lane >> 2) & 3, cc = F.lane & 3;
    const int nks = (w >> 1) + 1;
    const int trow = c * 128 + w * 16 + fr;
    LAS unsigned char* trb = vn + (4 * G + rr) * PITCH + 8 * cc;
    pg8::f32x4 acc[4][8];
#pragma unroll
    for (int h = 0; h < 4; ++h)
#pragma unroll
        for (int dt = 0; dt < 8; ++dt) acc[h][dt] = (pg8::f32x4){0.f, 0.f, 0.f, 0.f};
    for (int ks = 0; ks < nks; ++ks) {
#pragma unroll
        for (int h = 0; h < 4; ++h) {
            const bf16* wp = Wm + ((size_t)h * 128 + w * 16 + fr) * 128 + ks * 32 + 4 * G;
            const v2u wlo = *(const GAS v2u*)wp, whi = *(const GAS v2u*)(wp + 16);
            const v4u wf4 = (v4u){wlo.x, wlo.y, whi.x, whi.y};
            const bf16x8 wf = __builtin_bit_cast(bf16x8, wf4);
#pragma unroll
            for (int dt = 0; dt < 8; ++dt) {
                const LAS unsigned char* pa = trb + ks * 32 * PITCH + (h * 128 + dt * 16) * 2;
                const v4i16_t a0 = __builtin_amdgcn_ds_read_tr16_b64_v4i16((LAS v4i16_t*)pa), a1 = __builtin_amdgcn_ds_read_tr16_b64_v4i16((LAS v4i16_t*)(pa + 16 * PITCH));
                const bf16x8 af = (bf16x8){a0[0], a0[1], a0[2], a0[3], a1[0], a1[1], a1[2], a1[3]};
                acc[h][dt] = __builtin_amdgcn_mfma_f32_16x16x32_bf16(af, wf, acc[h][dt], 0, 0, 0);
            }
        }
    }
    float ss = 0.f;
#pragma unroll
    for (int h = 0; h < 4; ++h) { const float bt = A.in[I_SGUB][(size_t)(l * 4 + h) * 128 + w * 16 + fr];
#pragma unroll
        for (int dt = 0; dt < 8; ++dt) { const v2u uw = *(const GAS v2u*)(UG + (size_t)trow * DH + h * 128 + dt * 16 + 4 * G);
            pg8::f32x4 y = acc[h][dt] + bt; y[0] *= bflo(uw.x); y[1] *= bfhi(uw.x); y[2] *= bflo(uw.y); y[3] *= bfhi(uw.y);
            acc[h][dt] = y; ss += (y[0] * y[0] + y[1] * y[1]) + (y[2] * y[2] + y[3] * y[3]); } }
    ss += __shfl_xor(ss, 16); ss += __shfl_xor(ss, 32);
    const float rs = 1.0f / sqrtf(ss * (1.f / DH) + EPS);
#pragma unroll
    for (int h = 0; h < 4; ++h)
#pragma unroll
        for (int dt = 0; dt < 8; ++dt) { const pg8::f32x4 y = acc[h][dt] * rs; v2u o; o.x = pk2(y[0], y[1]); o.y = pk2(y[2], y[3]);
            *(GAS v2u*)(MIX + (size_t)trow * D + h * 128 + dt * 16 + 4 * G) = o; }
    __syncthreads();
}

typedef float f32x16 __attribute__((ext_vector_type(16)));
template <bool FULL>
__device__ __forceinline__ void ssm_item(Frame& F, const Args& A, int l, int g, int bp, int ch, float* xcarry = nullptr, bool cont = false) {
    const unsigned char* sp = F.ws + WS_SSMP + (size_t)l * SSMP_STRIDE;
    const bf16* US = (const bf16*)(F.ws + WS_P) + (size_t)2 * M * DH;
    const int lane = F.lane, H = lane >> 5, s = lane & 31;
    const float* abp = (const float*)(sp + SSMP_ABAR) + (size_t)g * NP * 2;
    const float a0r = abp[s * 2], a0i = abp[s * 2 + 1], a1r = abp[(32 + s) * 2], a1i = abp[(32 + s) * 2 + 1];
    bf16x8 bq[4];
    { const bf16* bb16 = (const bf16*)(F.ws + WS_BB16) + (size_t)(l * NG + g) * 2048;
#pragma unroll
      for (int q = 0; q < 4; ++q) bq[q] = *(const GAS bf16x8*)(bb16 + (q * 32 + s) * 16 + 8 * H); }
    float x0r = 0.f, x0i = 0.f, x1r = 0.f, x1i = 0.f;
    const int b = 2 * bp + H;
    if (FULL && cont) { x0r = xcarry[0]; x0i = xcarry[1]; x1r = xcarry[2]; x1i = xcarry[3]; }
    if (FULL && !cont) {
        const float* a8p = (const float*)(sp + SSMP_A128) + (size_t)g * NP * 2;
        const float c0r = a8p[s * 2], c0i = a8p[s * 2 + 1], c1r = a8p[(32 + s) * 2], c1i = a8p[(32 + s) * 2 + 1];
        const float* est = (const float*)(F.ws + WS_EST) + (((size_t)b * NG + g) * NCH * NP) * 2;
        for (int cb = 0; cb < ch; cb += 8) {
            f32x2_t ea[8], eb[8];
#pragma unroll
            for (int k = 0; k < 8; ++k) { const int cc = (cb + k < ch) ? cb + k : ch - 1; ea[k] = *(const GAS f32x2_t*)(est + ((size_t)cc * NP + s) * 2); eb[k] = *(const GAS f32x2_t*)(est + ((size_t)cc * NP + 32 + s) * 2); }
#pragma unroll
            for (int k = 0; k < 8; ++k) if (cb + k < ch) {
                float nr = c0r * x0r - c0i * x0i + ea[k].x, ni = c0r * x0i + c0i * x0r + ea[k].y; x0r = nr; x0i = ni;
                nr = c1r * x1r - c1i * x1i + eb[k].x; ni = c1r * x1i + c1i * x1r + eb[k].y; x1r = nr; x1i = ni; } }
    }
    const int ai = lane & 31;
    const bf16* ap = US + ((size_t)(2 * bp + ((ai >> 2) & 1)) * SEQ + ch * 128 + (ai & 3) + 4 * (ai >> 3)) * DH + g * 16 + 8 * H;
    constexpr int XP = 272;
    LAS unsigned char* xt = F.lds + RING_OFF + F.wave * (32 * XP);
    bf16x8 cq[4]; f32x4 dv = (f32x4){0.f, 0.f, 0.f, 0.f};
    const int fr = lane & 15, G = lane >> 4;
    if (FULL) { const bf16* ct16 = (const bf16*)(F.ws + WS_CT16) + (size_t)(l * NG + g) * 2048;
#pragma unroll
        for (int q = 0; q < 4; ++q) cq[q] = *(const GAS bf16x8*)(ct16 + fr * 128 + q * 32 + 8 * G);
        dv = *(const GAS f32x4*)(A.in[I_SD] + l * DH + g * 16 + 4 * G); }
    bf16x8 af = *(const GAS bf16x8*)ap;
    for (int tb = 0; tb < 8; ++tb) {
        const bf16x8 afn = *(const GAS bf16x8*)(ap + (size_t)((tb < 7 ? tb + 1 : tb) * 16) * DH);
        v2u uwp[2] = {(v2u){0u, 0u}, (v2u){0u, 0u}};
        if (FULL) {
#pragma unroll
            for (int hb = 0; hb < 2; ++hb) uwp[hb] = *(const GAS v2u*)(US + ((size_t)(2 * bp + hb) * SEQ + ch * 128 + tb * 16 + fr) * DH + g * 16 + 4 * G); }
        f32x16 z;
#pragma unroll
        for (int i = 0; i < 16; ++i) z[i] = 0.f;
        f32x16 r0 = __builtin_amdgcn_mfma_f32_32x32x16_bf16(af, bq[0], z, 0, 0, 0);
        f32x16 r1 = __builtin_amdgcn_mfma_f32_32x32x16_bf16(af, bq[1], z, 0, 0, 0);
        f32x16 i0 = __builtin_amdgcn_mfma_f32_32x32x16_bf16(af, bq[2], z, 0, 0, 0);
        f32x16 i1 = __builtin_amdgcn_mfma_f32_32x32x16_bf16(af, bq[3], z, 0, 0, 0);
#pragma unroll
        for (int t = 0; t < 16; ++t) {
            float nr = a0r * x0r - a0i * x0i + r0[t], ni = a0r * x0i + a0i * x0r + i0[t]; x0r = nr; x0i = ni;
            nr = a1r * x1r - a1i * x1i + r1[t]; ni = a1r * x1i + a1i * x1r + i1[t]; x1r = nr; x1i = ni;
            if (FULL) { LAS bf16* xr = (LAS bf16*)(xt + (H * 16 + t) * XP) + s;
                unsigned p0 = pg8::cvt_pk_bf16_raw(x0r, x0r), p1 = pg8::cvt_pk_bf16_raw(x1r, x1r), p2 = pg8::cvt_pk_bf16_raw(x0i, x0i), p3 = pg8::cvt_pk_bf16_raw(x1i, x1i);
                asm volatile("s_nop 1" : "+v"(p0), "+v"(p1), "+v"(p2), "+v"(p3));
                xr[0] = (bf16)p0; xr[32] = (bf16)p1; xr[64] = (bf16)p2; xr[96] = (bf16)p3;
                asm volatile("s_nop 1" :: "v"(p0), "v"(p1), "v"(p2), "v"(p3) : "memory"); }
        }
        if (FULL) {
            LDS_WAIT(); asm volatile("" ::: "memory");
#pragma unroll
            for (int hb = 0; hb < 2; ++hb) {
                pg8::f32x4 y = (pg8::f32x4){0.f, 0.f, 0.f, 0.f};
#pragma unroll
                for (int q = 0; q < 4; ++q) { const bf16x8 xf = *(const LAS bf16x8*)(xt + (hb * 16 + fr) * XP + q * 64 + 16 * G); y = __builtin_amdgcn_mfma_f32_16x16x32_bf16(cq[q], xf, y, 0, 0, 0); }
                const size_t row = (size_t)(2 * bp + hb) * SEQ + ch * 128 + tb * 16 + fr;
                const v2u uw = uwp[hb];
                y[0] += dv.x * bflo(uw.x); y[1] += dv.y * bfhi(uw.x); y[2] += dv.z * bflo(uw.y); y[3] += dv.w * bfhi(uw.y);
                v2u o; o.x = pk2(gelu_tanh(y[0]), gelu_tanh(y[1])); o.y = pk2(gelu_tanh(y[2]), gelu_tanh(y[3]));
                *(GAS v2u*)((bf16*)(F.ws + WS_YG) + row * DH + g * 16 + 4 * G) = o;
            }
            LDS_WAIT(); asm volatile("" ::: "memory");
        }
        af = afn;
    }
    if (FULL && xcarry) { xcarry[0] = x0r; xcarry[1] = x0i; xcarry[2] = x1r; xcarry[3] = x1i; }
    if (!FULL) { float* est = (float*)(F.ws + WS_EST) + ((((size_t)b * NG + g) * NCH + ch) * NP) * 2;
        *(GAS f32x2_t*)(est + s * 2) = (f32x2_t){x0r, x0i}; *(GAS f32x2_t*)(est + (32 + s) * 2) = (f32x2_t){x1r, x1i}; }
}

__device__ __forceinline__ void ph_normb(Frame& F, const Args& A, int l) {
    bf16* MIX = (bf16*)(F.ws + WS_MIX);
    const float* ssp = (const float*)(F.ws + WS_SSP);
    const int gw = F.vcu * NWAVES + F.wave, NGW = F.G * NWAVES;
    for (int mb = gw; mb < M; mb += 8 * NGW) {
        f32x4 p0[8], p1[8]; v4u w[8];
#pragma unroll
        for (int j = 0; j < 8; ++j) { const int m = mb + j * NGW; if (m < M) { p0[j] = *(const GAS f32x4*)(ssp + (size_t)m * 8); p1[j] = *(const GAS f32x4*)(ssp + (size_t)m * 8 + 4); w[j] = *(const GAS v4u*)(MIX + (size_t)m * D + DH + 8 * F.lane); } }
#pragma unroll
        for (int j = 0; j < 8; ++j) { const int m = mb + j * NGW; if (m < M) {
            const float s = 1.0f / sqrtf((((p0[j].x + p0[j].y) + (p0[j].z + p0[j].w)) + ((p1[j].x + p1[j].y) + (p1[j].z + p1[j].w))) * (1.f / DH) + EPS);
            v4u o; o.x = pk2(bflo(w[j].x) * s, bfhi(w[j].x) * s); o.y = pk2(bflo(w[j].y) * s, bfhi(w[j].y) * s); o.z = pk2(bflo(w[j].z) * s, bfhi(w[j].z) * s); o.w = pk2(bflo(w[j].w) * s, bfhi(w[j].w) * s);
            *(GAS v4u*)(MIX + (size_t)m * D + DH + 8 * F.lane) = o; } }
    }
}

__device__ __forceinline__ void ph_route_mfma(Frame& F, const Args& A, int l, int cbank) {
    const bf16* XA = (const bf16*)(F.ws + WS_XA); bf16* H2 = (bf16*)(F.ws + WS_H2);
    int* RE = (int*)(F.ws + WS_RE); int* RK = (int*)(F.ws + WS_RK); float* GW = (float*)(F.ws + WS_GW);
    gu32* cnt = F.ctl + CW_CNT + cbank * NE;
    constexpr int WP = 2064, PL_OFF = 64 * WP, SSQ_OFF = PL_OFF + 2 * 64 * 32 * 4;
    static_assert(SSQ_OFF + 512 <= LDSCTL_OFF, "route LDS map");
    LAS unsigned char* wt = F.lds + RING_OFF;
    LAS float* PL = (LAS float*)(F.lds + PL_OFF); LAS float* SSQ = (LAS float*)(F.lds + SSQ_OFF);
    LAS int* lcnt = (LAS int*)(F.lds + LDSCTL_OFF); LAS int* lbase = lcnt + 32;
    LAS int* as_e = (LAS int*)(F.lds + LDSCTL_OFF + 1024); LAS int* as_lr = as_e + 256; LAS float* as_g = (LAS float*)(as_lr + 256);
    const float* rb = A.in[I_RB] + l * NE;
    { const bf16* src = (const bf16*)(F.ws + WS_RWT) + (size_t)l * 2 * NE * D;
      v4u wv[16];
#pragma unroll
      for (int q = 0; q < 16; ++q) { const int i = F.tid + q * (NWAVES * 64), row = i >> 7, ch = i & 127; wv[q] = *(const GAS v4u*)(src + (size_t)row * D + ch * 8); }
#pragma unroll
      for (int q = 0; q < 16; ++q) { const int i = F.tid + q * (NWAVES * 64), row = i >> 7, ch = i & 127; *(LAS v4u*)(wt + row * WP + ch * 16) = wv[q]; } }
    const int fr = F.lane & 15, G = F.lane >> 4, rg = F.wave & 3;
    for (int blk = F.vcu; blk < M / 64; blk += F.G) {
        if (F.tid < 32) lcnt[F.tid] = 0;
        __syncthreads();
        if (F.wave < 4) {
            v4u xall[2][16];
#pragma unroll
            for (int kh = 0; kh < 2; ++kh) { const bf16* xp = XA + (size_t)(blk * 64 + rg * 16 + fr) * D + kh * 512 + 8 * G;
#pragma unroll
                for (int ks = 0; ks < 16; ++ks) xall[kh][ks] = *(const GAS v4u*)(xp + ks * 32); }
#pragma unroll
            for (int kh = 0; kh < 2; ++kh) {
                pg8::f32x4 a0 = (pg8::f32x4){0.f, 0.f, 0.f, 0.f}, a1 = a0; float ssq = 0.f;
                const LAS unsigned char* wp = wt + fr * WP + (kh * 512 + 8 * G) * 2;
#pragma unroll
                for (int ks = 0; ks < 16; ++ks) {
                    const v4u xw = xall[kh][ks]; const bf16x8 xb = __builtin_bit_cast(bf16x8, xw);
                    { const float x0 = bflo(xw.x), x1 = bfhi(xw.x), x2 = bflo(xw.y), x3 = bfhi(xw.y), x4 = bflo(xw.z), x5 = bfhi(xw.z), x6 = bflo(xw.w), x7 = bfhi(xw.w);
                      ssq += ((x0 * x0 + x1 * x1) + (x2 * x2 + x3 * x3)) + ((x4 * x4 + x5 * x5) + (x6 * x6 + x7 * x7)); }
                    const bf16x8 w0h = *(const LAS bf16x8*)(wp + ks * 64), w1h = *(const LAS bf16x8*)(wp + 16 * WP + ks * 64);
                    const bf16x8 w0l = *(const LAS bf16x8*)(wp + 32 * WP + ks * 64), w1l = *(const LAS bf16x8*)(wp + 48 * WP + ks * 64);
                    a0 = __builtin_amdgcn_mfma_f32_16x16x32_bf16(w0h, xb, a0, 0, 0, 0); a1 = __builtin_amdgcn_mfma_f32_16x16x32_bf16(w1h, xb, a1, 0, 0, 0);
                    a0 = __builtin_amdgcn_mfma_f32_16x16x32_bf16(w0l, xb, a0, 0, 0, 0); a1 = __builtin_amdgcn_mfma_f32_16x16x32_bf16(w1l, xb, a1, 0, 0, 0);
                }
                ssq += __shfl_xor(ssq, 16); ssq += __shfl_xor(ssq, 32);
                LAS float* pl = PL + ((kh * 64 + rg * 16 + fr) * 32);
                *(LAS pg8::f32x4*)(pl + 4 * G) = a0; *(LAS pg8::f32x4*)(pl + 16 + 4 * G) = a1;
                if (G == 0) SSQ[kh * 64 + rg * 16 + fr] = ssq;
            }
        }
        __syncthreads();
#pragma unroll 1
        for (int rr = 0; rr < 8; ++rr) {
            const int lr = F.wave * 8 + rr, row = blk * 64 + lr, L = F.lane, e = L >> 1;
            const float rs = 1.0f / sqrtf((SSQ[lr] + SSQ[64 + lr]) * (1.f / D) + EPS);
            {
                const GAS v2u* xr = (const GAS v2u*)(XA + (size_t)row * D) + L; GAS v2u* o8 = (GAS v2u*)(H2 + (size_t)row * D) + L;
#pragma unroll
                for (int j = 0; j < 4; ++j) { const v2u xw = xr[64 * j]; v2u o; o.x = pk2(bflo(xw.x) * rs, bfhi(xw.x) * rs); o.y = pk2(bflo(xw.y) * rs, bfhi(xw.y) * rs); o8[64 * j] = o; } }
            const float val = (PL[lr * 32 + e] + PL[(64 + lr) * 32 + e]) * rs + rb[e];
            LAS float* lrow = (LAS float*)(F.lds + LDSCTL_OFF + 1024 + 3072) + F.wave * 32;
            if ((L & 1) == 0) lrow[e] = val;
            LDS_WAIT(); asm volatile("" ::: "memory");
            int rank = 0;
#pragma unroll
            for (int q = 0; q < 8; ++q) { const f32x4 o = *(const LAS f32x4*)(lrow + 4 * q);
                rank += (o.x > val || (o.x == val && 4 * q + 0 < e)) ? 1 : 0; rank += (o.y > val || (o.y == val && 4 * q + 1 < e)) ? 1 : 0;
                rank += (o.z > val || (o.z == val && 4 * q + 2 < e)) ? 1 : 0; rank += (o.w > val || (o.w == val && 4 * q + 3 < e)) ? 1 : 0; }
            asm volatile("" ::: "memory");
            float mx = val;
#pragma unroll
            for (int o = 2; o < 64; o <<= 1) mx = fmaxf(mx, __shfl_xor(mx, o));
            const bool win = (rank < 4) && ((L & 1) == 0);
            const float ex = win ? __expf(val - mx) : 0.f;
            const float den = wave_sum(ex);
            if (win) { const int slr = __hip_atomic_fetch_add(lcnt + e, 1, __ATOMIC_RELAXED, __HIP_MEMORY_SCOPE_WORKGROUP);
                const int ix = lr * 4 + rank; as_e[ix] = e; as_lr[ix] = slr; as_g[ix] = ex / den; }
            LDS_WAIT(); asm volatile("" ::: "memory");
        }
        __syncthreads();
        if (F.tid < 32) lbase[F.tid] = (int)__hip_atomic_fetch_add(cnt + F.tid, (unsigned)lcnt[F.tid], RLX_AGENT);
        __syncthreads();
        if (F.tid < 256) { const int a = blk * 256 + F.tid, e = as_e[F.tid], rk = lbase[e] + as_lr[F.tid]; RE[a] = e; RK[a] = rk; GW[a] = as_g[F.tid]; ((int*)(F.ws + WS_XS))[e * NAS + rk] = a >> 2; }
        __syncthreads();
    }
}

__device__ __forceinline__ int moe_tables(Frame& F, int l, int NT, int GS, bool build, bool fresh = true) {
    gu32* cnt = F.ctl + CW_CNT + l * NE;
    LAS int* offL = (LAS int*)(F.lds + TAB_OFF); LAS int* cntL = offL + 64; LAS unsigned* tab = (LAS unsigned*)(F.lds + TAB_OFF + 1024);
    if (fresh) {
    if (F.tid < NE) cntL[F.tid] = (int)__hip_atomic_load(cnt + F.tid, RLX_AGENT);
    __syncthreads();
    if (F.tid == 0) { int o = 0; for (int e = 0; e < NE; ++e) { offL[e] = o; o += (cntL[e] + 255) & ~255; } offL[NE] = o; }
    __syncthreads();
    }
    if (build && F.tid < NE) { const int e = F.tid, t0 = offL[e] >> 8, mt = (offL[e + 1] - offL[e]) >> 8;
        int idx = t0 * NT;
        for (int pg = 0; pg * GS < mt; ++pg) { const int gs = (mt - pg * GS) < GS ? (mt - pg * GS) : GS;
            for (int pn = 0; pn < NT; ++pn) for (int pi = 0; pi < gs; ++pi) { tab[idx] = (unsigned)(t0 + pg * GS + pi) | ((unsigned)(e * NT + pn) << 12); ++idx; } } }
    __syncthreads();
    return (offL[NE] >> 8) * NT;
}

__device__ __forceinline__ void ph_combine(Frame& F, const Args& A, int l) {
    const bf16* XA = (const bf16*)(F.ws + WS_XA); bf16* XC = (bf16*)(F.ws + WS_XC); float* RSI = (float*)(F.ws + WS_RSI) + M;
    const bf16* YB = (const bf16*)(F.ws + WS_YB); const int* RE = (const int*)(F.ws + WS_RE); const int* RK = (const int*)(F.ws + WS_RK); const float* GW = (const float*)(F.ws + WS_GW);
    (void)moe_tables(F, l, 4, 8, false, false);
    const LAS int* offL = (const LAS int*)(F.lds + TAB_OFF);
    const int gw = F.vcu * NWAVES + F.wave, NGW = F.G * NWAVES;
    const bool last = (l == DEPTH - 1);
    for (int jb = 0; gw + jb * NGW < M; jb += 16) {
        int slot_l = 0; float g_l = 0.f;
        { const int ml = gw + (jb + (F.lane >> 2)) * NGW;
          if (ml < M) { const int a = ml * 4 + (F.lane & 3); slot_l = offL[__hip_atomic_load(RE + a, RLX_AGENT)] + __hip_atomic_load(RK + a, RLX_AGENT); g_l = __hip_atomic_load(GW + a, RLX_AGENT); } }
        v2u xa[4], ya[4][4], xb[4], yb[4][4];
#define COMB_LOAD(X, Y, J) do { const int m_ = gw + (jb + (J)) * NGW; const GAS v2u* xr_ = (const GAS v2u*)(XA + (size_t)m_ * D) + F.lane; \
            _Pragma("unroll") for (int q = 0; q < 4; ++q) (X)[q] = xr_[64 * q]; \
            _Pragma("unroll") for (int k = 0; k < 4; ++k) { const int slot_ = __builtin_amdgcn_readlane(slot_l, 4 * (J) + k); const GAS v2u* yp_ = (const GAS v2u*)(YB + (size_t)slot_ * D) + F.lane; \
                _Pragma("unroll") for (int q = 0; q < 4; ++q) (Y)[k][q] = yp_[64 * q]; } } while (0)
        COMB_LOAD(xa, ya, 0);
#pragma unroll 1
        for (int jj = 0; jj < 16; ++jj) {
            const int m = gw + (jb + jj) * NGW;
            if (m >= M) break;
            const bool more = (jj < 15) && (m + NGW < M);
            if (more) COMB_LOAD(xb, yb, jj + 1);
            f32x4 v[4];
#pragma unroll
            for (int q = 0; q < 4; ++q) v[q] = (f32x4){bflo(xa[q].x), bfhi(xa[q].x), bflo(xa[q].y), bfhi(xa[q].y)};
#pragma unroll
            for (int k = 0; k < 4; ++k) { const float g = __builtin_bit_cast(float, __builtin_amdgcn_readlane(__builtin_bit_cast(int, g_l), 4 * jj + k));
#pragma unroll
                for (int q = 0; q < 4; ++q) { const v2u w = ya[k][q]; v[q].x += g * bflo(w.x); v[q].y += g * bfhi(w.x); v[q].z += g * bflo(w.y); v[q].w += g * bfhi(w.y); } }
            float sq = 0.f;
#pragma unroll
            for (int q = 0; q < 4; ++q) sq += (v[q].x * v[q].x + v[q].y * v[q].y) + (v[q].z * v[q].z + v[q].w * v[q].w);
            const float rs = 1.0f / sqrtf(wave_sum(sq) * (1.f / D) + EPS);
            if (!last) {
                GAS unsigned long long* o8 = (GAS unsigned long long*)(XC + (size_t)m * D) + F.lane;
#pragma unroll
                for (int q = 0; q < 4; ++q) o8[64 * q] = (unsigned long long)pk2(v[q].x, v[q].y) | ((unsigned long long)pk2(v[q].z, v[q].w) << 32);
                if (F.lane == 0) RSI[m] = rs;
            } else {
                GAS f32x4* oo = (GAS f32x4*)(A.out + (size_t)m * D) + F.lane; const GAS f32x4* fw = (const GAS f32x4*)A.in[I_FINW] + F.lane;
#pragma unroll
                for (int q = 0; q < 4; ++q) { const f32x4 w = fw[64 * q]; oo[64 * q] = v[q] * rs * w; }
            }
            if (more) {
#pragma unroll
                for (int q = 0; q < 4; ++q) { xa[q] = xb[q];
#pragma unroll
                    for (int k = 0; k < 4; ++k) ya[k][q] = yb[k][q]; } }
        }
#undef COMB_LOAD
    }
}
template <class Epi, class Sched>
__device__ __forceinline__ void run_gemm(Frame& F, const pg8::Gemm& g, const Sched& S, const Epi& E) {
    pg8::gemm_phase<Epi, Sched, true>(F.lds + RING_OFF, g, S, E);
}
__global__ void __launch_bounds__(NWAVES * 64, 2) mk_fwd(Args args) {
    extern __shared__ __attribute__((aligned(16))) unsigned char lds[];
    Frame F;
    F.lds = (LAS unsigned char*)lds;
    F.MISC = (volatile LAS unsigned*)(F.lds + MISC_OFF);
    F.tid = threadIdx.x; F.lane = F.tid & 63; F.wave = __builtin_amdgcn_readfirstlane(F.tid >> 6);
    F.G = gridDim.x; { const int bx = blockIdx.x; F.vcu = (F.G % 8 == 0) ? (bx % 8) * (F.G / 8) + bx / 8 : bx; }
    F.ws = args.ws; F.ctl = (gu32*)(args.ws + WS_CTL);
    for (int u = F.tid; u < (LDS_BYTES - LDSCTL_OFF) / 4; u += NWAVES * 64) ((LAS unsigned*)(F.lds + LDSCTL_OFF))[u] = 0u;
    __syncthreads();
#if N_LAUNCH_MODE == 1
    XcdBarrier bar = xcd_barrier_post((unsigned*)(F.ctl + CW_BAR), F.MISC + 8);
#define GRID_BAR() xcd_barrier(bar)
#else
#define GRID_BAR() do { } while (0)
#endif
    const int lo = args.ph_lo, hi = args.ph_hi;
#define IN(k) (lo <= (k) && (k) < hi)
#define SEAM(k) do { if (IN(k) && IN((k) + 1)) GRID_BAR(); } while (0)

#ifndef PH_MASK
#define PH_MASK 0xfff
#endif
#define PHX(k) (((PH_MASK) >> (k)) & 1)
#ifndef DUP_MASK
#define DUP_MASK 0
#endif
#define REPS(k) (1 + (((DUP_MASK) >> (k)) & 1))
    if (PHX(11) && IN(0)) { for (int rep = 0; rep < REPS(11); ++rep) { if (rep) GRID_BAR(); ph_prep(F, args); __syncthreads(); conv_pull(F, args, 1 << 20, QN); }     SEAM(0); }

#define LAUNDER() do { asm volatile("" : "+v"(F.tid)); F.lane = F.tid & 63; F.wave = __builtin_amdgcn_readfirstlane(F.tid >> 6); } while (0)
    for (int l = 0; l < DEPTH; ++l) {
        const int pb = 1 + l * PH_PER_LAYER;
        unsigned char* wb = F.ws + WS_W + (size_t)l * W_STRIDE;
        const bf16* xin = (l == 0) ? (const bf16*)(F.ws + WS_XB) : (const bf16*)(F.ws + WS_XC);
        if (PHX(0) && IN(pb + 0)) { for (int rep = 0; rep < REPS(0); ++rep) { if (rep) GRID_BAR();
            pg8::Gemm g{xin, (const bf16*)(wb + W_IN), M, NPROJ, D}; pg8::StaticOrder S; S.init(M, NPROJ, F.G, (int)blockIdx.x);
            EpiInProj E{(bf16*)(F.ws + WS_P), (const float*)(F.ws + WS_RSI) + (size_t)l * M};
            run_gemm(F, g, S, E);
            } SEAM(pb + 0);
        }
        if (PHX(1) && IN(pb + 1)) { for (int rep = 0; rep < REPS(1); ++rep) { if (rep) GRID_BAR(); LAUNDER();
            for (int bi = (int)blockIdx.x; bi < 256; bi += F.G) { const int wi = bi * 8 + F.wave; ssm_item<false>(F, args, l, wi >> 6, (wi >> 5) & 1, wi & 31); }
            } SEAM(pb + 1);
        }
        if (PHX(2) && IN(pb + 2)) { for (int rep = 0; rep < REPS(2); ++rep) { if (rep) GRID_BAR(); LAUNDER();
            for (int bi = (int)blockIdx.x; bi < 256; bi += F.G) { if (F.wave < 4) { float xs[4]; const int wi = bi * 8 + 2 * F.wave;
                ssm_item<true>(F, args, l, wi >> 6, (wi >> 5) & 1, wi & 31, xs, false); ssm_item<true>(F, args, l, wi >> 6, (wi >> 5) & 1, (wi & 31) + 1, xs, true); } }
            } SEAM(pb + 2);
        }
        if (PHX(3) && IN(pb + 3)) { for (int rep = 0; rep < REPS(3); ++rep) { if (rep) GRID_BAR();
            pg8::Gemm g{(const bf16*)(F.ws + WS_YG), (const bf16*)(wb + W_GLU), M, DH, DH}; pg8::StaticOrder S; S.init(M, DH, F.G, (int)blockIdx.x);
            EpiGlu E{(const bf16*)(F.ws + WS_YG), (bf16*)(F.ws + WS_MIX), args.in[I_GLUB] + l * DH, (float*)(F.ws + WS_SSP)};
            run_gemm(F, g, S, E);
            LAUNDER();
            if (F.G >= 256) { for (int c = (int)blockIdx.x - 128; c >= 0 && c < 128; c += F.G) sgu_chunk_mfma(F, args, l, c); }
            else { for (int c = (int)blockIdx.x; c < 128; c += F.G) sgu_chunk_mfma(F, args, l, c); }
            } SEAM(pb + 3);
        }
        if (PHX(4) && IN(pb + 4)) { for (int rep = 0; rep < REPS(4); ++rep) { if (rep) GRID_BAR(); LAUNDER(); ph_normb(F, args, l); } SEAM(pb + 4); }
        if (PHX(5) && IN(pb + 5)) { for (int rep = 0; rep < REPS(5); ++rep) { if (rep) GRID_BAR();
            pg8::Gemm g{(const bf16*)(F.ws + WS_MIX), (const bf16*)(wb + W_OUT), M, D, D}; pg8::StaticOrder S; S.init(M, D, F.G, (int)blockIdx.x);
            EpiResid E{xin, (bf16*)(F.ws + WS_XA)};
            run_gemm(F, g, S, E);
            } SEAM(pb + 5);
        }
        if (PHX(6) && IN(pb + 6)) { for (int rep = 0; rep < REPS(6); ++rep) { if (rep) GRID_BAR(); LAUNDER(); ph_route_mfma(F, args, l, (REPS(6) == 2 && rep == 0) ? 2 + l : l); } SEAM(pb + 6); }
        if (PHX(7) && IN(pb + 7)) { for (int rep = 0; rep < REPS(7); ++rep) { if (rep) GRID_BAR();
            const int n = moe_tables(F, l, 8, 4, true);
            pg8::Gemm g{(const bf16*)(F.ws + WS_H2), (const bf16*)(wb + W_GU), M, NE * 2048, D};
            LdsOrder<true> S{(const LAS unsigned*)(F.lds + TAB_OFF + 1024), n, F.G, (int)blockIdx.x, (const LAS int*)(F.lds + TAB_OFF), (const LAS int*)(F.lds + TAB_OFF) + 64, (const int*)(F.ws + WS_XS), (const LAS unsigned*)(F.lds + TAB_OFF + 10240)};
            EpiSwiglu E{(bf16*)(F.ws + WS_ACT), args.in[I_BGU] + (size_t)l * NE * 2048};
            S.fill_rows((LAS unsigned*)(F.lds + TAB_OFF + 10240), F.tid); __syncthreads();
            run_gemm(F, g, S, E);
            } SEAM(pb + 7);
        }
        if (PHX(8) && IN(pb + 8)) { for (int rep = 0; rep < REPS(8); ++rep) { if (rep) GRID_BAR();
            const int n = moe_tables(F, l, 4, 8, true, REPS(8) == 2 || REPS(9) == 2);
            pg8::Gemm g{(const bf16*)(F.ws + WS_ACT), (const bf16*)(wb + W_DN), SLOTS, NE * D, D};
            LdsOrder<false> S{(const LAS unsigned*)(F.lds + TAB_OFF + 1024), n, F.G, (int)blockIdx.x, (const LAS int*)(F.lds + TAB_OFF), (const LAS int*)(F.lds + TAB_OFF) + 64, (const int*)(F.ws + WS_XS), (const LAS unsigned*)(F.lds + TAB_OFF + 10240)};
            EpiDown E{(bf16*)(F.ws + WS_YB), args.in[I_BDN] + (size_t)l * NE * D};
            run_gemm(F, g, S, E);
            } SEAM(pb + 8);
        }
        if (PHX(9) && IN(pb + 9)) { for (int rep = 0; rep < REPS(9); ++rep) { if (rep) GRID_BAR(); LAUNDER(); ph_combine(F, args, l); } SEAM(pb + 9); }
    }
#undef IN
#undef SEAM
}

extern "C" void kernel_launch(void* const* d_in, const int* in_sizes, int n_in, void* d_out, int out_size, void* d_ws, size_t ws_size, hipStream_t stream) {
    static int grid = 0;
    if (grid == 0) {
        if (n_in != 28 || in_sizes[0] != M * D || out_size != M * D || ws_size < WS_END) { fprintf(stderr, "kernel_launch: unexpected shapes (n_in %d, in0 %d, out %d, ws %zu < %zu); nothing launched\n", n_in, n_in > 0 ? in_sizes[0] : -1, out_size, ws_size, (size_t)WS_END); grid = -1; return; }
        int dev = 0, cus = 0, per_cu = 0;
        if (hipGetDevice(&dev) != hipSuccess || hipDeviceGetAttribute(&cus, hipDeviceAttributeMultiprocessorCount, dev) != hipSuccess) { grid = -1; return; }
        if (hipFuncSetAttribute((const void*)mk_fwd, hipFuncAttributeMaxDynamicSharedMemorySize, LDS_BYTES) != hipSuccess) { fprintf(stderr, "kernel_launch: hipFuncSetAttribute failed\n"); grid = -1; return; }
        if (hipOccupancyMaxActiveBlocksPerMultiprocessor(&per_cu, (const void*)mk_fwd, NWAVES * 64, LDS_BYTES) != hipSuccess || per_cu < 1) { fprintf(stderr, "kernel_launch: occupancy query reports %d workgroups per CU\n", per_cu); }
        (void)hipGetLastError();
        grid = cus;
        if (grid % 8 != 0 || grid < 8) { fprintf(stderr, "kernel_launch: %d CUs: unsupported\n", grid); grid = -1; return; }
    }
    if (grid < 0) return;
    if (hipMemsetAsync((char*)d_ws + WS_CTL, 0, CTL_ZERO_BYTES, stream) != hipSuccess) return;
    Args a{};
    for (int i = 0; i < 28; ++i) a.in[i] = (const float*)d_in[i];
    a.out = (float*)d_out; a.ws = (unsigned char*)d_ws;
#if N_LAUNCH_MODE == 1
    a.ph_lo = 0; a.ph_hi = N_PHASES;
    hipLaunchKernelGGL(mk_fwd, dim3(grid), dim3(NWAVES * 64), LDS_BYTES, stream, a);
#else
    for (int p = 0; p < N_PHASES; ++p) { a.ph_lo = p; a.ph_hi = p + 1; hipLaunchKernelGGL(mk_fwd, dim3(grid), dim3(NWAVES * 64), LDS_BYTES, stream, a); }
#endif
}
```

```cpp
#include <hip/hip_runtime.h>
#include <cstdio>
#include <cstdint>
#ifndef N_LAUNCH_MODE
#define N_LAUNCH_MODE 1
#endif
namespace pg8 {
#define PG8_LAS __attribute__((address_space(3)))
typedef unsigned short bf16_t;
typedef short bf16x8 __attribute__((ext_vector_type(8)));
typedef float f32x4 __attribute__((ext_vector_type(4)));
typedef unsigned u32x4 __attribute__((ext_vector_type(4)));
constexpr int BM = 256, BK = 64, HALF = 128, HTB = HALF * BK * 2  , STAGE_BYTES = 8 * HTB, NXCD = 8, WGM = 8;

__host__ __device__ __forceinline__ int lds_byte(int r, int c) { const int st = (r >> 4) * 2 + (c >> 5), rr = r & 15, cc = c & 31, ob = rr * 64 + cc * 2; return st * 1024 + (ob ^ (((ob >> 9) & 1) << 5)); }
__host__ __device__ __forceinline__ void stage_rc(int b, int& R, int& C) { const int st = b / 1024, sb = b % 1024, swz = sb ^ (((sb >> 9) & 1) << 5); R = (st >> 1) * 16 + swz / 64; C = (st & 1) * 32 + (swz % 64) / 2; }
__host__ __device__ __forceinline__ int perm32(int rho) { const int n = rho >> 4, i = rho & 15; return 8 * (i >> 2) + 4 * n + (i & 3); }

struct Unit { int pm, pn, li; };
struct Gemm { const bf16_t* A; const bf16_t* Bt; int M, N, K; };

struct StaticOrder {
    static constexpr bool GATHER = false;
    int nM, nN, nwg, G, c;
    __host__ __device__ void init(int M, int N, int G_, int c_) { nM = M / BM; nN = N / BM; nwg = nM * nN; G = G_; c = c_; }
    __host__ __device__ bool next(int i, Unit& u) const {
        const long L = (long)i * G + c; if (L >= nwg) return false;
        int wgid = (int)L; { const int q = nwg / NXCD, r = nwg % NXCD, xcd = wgid % NXCD, off = wgid / NXCD; wgid = (xcd < r ? xcd * (q + 1) : r * (q + 1) + (xcd - r) * q) + off; }
        const int nig = WGM * nN, gid = wgid / nig, fm = gid * WGM, gsz = (nM - fm) < WGM ? (nM - fm) : WGM;
        u.pm = fm + ((wgid % nig) % gsz); u.pn = (wgid % nig) / gsz; u.li = i; return true;
    }
    __device__ __forceinline__ void a_ready(const Unit&) const {}
    __device__ __forceinline__ void done(const Unit&) const {}
};

typedef __bf16 bf16x2_t __attribute__((ext_vector_type(2)));
typedef float f32x2c_t __attribute__((ext_vector_type(2)));
__device__ __forceinline__ unsigned cvt_pk_bf16(float lo, float hi) { const bf16x2_t r = __builtin_convertvector((f32x2c_t){lo, hi}, bf16x2_t); unsigned u = __builtin_bit_cast(unsigned, r); asm volatile("s_nop 1" : "+v"(u)); return u; }
__device__ __forceinline__ unsigned cvt_pk_bf16_raw(float lo, float hi) { const bf16x2_t r = __builtin_convertvector((f32x2c_t){lo, hi}, bf16x2_t); return __builtin_bit_cast(unsigned, r); }
template <class Epi, class Sched, bool ALIGN_EPI = true>
__device__ __forceinline__ void gemm_phase(PG8_LAS unsigned char* lds, const Gemm g, const Sched& S, const Epi& E) {
    int tid_ = threadIdx.x; asm volatile("" : "+v"(tid_));
    const int tid = tid_, wid = __builtin_amdgcn_readfirstlane(tid >> 6), lane = tid & 63, wr = wid >> 2, wc = wid & 3, fr = lane & 15, fq = lane >> 4;
    const int K = g.K, nt = K / BK;
    int RA[2]; unsigned cofA[2], voffB[2];
#pragma unroll
    for (int i = 0; i < 2; ++i) { int R, C; stage_rc(tid * 16 + i * 8192, R, C); const int Rb = Epi::PERM ? ((R & ~31) + perm32(R & 31)) : R;
        RA[i] = R; cofA[i] = (unsigned)C * 2u; voffB[i] = (unsigned)(Rb * K + C) * 2u; }
    const size_t kstep = (size_t)(BK * 2);
    const size_t hstep = (size_t)HALF * K * 2;
    const size_t tstep = 2 * hstep;
    const unsigned ldsw = (unsigned)wid * 1024u;
    const int aoff = lds_byte(wr * 64 + fr, fq * 8), boff = lds_byte(wc * 32 + fr, fq * 8);
    const char* gA = (const char*)g.A;
#define PG8_AOFF(dst, u) do { _Pragma("unroll") for (int _h = 0; _h < 2; ++_h) _Pragma("unroll") for (int _i = 0; _i < 2; ++_i) { \
        if constexpr (Sched::GATHER) dst[_h][_i] = S.arow((u), _h * HALF + RA[_i]) + cofA[_i]; \
        else dst[_h][_i] = (unsigned)(((u).pm * BM + _h * HALF + RA[_i]) * K) * 2u + cofA[_i]; } } while (0)
#define PG8_SA(b, h) (((b) * 2 + (h)) * HTB)
#define PG8_SB(b, h) ((4 + (b) * 2 + (h)) * HTB)
#define PG8_STAGE(bufoff, gbase, voff) do { _Pragma("unroll") for (int _i = 0; _i < 2; ++_i) \
        __builtin_amdgcn_global_load_lds((const unsigned*)((const char*)(gbase) + (voff)[_i]), (PG8_LAS unsigned*)(lds + (bufoff) + ldsw + _i * 8192), 16, 0, 0); } while (0)
#define PG8_LDA(dst, b, h) do { _Pragma("unroll") for (int m = 0; m < 4; ++m) _Pragma("unroll") for (int k = 0; k < 2; ++k) dst[m][k] = *(const PG8_LAS bf16x8*)(lds + PG8_SA(b, h) + aoff + m * 2048 + k * 1024); } while (0)
#define PG8_LDB(dst, b, h) do { _Pragma("unroll") for (int n = 0; n < 2; ++n) _Pragma("unroll") for (int k = 0; k < 2; ++k) dst[n][k] = *(const PG8_LAS bf16x8*)(lds + PG8_SB(b, h) + boff + n * 2048 + k * 1024); } while (0)
#define PG8_MMA(ai, bj, At, Bt) do { __builtin_amdgcn_s_setprio(1); _Pragma("unroll") for (int m = 0; m < 4; ++m) _Pragma("unroll") for (int n = 0; n < 2; ++n) _Pragma("unroll") for (int k = 0; k < 2; ++k) \
        acc[ai][bj][m][n] = __builtin_amdgcn_mfma_f32_16x16x32_bf16(Bt[n][k], At[m][k], acc[ai][bj][m][n], 0, 0, 0); __builtin_amdgcn_s_setprio(0); } while (0)
#define PG8_WAIT_V(n) asm volatile("s_waitcnt vmcnt(" #n ")" ::: "memory")
#define PG8_WAIT_L(n) asm volatile("s_waitcnt lgkmcnt(" #n ")" ::: "memory")
#define PG8_BAR __builtin_amdgcn_s_barrier()
#define PG8_SCHED __builtin_amdgcn_sched_barrier(0)
    Unit cur, nxt; int ui = 0;
    if (!S.next(0, cur)) return;
    f32x4 acc[2][2][4][2];
#pragma unroll
    for (int a = 0; a < 2; ++a)
#pragma unroll
        for (int b = 0; b < 2; ++b)
#pragma unroll
            for (int m = 0; m < 4; ++m)
#pragma unroll
                for (int n = 0; n < 2; ++n) acc[a][b][m][n] = (f32x4){0.f, 0.f, 0.f, 0.f};
    bf16x8 At[4][2], B0[2][2], B1[2][2];
    unsigned oC[2][2], oN[2][2];
    PG8_AOFF(oC, cur);
    const char* cB = (const char*)g.Bt + (size_t)cur.pn * tstep;
    S.a_ready(cur);
    PG8_STAGE(PG8_SB(0, 0), cB, voffB); PG8_STAGE(PG8_SB(0, 1), cB + hstep, voffB); PG8_STAGE(PG8_SA(0, 0), gA, oC[0]); PG8_STAGE(PG8_SA(0, 1), gA, oC[1]);
    if (wr == 1) PG8_BAR;
    PG8_WAIT_V(2); PG8_BAR;
    PG8_STAGE(PG8_SB(1, 0), cB + kstep, voffB); PG8_STAGE(PG8_SA(1, 0), gA + kstep, oC[0]); PG8_STAGE(PG8_SB(1, 1), cB + hstep + kstep, voffB);
    PG8_WAIT_V(6); PG8_BAR;
    for (;;) {
        const bool has_next = S.next(ui + 1, nxt);
        if (has_next) PG8_AOFF(oN, nxt);
        else {
#pragma unroll
            for (int _h = 0; _h < 2; ++_h)
#pragma unroll
                for (int _i = 0; _i < 2; ++_i) oN[_h][_i] = oC[_h][_i]; }
        const char* nB = has_next ? (const char*)g.Bt + (size_t)nxt.pn * tstep : cB;
        for (int t = 0; t < nt; t += 2) {
            const bool last = (t == nt - 2);
            if constexpr (Epi::MIDK) { if (t == (nt >> 1)) E.midk(acc, cur, wr, wc, fr, fq); }
            const char* a1 = gA + (size_t)(t + 1) * kstep;
            const char* a2 = last ? gA : gA + (size_t)(t + 2) * kstep; const char* b2 = last ? nB : cB + (size_t)(t + 2) * kstep;
            const char* a3 = a2 + kstep; const char* b3 = b2 + kstep;
            unsigned o2[2][2];
#pragma unroll
            for (int _h = 0; _h < 2; ++_h)
#pragma unroll
                for (int _i = 0; _i < 2; ++_i) o2[_h][_i] = last ? oN[_h][_i] : oC[_h][_i];
            if (last && has_next) S.a_ready(nxt);
            PG8_LDB(B0, 0, 0); PG8_LDB(B1, 0, 1); PG8_SCHED; PG8_LDA(At, 0, 0); PG8_STAGE(PG8_SA(1, 1), a1, oC[1]);
            PG8_WAIT_V(8); PG8_WAIT_L(0); PG8_BAR; PG8_MMA(0, 0, At, B0); PG8_MMA(0, 1, At, B1); PG8_BAR; PG8_SCHED;
            PG8_LDA(At, 0, 1); PG8_STAGE(PG8_SB(0, 0), b2, voffB); PG8_STAGE(PG8_SB(0, 1), b2 + hstep, voffB); PG8_STAGE(PG8_SA(0, 0), a2, o2[0]);
            PG8_WAIT_V(8); PG8_WAIT_L(0); PG8_BAR; PG8_MMA(1, 0, At, B0); PG8_MMA(1, 1, At, B1); PG8_BAR; PG8_SCHED;
            PG8_LDB(B0, 1, 0); PG8_LDB(B1, 1, 1); PG8_SCHED; PG8_LDA(At, 1, 0); PG8_STAGE(PG8_SA(0, 1), a2, o2[1]);
            PG8_WAIT_V(8); PG8_WAIT_L(0); PG8_BAR; PG8_MMA(0, 0, At, B0); PG8_MMA(0, 1, At, B1); PG8_BAR; PG8_SCHED;
            PG8_LDA(At, 1, 1); PG8_STAGE(PG8_SB(1, 0), b3, voffB); PG8_STAGE(PG8_SB(1, 1), b3 + hstep, voffB); PG8_STAGE(PG8_SA(1, 0), a3, o2[0]);
            PG8_WAIT_V(8); PG8_WAIT_L(0); PG8_BAR; PG8_MMA(1, 0, At, B0); PG8_MMA(1, 1, At, B1); PG8_BAR; PG8_SCHED;
        }
        if constexpr (ALIGN_EPI) { if (wr == 0) PG8_BAR; }
        E(acc, cur, wr, wc, fr, fq); S.done(cur);
        if (!has_next) break;
#pragma unroll
        for (int a = 0; a < 2; ++a)
#pragma unroll
            for (int b = 0; b < 2; ++b)
#pragma unroll
                for (int m = 0; m < 4; ++m)
#pragma unroll
                    for (int n = 0; n < 2; ++n) acc[a][b][m][n] = (f32x4){0.f, 0.f, 0.f, 0.f};
        cur = nxt; cB = nB; ++ui;
#pragma unroll
        for (int _h = 0; _h < 2; ++_h)
#pragma unroll
            for (int _i = 0; _i < 2; ++_i) oC[_h][_i] = oN[_h][_i];
        if constexpr (ALIGN_EPI) { if (wr == 1) PG8_BAR; }
    }
    PG8_WAIT_V(0);
    if constexpr (!ALIGN_EPI) { if (wr == 0) PG8_BAR; }
    PG8_BAR;
#undef PG8_AOFF
#undef PG8_SA
#undef PG8_SB
#undef PG8_STAGE
#undef PG8_LDA
#undef PG8_LDB
#undef PG8_MMA
#undef PG8_WAIT_V
#undef PG8_WAIT_L
#undef PG8_BAR
#undef PG8_SCHED
}
}
#define GAS __attribute__((address_space(1)))
#define LAS __attribute__((address_space(3)))
typedef unsigned short bf16;
typedef unsigned v4u __attribute__((ext_vector_type(4)));
typedef float f32x4 __attribute__((ext_vector_type(4)));
typedef short bf16x8 __attribute__((ext_vector_type(8)));
typedef GAS unsigned gu32;
typedef GAS unsigned long long gu64;
#define RLX_AGENT __ATOMIC_RELAXED, __HIP_MEMORY_SCOPE_AGENT
#define LDS_WAIT() asm volatile("s_waitcnt lgkmcnt(0)" ::: "memory")
#define VM_WAIT() asm volatile("s_waitcnt vmcnt(0)" ::: "memory")
__device__ __forceinline__ unsigned long long rt() { return __builtin_amdgcn_s_memrealtime(); }
__device__ __forceinline__ unsigned f2bf(float f) { unsigned u = __builtin_bit_cast(unsigned, f); return (u + 0x7fffu + ((u >> 16) & 1u)) >> 16; }
__device__ __forceinline__ unsigned pk2(float lo, float hi) { return f2bf(lo) | (f2bf(hi) << 16); }

#define XB_TMO      128
#define XB_XCNT(j)  (256  + 64 * (j))
#define XB_XSUB(j)  (1280 + 64 * (j))
#define XB_XGEN(j)  (2304 + 64 * (j))
#define XB_TOP      3328
#define XB_TOPGEN   3392
#define XCD_BAR_WORDS 3456
#define XB_SPIN_CAP (1u << 18)

__device__ __forceinline__ unsigned xb_ld(unsigned* p)              { return __hip_atomic_load(p, __ATOMIC_RELAXED, __HIP_MEMORY_SCOPE_AGENT); }
__device__ __forceinline__ unsigned xb_add(unsigned* p, unsigned v) { return __hip_atomic_fetch_add(p, v, __ATOMIC_RELAXED, __HIP_MEMORY_SCOPE_AGENT); }
__device__ __forceinline__ unsigned xb_xcc_id() { return (unsigned)__builtin_amdgcn_s_getreg((3 << 11) | 20) & 0xFu; }
#define XB_SPIN(cond, bar) do { unsigned _sp = 0; while (cond) { __builtin_amdgcn_s_sleep(1); \
    if ((++_sp & 255u) == 0u) { if (xb_ld(&(bar)[XB_TMO])) break; if (_sp > XB_SPIN_CAP) { atomicAdd(&(bar)[XB_TMO], 1u); break; } } } } while (0)

struct XcdBarrier {
    unsigned* bar; unsigned x;
    volatile LAS unsigned* st;
};

__device__ __forceinline__ XcdBarrier xcd_barrier_post(unsigned* bar, volatile LAS unsigned* st) {
    XcdBarrier b; b.bar = bar; b.x = xb_xcc_id(); b.st = st;
    if (threadIdx.x == 0) (void)xb_add(&bar[XB_XCNT(b.x)], 1u);
    return b;
}
__device__ __forceinline__ void xcd_barrier_complete(unsigned* bar, unsigned x, unsigned& nloc, unsigned& nx) {
    const unsigned G = gridDim.x * gridDim.y * gridDim.z;
    unsigned sum, cnt, mine, sp = 0u;
    for (;;) {
        sum = 0u; cnt = 0u; mine = 0u;
#pragma unroll
        for (unsigned j = 0; j < 16; ++j) { const unsigned c = xb_ld(&bar[XB_XCNT(j)]); sum += c; cnt += (c > 0u) ? 1u : 0u; mine = (j == x) ? c : mine; }
        if (sum == G) break;
        __builtin_amdgcn_s_sleep(1);
        if ((++sp & 255u) == 0u) { if (xb_ld(&bar[XB_TMO])) break; if (sp > XB_SPIN_CAP) { atomicAdd(&bar[XB_TMO], 1u); break; } }
    }
    nloc = mine > 0u ? mine : 1u; nx = cnt > 0u ? cnt : 1u;
}

__device__ __forceinline__ void xcd_barrier(const XcdBarrier& b) {
    asm volatile("s_waitcnt vmcnt(0)" ::: "memory");
    __syncthreads();
    if (threadIdx.x == 0) {
        unsigned* bar = b.bar;
        __builtin_amdgcn_s_waitcnt(0);
        unsigned nloc = b.st[0], nx = b.st[1];
        if (nloc == 0u) { xcd_barrier_complete(bar, b.x, nloc, nx); b.st[0] = nloc; b.st[1] = nx; }
        const unsigned old = xb_add(&bar[XB_XSUB(b.x)], 1u);
        const unsigned gen = old / nloc;
        if (old + 1u == (gen + 1u) * nloc) {
            __builtin_amdgcn_fence(__ATOMIC_RELEASE, "agent");
            asm volatile("s_waitcnt vmcnt(0)" ::: "memory");
            const unsigned og = xb_add(&bar[XB_TOP], 1u);
            const unsigned tg = og / nx;
            if (og + 1u == (tg + 1u) * nx) xb_add(&bar[XB_TOPGEN], 1u);
            else XB_SPIN(xb_ld(&bar[XB_TOPGEN]) == tg, bar);
            __builtin_amdgcn_fence(__ATOMIC_ACQUIRE, "agent");
            xb_add(&bar[XB_XGEN(b.x)], 1u);
            asm volatile("s_waitcnt vmcnt(0)" ::: "memory");
        } else {
            XB_SPIN(xb_ld(&bar[XB_XGEN(b.x)]) == gen, bar);
            __builtin_amdgcn_fence(__ATOMIC_ACQUIRE, "agent");
            asm volatile("s_waitcnt vmcnt(0)" ::: "memory");
        }
    }
    __syncthreads();
}
constexpr int M = 16384, D = 1024, DH = 512, NPROJ = 1536, NE = 32, TOPK = 4, NAS = M * TOPK, SLOTS = NAS + NE * 256, SEQ = 4096, NBATCH = 4, NCH = 32, NG = 32, NP = 64, DEPTH = 2;
constexpr float EPS = 1e-5f;
constexpr int NWAVES = 8;
constexpr size_t MiB = 1u << 20;
constexpr size_t WS_CTL = 0, CTL_ZERO_BYTES = 512 * 1024;
constexpr int CW_BAR = 1024;
constexpr int CW_Q = 6144;
constexpr int CW_CNT = 8192;
constexpr int CW_SS = 16384;
static_assert((CW_SS + DEPTH * 2 * M) * 4 <= (int)CTL_ZERO_BYTES, "CTL words inside the memset region");
constexpr size_t WS_RE = 1 * MiB;
constexpr size_t WS_RK = WS_RE + (size_t)NAS * 4;
constexpr size_t WS_GW = WS_RK + (size_t)NAS * 4;
constexpr size_t WS_SO = WS_GW + (size_t)NAS * 4;
constexpr size_t WS_TGU = WS_SO + (size_t)NAS * 4;
constexpr size_t WS_TDN = WS_TGU + 288 * 8 * 8;
constexpr size_t WS_META = WS_TDN + 288 * 4 * 8;
constexpr size_t WS_SSMP = 3 * MiB;
constexpr size_t SSMP_ABAR = 0, SSMP_A128 = 16384, SSMP_BBAR = 32768, SSMP_CTAB = SSMP_BBAR + 262144, SSMP_STRIDE = SSMP_CTAB + 262144;
constexpr size_t WS_BB16 = 5 * MiB;
constexpr size_t WS_CT16 = WS_BB16 + 512 * 1024;
constexpr size_t WS_RWT = 6 * MiB + 512 * 1024;
constexpr size_t WS_RSI = 7 * MiB;
constexpr size_t WS_WM = 6 * MiB;
static_assert(WS_META + 256 <= WS_SSMP && WS_SSMP + DEPTH * SSMP_STRIDE <= WS_BB16 && WS_WM + DEPTH * 4 * 128 * 128 * 2 <= 8 * MiB, "small tables");
constexpr size_t WS_W = 8 * MiB, W_IN = 0, W_OUT = 3 * MiB, W_GLU = 5 * MiB, W_GU = 6 * MiB, W_DN = 134 * MiB, W_STRIDE = 198 * MiB;
constexpr size_t WS_XB = WS_W + DEPTH * W_STRIDE;
constexpr size_t WS_P = WS_XB + 32 * MiB;
constexpr size_t WS_YG = WS_P + 48 * MiB;
constexpr size_t WS_MIX = WS_YG + 16 * MiB;
constexpr size_t WS_XA = WS_MIX + 32 * MiB;
constexpr size_t WS_XC = WS_XA + 64 * MiB;
constexpr size_t WS_H2 = WS_XC + 64 * MiB;
constexpr size_t WS_XS = WS_H2 + 32 * MiB;
constexpr size_t WS_ACT = WS_XS + 144 * MiB;
constexpr size_t WS_YB = WS_ACT + 144 * MiB;
constexpr size_t WS_EST = WS_YB + 144 * MiB;
constexpr size_t WS_SSP = WS_EST + 2 * MiB;
constexpr size_t WS_END = WS_SSP + 1 * MiB;
static_assert((size_t)SLOTS * D * 2 == 144 * MiB, "slot buffers");
constexpr int RING_OFF = 0, RING_BYTES = 131072;
constexpr int TAB_OFF = 131072;
constexpr int LDSCTL_OFF = 151552, MISC_OFF = LDSCTL_OFF + 6144;
constexpr int LDS_BYTES = 159744;
static_assert(MISC_OFF + 128 <= LDS_BYTES, "LDS map");
constexpr int PH_PER_LAYER = 10, N_PHASES = 1 + DEPTH * PH_PER_LAYER;
__device__ __forceinline__ float wave_sum(float v) {
#pragma unroll
    for (int o = 1; o < 64; o <<= 1) v += __shfl_xor(v, o);
    return v;
}
__device__ __forceinline__ float fast_sigmoid(float x) { return __builtin_amdgcn_rcpf(1.0f + __builtin_amdgcn_exp2f(-1.4426950409f * x)); }
__device__ __forceinline__ float gelu_tanh(float x) { const float u = x * (1.5957691216f + 0.0713548163f * x * x); return x * fast_sigmoid(u); }
__device__ __forceinline__ float bf2f(unsigned short b) { return __builtin_bit_cast(float, (unsigned)b << 16); }
__device__ __forceinline__ float bflo(unsigned w) { return __builtin_bit_cast(float, w << 16); }
__device__ __forceinline__ float bfhi(unsigned w) { return __builtin_bit_cast(float, w & 0xffff0000u); }
typedef unsigned v2u __attribute__((ext_vector_type(2)));
typedef float f32x2_t __attribute__((ext_vector_type(2)));

struct EpiInProj {
    static constexpr bool PERM = true, MIDK = false;
    bf16* P; const float* rs;
    __device__ __forceinline__ void operator()(const pg8::f32x4 (&acc)[2][2][4][2], const pg8::Unit& u, int wr, int wc, int fr, int fq) const {
        const int t = u.pn >> 1; const bool act = t < 2;
        bf16* base = P + (size_t)t * M * DH;
        const int row0 = u.pm * 256 + wr * 64 + fr, col0 = (u.pn & 1) * 256 + wc * 32 + 8 * fq;
#pragma unroll
        for (int ai = 0; ai < 2; ++ai)
#pragma unroll
            for (int m = 0; m < 4; ++m) { bf16* rowp = base + (size_t)(row0 + ai * 128 + m * 16) * DH + col0; const float rsv = rs[row0 + ai * 128 + m * 16];
#pragma unroll
                for (int bj = 0; bj < 2; ++bj) { pg8::f32x4 v0 = acc[ai][bj][m][0] * rsv, v1 = acc[ai][bj][m][1] * rsv;
                    if (act) {
#pragma unroll
                        for (int j = 0; j < 4; ++j) { v0[j] = gelu_tanh(v0[j]); v1[j] = gelu_tanh(v1[j]); } }
                    v4u w; w.x = pg8::cvt_pk_bf16(v0[0], v0[1]); w.y = pg8::cvt_pk_bf16(v0[2], v0[3]); w.z = pg8::cvt_pk_bf16(v1[0], v1[1]); w.w = pg8::cvt_pk_bf16(v1[2], v1[3]);
                    *(v4u*)(rowp + bj * 128) = w; } }
    }
};
struct EpiGlu {
    static constexpr bool PERM = true, MIDK = false;
    const bf16* YG; bf16* MIX; const float* bias; float* ss;
    __device__ __forceinline__ void operator()(const pg8::f32x4 (&acc)[2][2][4][2], const pg8::Unit& u, int wr, int wc, int fr, int fq) const {
        const int row0 = u.pm * 256 + wr * 64 + fr, col0 = u.pn * 256 + wc * 32 + 8 * fq;
        pg8::f32x4 bv[2][2];
#pragma unroll
        for (int bj = 0; bj < 2; ++bj)
#pragma unroll
            for (int n = 0; n < 2; ++n) bv[bj][n] = *(const pg8::f32x4*)(bias + col0 + bj * 128 + 4 * n);
#pragma unroll
        for (int ai = 0; ai < 2; ++ai)
#pragma unroll
            for (int m = 0; m < 4; ++m) { const int row = row0 + ai * 128 + m * 16; float sq = 0.f;
#pragma unroll
                for (int bj = 0; bj < 2; ++bj) { const int col = col0 + bj * 128;
                    const v4u yw = *(const v4u*)(YG + (size_t)row * DH + col);
                    const pg8::f32x4 g0 = acc[ai][bj][m][0] + bv[bj][0], g1 = acc[ai][bj][m][1] + bv[bj][1];
                    float o[8];
                    o[0] = bflo(yw.x) * fast_sigmoid(g0[0]); o[1] = bfhi(yw.x) * fast_sigmoid(g0[1]); o[2] = bflo(yw.y) * fast_sigmoid(g0[2]); o[3] = bfhi(yw.y) * fast_sigmoid(g0[3]);
                    o[4] = bflo(yw.z) * fast_sigmoid(g1[0]); o[5] = bfhi(yw.z) * fast_sigmoid(g1[1]); o[6] = bflo(yw.w) * fast_sigmoid(g1[2]); o[7] = bfhi(yw.w) * fast_sigmoid(g1[3]);
#pragma unroll
                    for (int j = 0; j < 8; ++j) sq += o[j] * o[j];
                    v4u w; w.x = pg8::cvt_pk_bf16(o[0], o[1]); w.y = pg8::cvt_pk_bf16(o[2], o[3]); w.z = pg8::cvt_pk_bf16(o[4], o[5]); w.w = pg8::cvt_pk_bf16(o[6], o[7]);
                    *(v4u*)(MIX + (size_t)row * D + DH + col) = w; }
                sq += __shfl_xor(sq, 16); sq += __shfl_xor(sq, 32);
                if (fq == 0) ss[(size_t)row * 8 + u.pn * 4 + wc] = sq; }
    }
};
struct EpiResid {
    static constexpr bool PERM = true, MIDK = false;
    const bf16* resid; bf16* out;
    __device__ __forceinline__ void operator()(const pg8::f32x4 (&acc)[2][2][4][2], const pg8::Unit& u, int wr, int wc, int fr, int fq) const {
        const int row0 = u.pm * 256 + wr * 64 + fr, col0 = u.pn * 256 + wc * 32 + 8 * fq;
#pragma unroll
        for (int ai = 0; ai < 2; ++ai)
#pragma unroll
            for (int m = 0; m < 4; ++m) { const size_t off = (size_t)(row0 + ai * 128 + m * 16) * D + col0;
#pragma unroll
                for (int bj = 0; bj < 2; ++bj) { const v4u r = *(const v4u*)(resid + off + bj * 128); const pg8::f32x4 a0 = acc[ai][bj][m][0], a1 = acc[ai][bj][m][1];
                    v4u w; w.x = pg8::cvt_pk_bf16(bflo(r.x) + a0[0], bfhi(r.x) + a0[1]); w.y = pg8::cvt_pk_bf16(bflo(r.y) + a0[2], bfhi(r.y) + a0[3]);
                    w.z = pg8::cvt_pk_bf16(bflo(r.z) + a1[0], bfhi(r.z) + a1[1]); w.w = pg8::cvt_pk_bf16(bflo(r.w) + a1[2], bfhi(r.w) + a1[3]);
                    *(v4u*)(out + off + bj * 128) = w; } }
    }
};
struct EpiSwiglu {
    static constexpr bool PERM = true, MIDK = false;
    bf16* ACT; const float* bgu;
    __device__ __forceinline__ void operator()(const pg8::f32x4 (&acc)[2][2][4][2], const pg8::Unit& u, int wr, int wc, int fr, int fq) const {
        const int e = u.pn >> 3, pn = u.pn & 7;
        const int row0 = u.pm * 256 + wr * 64 + fr, col0 = pn * 128 + wc * 32 + 8 * fq;
        const float* bg = bgu + (size_t)e * 2048 + col0;
        pg8::f32x4 bgl[2], bli[2];
#pragma unroll
        for (int n = 0; n < 2; ++n) { bgl[n] = *(const pg8::f32x4*)(bg + 4 * n); bli[n] = *(const pg8::f32x4*)(bg + 1024 + 4 * n); }
#pragma unroll
        for (int ai = 0; ai < 2; ++ai)
#pragma unroll
            for (int m = 0; m < 4; ++m) { float o[8];
#pragma unroll
                for (int n = 0; n < 2; ++n)
#pragma unroll
                    for (int j = 0; j < 4; ++j) { float gl = acc[ai][0][m][n][j] + bgl[n][j], li = acc[ai][1][m][n][j] + bli[n][j];
                        gl = fminf(gl, 7.0f); li = fminf(fmaxf(li, -7.0f), 7.0f);
                        o[4 * n + j] = gl * fast_sigmoid(1.702f * gl) * (li + 1.0f); }
                v4u w; w.x = pg8::cvt_pk_bf16(o[0], o[1]); w.y = pg8::cvt_pk_bf16(o[2], o[3]); w.z = pg8::cvt_pk_bf16(o[4], o[5]); w.w = pg8::cvt_pk_bf16(o[6], o[7]);
                *(v4u*)(ACT + (size_t)(row0 + ai * 128 + m * 16) * D + col0) = w; }
    }
};
struct EpiDown {
    static constexpr bool PERM = true, MIDK = false;
    bf16* YB; const float* bdn;
    __device__ __forceinline__ void operator()(const pg8::f32x4 (&acc)[2][2][4][2], const pg8::Unit& u, int wr, int wc, int fr, int fq) const {
        const int e = u.pn >> 2, pn = u.pn & 3;
        const int row0 = u.pm * 256 + wr * 64 + fr, col0 = pn * 256 + wc * 32 + 8 * fq;
        const float* bb = bdn + (size_t)e * D + col0;
        pg8::f32x4 bv[2][2];
#pragma unroll
        for (int bj = 0; bj < 2; ++bj)
#pragma unroll
            for (int n = 0; n < 2; ++n) bv[bj][n] = *(const pg8::f32x4*)(bb + bj * 128 + 4 * n);
#pragma unroll
        for (int ai = 0; ai < 2; ++ai)
#pragma unroll
            for (int m = 0; m < 4; ++m) { bf16* rowp = YB + (size_t)(row0 + ai * 128 + m * 16) * D + col0;
#pragma unroll
                for (int bj = 0; bj < 2; ++bj) { const pg8::f32x4 v0 = acc[ai][bj][m][0] + bv[bj][0], v1 = acc[ai][bj][m][1] + bv[bj][1];
                    v4u w; w.x = pg8::cvt_pk_bf16(v0[0], v0[1]); w.y = pg8::cvt_pk_bf16(v0[2], v0[3]); w.z = pg8::cvt_pk_bf16(v1[0], v1[1]); w.w = pg8::cvt_pk_bf16(v1[2], v1[3]);
                    *(v4u*)(rowp + bj * 128) = w; } }
    }
};
template <bool GATHER_>
struct LdsOrder {
    static constexpr bool GATHER = GATHER_;
    const LAS unsigned* tab; int n, G, c;
    const LAS int* offL; const LAS int* cntL; const int* tok; const LAS unsigned* rows;
    __device__ __forceinline__ bool next(int i, pg8::Unit& u) const {
        const int per = G >> 3, L = (i * 8 + (c & 7)) * per + (c >> 3);
        if (L >= n) return false;
        const unsigned e = (unsigned)__builtin_amdgcn_readfirstlane((int)tab[L]);
        u.pm = (int)(e & 0xfffu); u.pn = (int)(e >> 12); u.li = i;
        return true;
    }
    __device__ __forceinline__ unsigned arow(const pg8::Unit& u, int r) const { return rows[u.li * 256 + r]; }
    __device__ __forceinline__ void fill_rows(LAS unsigned* rw, int tid) const {
        pg8::Unit u;
        for (int i = 0; i < 10 && next(i, u); ++i)
            for (int r = tid; r < 256; r += NWAVES * 64) { const int e = u.pn >> 3, rank = u.pm * 256 + r - offL[e], cn = cntL[e], idx = rank < cn ? rank : cn - 1;
                rw[i * 256 + r] = (unsigned)tok[e * NAS + idx] * (unsigned)(D * 2); }
    }
    __device__ __forceinline__ void a_ready(const pg8::Unit&) const {}
    __device__ __forceinline__ void done(const pg8::Unit&) const {}
};
struct Frame {
    LAS unsigned char* lds;
    volatile LAS unsigned* MISC;
    gu32* ctl;
    unsigned char* ws;
    int tid, lane, wave, vcu, G;
};
struct Args { const float* in[28]; float* out; unsigned char* ws; int ph_lo, ph_hi; };
enum { I_X = 0, I_ANW, I_WIN, I_LNW, I_LNB, I_SGUW, I_SGUB, I_ARE, I_AIM, I_BRE, I_BIM, I_CRE, I_CIM, I_SD, I_LOGDT, I_GLUW, I_GLUB, I_ONA, I_ONB, I_WOUT, I_FNW, I_RW, I_RB, I_WGU, I_BGU, I_WDN, I_BDN, I_FINW };

__device__ __forceinline__ void tr_item(const float* W, int K, int N, bf16* WT, int k0, int n0, int drow0, const float* sc, LAS float* scr, int lane) {
    const int c4 = lane & 15, kr = lane >> 4;
    f32x4 v[16];
#pragma unroll
    for (int i = 0; i < 16; ++i) v[i] = __builtin_nontemporal_load((const GAS f32x4*)(W + (size_t)(k0 + 4 * i + kr) * N + n0 + 4 * c4));
#pragma unroll
    for (int i = 0; i < 16; ++i) { const int k = 4 * i + kr; const float s = sc ? sc[k0 + k] : 1.0f; LAS float* d = scr + k * 65 + 4 * c4;
        d[0] = v[i].x * s; d[1] = v[i].y * s; d[2] = v[i].z * s; d[3] = v[i].w * s; }
    LDS_WAIT(); asm volatile("" ::: "memory");
    const int nl = lane & 7, kc = lane >> 3;
#pragma unroll
    for (int j = 0; j < 8; ++j) { const int n = nl + 8 * j; const LAS float* s = scr + (8 * kc) * 65 + n;
        v4u o; o.x = pk2(s[0 * 65], s[1 * 65]); o.y = pk2(s[2 * 65], s[3 * 65]); o.z = pk2(s[4 * 65], s[5 * 65]); o.w = pk2(s[6 * 65], s[7 * 65]);
        __builtin_nontemporal_store(o, (GAS v4u*)(WT + (size_t)(drow0 + n) * K + k0 + 8 * kc)); }
    LDS_WAIT(); asm volatile("" ::: "memory");
}
__device__ __forceinline__ void rms_row_to_bf16(const float* xrow, bf16* orow, float* rsp, int lane) {
    const GAS f32x4* xr = (const GAS f32x4*)xrow + lane;
    f32x4 v[4]; float s = 0.f;
#pragma unroll
    for (int j = 0; j < 4; ++j) { v[j] = xr[64 * j]; s += (v[j].x * v[j].x + v[j].y * v[j].y) + (v[j].z * v[j].z + v[j].w * v[j].w); }
    const float rs = 1.0f / sqrtf(wave_sum(s) * (1.f / D) + EPS);
    GAS unsigned long long* o8 = (GAS unsigned long long*)orow + lane;
#pragma unroll
    for (int j = 0; j < 4; ++j) o8[64 * j] = (unsigned long long)pk2(v[j].x, v[j].y) | ((unsigned long long)pk2(v[j].z, v[j].w) << 32);
    if (lane == 0) *rsp = rs;
}
constexpr int I_IN = 16 * 24, I_OUT = 16 * 16, I_GLU = 8 * 8, I_GU = NE * 16 * 32, I_DN = NE * 16 * 16;
constexpr int Q_L0GU = I_GU, Q_L0DN = Q_L0GU + I_DN, Q_L1GU = Q_L0DN + I_GU, QN = Q_L1GU + I_DN;
__device__ __forceinline__ void conv_gu_item(Frame& F, const Args& A, int l, int r, LAS float* scr) {
    unsigned char* wb = F.ws + WS_W + (size_t)l * W_STRIDE;
    const int e = r / 512, rr = r % 512, kb = rr / 32, nb = rr % 32, n0 = 64 * nb, j = n0 & 1023, half = n0 >> 10, drow0 = (j >> 7) * 256 + half * 128 + (j & 127);
    tr_item(A.in[I_WGU] + ((size_t)l * NE + e) * D * 2048, D, 2048, (bf16*)(wb + W_GU) + (size_t)e * 2048 * D, 64 * kb, n0, drow0, A.in[I_FNW] + l * D, scr, F.lane);
}
__device__ __forceinline__ void conv_dn_item(Frame& F, const Args& A, int l, int r, LAS float* scr) {
    unsigned char* wb = F.ws + WS_W + (size_t)l * W_STRIDE;
    const int e = r / 256, rr = r % 256, kb = rr / 16, nb = rr % 16;
    tr_item(A.in[I_WDN] + ((size_t)l * NE + e) * D * D, D, D, (bf16*)(wb + W_DN) + (size_t)e * D * D, 64 * kb, 64 * nb, 64 * nb, nullptr, scr, F.lane);
}
__device__ __forceinline__ void conv_pull(Frame& F, const Args& A, int nb, int until) {
    LAS float* scr = (LAS float*)(F.lds + RING_OFF + F.wave * 16640);
    LAS int* qb = (LAS int*)(F.lds + LDSCTL_OFF + 768);
    for (int b = 0; b < nb; ++b) {
        if (F.tid == 0) qb[0] = (int)__hip_atomic_fetch_add(F.ctl + CW_Q, 8u, RLX_AGENT);
        __syncthreads();
        const int base = qb[0];
        __syncthreads();
        if (base >= QN) break;
        const int q = base + F.wave;
        if (q < Q_L0GU) conv_gu_item(F, A, 0, q, scr);
        else if (q < Q_L0DN) conv_dn_item(F, A, 0, q - Q_L0GU, scr);
        else if (q < Q_L1GU) conv_gu_item(F, A, 1, q - Q_L0DN, scr);
        else if (q < QN) conv_dn_item(F, A, 1, q - Q_L1GU, scr);
        if (base >= until) break;
    }
}
__device__ __forceinline__ void ph_prep(Frame& F, const Args& A) {
    LAS float* scr = (LAS float*)(F.lds + RING_OFF + F.wave * 16640);
    const int gw = F.vcu * NWAVES + F.wave, NGW = F.G * NWAVES;
    constexpr int PER_S = I_IN + I_OUT + I_GLU;
    for (int it = gw; it < DEPTH * PER_S; it += NGW) {
        const int l = it / PER_S; int r = it - l * PER_S;
        unsigned char* wb = F.ws + WS_W + (size_t)l * W_STRIDE;
        if (r < I_IN) { const int kb = r / 24, nb = r % 24; tr_item(A.in[I_WIN] + (size_t)l * D * NPROJ, D, NPROJ, (bf16*)(wb + W_IN), 64 * kb, 64 * nb, 64 * nb, A.in[I_ANW] + l * D, scr, F.lane); continue; } r -= I_IN;
        if (r < I_OUT) { const int kb = r / 16, nb = r % 16; const float* sc = (kb < 8) ? A.in[I_ONA] + l * DH : A.in[I_ONB] + l * DH - DH;
            tr_item(A.in[I_WOUT] + (size_t)l * D * D, D, D, (bf16*)(wb + W_OUT), 64 * kb, 64 * nb, 64 * nb, sc, scr, F.lane); continue; } r -= I_OUT;
        { const int kb = r / 8, nb = r % 8; tr_item(A.in[I_GLUW] + (size_t)l * DH * DH, DH, DH, (bf16*)(wb + W_GLU), 64 * kb, 64 * nb, 64 * nb, nullptr, scr, F.lane); }
    }
    for (int m = gw; m < M; m += NGW) rms_row_to_bf16(A.in[I_X] + (size_t)m * D, (bf16*)(F.ws + WS_XB) + (size_t)m * D, (float*)(F.ws + WS_RSI) + m, F.lane);
    for (int i = (F.vcu * NWAVES + F.wave) * 64 + F.lane; i < DEPTH * NG * NP; i += F.G * NWAVES * 64) {
        const int l = i / (NG * NP), gp = i % (NG * NP), g = gp / NP, p = gp % NP;
        unsigned char* sp = F.ws + WS_SSMP + (size_t)l * SSMP_STRIDE;
        const float dt = expf(A.in[I_LOGDT][l * NG + g]), ar = A.in[I_ARE][i], ai = A.in[I_AIM][i];
        const float ex = expf(dt * ar); float sn, cs; sincosf(dt * ai, &sn, &cs);
        const float abr = ex * cs, abi = ex * sn;
        const float nr = abr - 1.0f, ni = abi, den = ar * ar + ai * ai, cr = (nr * ar + ni * ai) / den, ci = (ni * ar - nr * ai) / den;
        ((float*)(sp + SSMP_ABAR))[gp * 2] = abr; ((float*)(sp + SSMP_ABAR))[gp * 2 + 1] = abi;
        float pr = abr, pi = abi;
#pragma unroll
        for (int k = 0; k < 7; ++k) { const float t = pr * pr - pi * pi; pi = 2.0f * pr * pi; pr = t; }
        ((float*)(sp + SSMP_A128))[gp * 2] = pr; ((float*)(sp + SSMP_A128))[gp * 2 + 1] = pi;
        float* bb = (float*)(sp + SSMP_BBAR) + (size_t)gp * 32;
        const float* bre = A.in[I_BRE] + (size_t)i * 16; const float* bim = A.in[I_BIM] + (size_t)i * 16;
#pragma unroll
        for (int h = 0; h < 16; ++h) { const float br = bre[h], bi = bim[h]; bb[h] = cr * br - ci * bi; bb[16 + h] = cr * bi + ci * br; }
        float* ct = (float*)(sp + SSMP_CTAB) + (size_t)g * 128 * 16;
        const float* cre = A.in[I_CRE] + (size_t)(l * NG + g) * 16 * NP; const float* cim = A.in[I_CIM] + (size_t)(l * NG + g) * 16 * NP;
#pragma unroll
        for (int h = 0; h < 16; ++h) { ct[p * 16 + h] = cre[h * NP + p]; ct[(64 + p) * 16 + h] = -cim[h * NP + p]; }
        bf16* bb16 = (bf16*)(F.ws + WS_BB16) + (size_t)(l * NG + g) * 2048; bf16* ct16 = (bf16*)(F.ws + WS_CT16) + (size_t)(l * NG + g) * 2048;
#pragma unroll
        for (int h = 0; h < 16; ++h) { bb16[((p >> 5) * 32 + (p & 31)) * 16 + h] = (bf16)f2bf(bb[h]); bb16[((2 + (p >> 5)) * 32 + (p & 31)) * 16 + h] = (bf16)f2bf(bb[16 + h]);
            ct16[h * 128 + p] = (bf16)f2bf(cre[h * NP + p]); ct16[h * 128 + 64 + p] = (bf16)f2bf(-cim[h * NP + p]); }
    }
    for (int i = (F.vcu * NWAVES + F.wave) * 64 + F.lane; i < DEPTH * D * NE; i += F.G * NWAVES * 64) { const int l = i / (D * NE), k = (i / NE) % D, e = i % NE;
        const float w = A.in[I_RW][i] * A.in[I_FNW][l * D + k]; const unsigned hi = f2bf(w); const float lo = w - __builtin_bit_cast(float, hi << 16);
        bf16* t = (bf16*)(F.ws + WS_RWT) + (size_t)l * 2 * NE * D; t[e * D + k] = (bf16)hi; t[(NE + e) * D + k] = (bf16)f2bf(lo); }
    for (int i = (F.vcu * NWAVES + F.wave) * 64 + F.lane; i < DEPTH * 4 * 128 * 128; i += F.G * NWAVES * 64) { const int t = (i >> 7) & 127, sx = i & 127;
        ((bf16*)(F.ws + WS_WM))[i] = (sx <= t) ? (bf16)f2bf(A.in[I_SGUW][i]) : (bf16)0; }
}

typedef short v4i16_t __attribute__((ext_vector_type(4)));
__device__ __forceinline__ void sgu_chunk_mfma(Frame& F, const Args& A, int l, int c) {
    const bf16* UG = (const bf16*)(F.ws + WS_P); const bf16* VG = UG + (size_t)M * DH;
    bf16* MIX = (bf16*)(F.ws + WS_MIX);
    const bf16* Wm = (const bf16*)(F.ws + WS_WM) + (size_t)l * 4 * 128 * 128;
    constexpr int PITCH = 1056;
    LAS unsigned char* vn = F.lds + RING_OFF;
    const float* lnw = A.in[I_LNW] + l * DH; const float* lnb = A.in[I_LNB] + l * DH;
    {
        const f32x4 w0 = *(const GAS f32x4*)(lnw + 8 * F.lane), w1 = *(const GAS f32x4*)(lnw + 8 * F.lane + 4), b0 = *(const GAS f32x4*)(lnb + 8 * F.lane), b1 = *(const GAS f32x4*)(lnb + 8 * F.lane + 4);
        const float ww[8] = {w0.x, w0.y, w0.z, w0.w, w1.x, w1.y, w1.z, w1.w}, bb[8] = {b0.x, b0.y, b0.z, b0.w, b1.x, b1.y, b1.z, b1.w};
#pragma unroll 4
        for (int r = F.wave * 16; r < F.wave * 16 + 16; ++r) {
            const v4u w = *(const GAS v4u*)(VG + (size_t)(c * 128 + r) * DH + 8 * F.lane);
            float v[8] = {bflo(w.x), bfhi(w.x), bflo(w.y), bfhi(w.y), bflo(w.z), bfhi(w.z), bflo(w.w), bfhi(w.w)};
            float s = 0.f, s2 = 0.f;
#pragma unroll
            for (int j = 0; j < 8; ++j) { s += v[j]; s2 += v[j] * v[j]; }
            s = wave_sum(s); s2 = wave_sum(s2);
            const float mean = s * (1.f / DH), var = fmaxf(s2 * (1.f / DH) - mean * mean, 0.f), rstd = 1.0f / sqrtf(var + EPS);
            float o[8];
#pragma unroll
            for (int j = 0; j < 8; ++j) o[j] = (v[j] - mean) * rstd * ww[j] + bb[j];
            v4u ow; ow.x = pk2(o[0], o[1]); ow.y = pk2(o[2], o[3]); ow.z = pk2(o[4], o[5]); ow.w = pk2(o[6], o[7]);
            *(LAS v4u*)(vn + r * PITCH + 16 * F.lane) = ow;
        }
    }
    __syncthreads();
    const int w = F.wave, fr = F.lane & 15, G = F.lane >> 4, rr = (F.lane >> 2) & 3, cc = F.lane & 3;
    const int nks = (w >> 1) + 1;
    const int trow = c * 128 + w * 16 + fr;
    LAS unsigned char* trb = vn + (4 * G + rr) * PITCH + 8 * cc;
    pg8::f32x4 acc[4][8];
#pragma unroll
    for (int h = 0; h < 4; ++h)
#pragma unroll
        for (int dt = 0; dt < 8; ++dt) acc[h][dt] = (pg8::f32x4){0.f, 0.f, 0.f, 0.f};
    for (int ks = 0; ks < nks; ++ks) {
#pragma unroll
        for (int h = 0; h < 4; ++h) {
            const bf16* wp = Wm + ((size_t)h * 128 + w * 16 + fr) * 128 + ks * 32 + 4 * G;
            const v2u wlo = *(const GAS v2u*)wp, whi = *(const GAS v2u*)(wp + 16);
            const v4u wf4 = (v4u){wlo.x, wlo.y, whi.x, whi.y};
            const bf16x8 wf = __builtin_bit_cast(bf16x8, wf4);
#pragma unroll
            for (int dt = 0; dt < 8; ++dt) {
                const LAS unsigned char* pa = trb + ks * 32 * PITCH + (h * 128 + dt * 16) * 2;
                const v4i16_t a0 = __builtin_amdgcn_ds_read_tr16_b64_v4i16((LAS v4i16_t*)pa), a1 = __builtin_amdgcn_ds_read_tr16_b64_v4i16((LAS v4i16_t*)(pa + 16 * PITCH));
                const bf16x8 af = (bf16x8){a0[0], a0[1], a0[2], a0[3], a1[0], a1[1], a1[2], a1[3]};
                acc[h][dt] = __builtin_amdgcn_mfma_f32_16x16x32_bf16(af, wf, acc[h][dt], 0, 0, 0);
            }
        }
    }
    float ss = 0.f;
#pragma unroll
    for (int h = 0; h < 4; ++h) { const float bt = A.in[I_SGUB][(size_t)(l * 4 + h) * 128 + w * 16 + fr];
#pragma unroll
        for (int dt = 0; dt < 8; ++dt) { const v2u uw = *(const GAS v2u*)(UG + (size_t)trow * DH + h * 128 + dt * 16 + 4 * G);
            pg8::f32x4 y = acc[h][dt] + bt; y[0] *= bflo(uw.x); y[1] *= bfhi(uw.x); y[2] *= bflo(uw.y); y[3] *= bfhi(uw.y);
            acc[h][dt] = y; ss += (y[0] * y[0] + y[1] * y[1]) + (y[2] * y[2] + y[3] * y[3]); } }
    ss += __shfl_xor(ss, 16); ss += __shfl_xor(ss, 32);
    const float rs = 1.0f / sqrtf(ss * (1.f / DH) + EPS);
#pragma unroll
    for (int h = 0; h < 4; ++h)
#pragma unroll
        for (int dt = 0; dt < 8; ++dt) { const pg8::f32x4 y = acc[h][dt] * rs; v2u o; o.x = pk2(y[0], y[1]); o.y = pk2(y[2], y[3]);
            *(GAS v2u*)(MIX + (size_t)trow * D + h * 128 + dt * 16 + 4 * G) = o; }
    __syncthreads();
}

typedef float f32x16 __attribute__((ext_vector_type(16)));
template <bool FULL>
__device__ __forceinline__ void ssm_item(Frame& F, const Args& A, int l, int g, int bp, int ch, float* xcarry = nullptr, bool cont = false) {
    const unsigned char* sp = F.ws + WS_SSMP + (size_t)l * SSMP_STRIDE;
    const bf16* US = (const bf16*)(F.ws + WS_P) + (size_t)2 * M * DH;
    const int lane = F.lane, H = lane >> 5, s = lane & 31;
    const float* abp = (const float*)(sp + SSMP_ABAR) + (size_t)g * NP * 2;
    const float a0r = abp[s * 2], a0i = abp[s * 2 + 1], a1r = abp[(32 + s) * 2], a1i = abp[(32 + s) * 2 + 1];
    bf16x8 bq[4];
    { const bf16* bb16 = (const bf16*)(F.ws + WS_BB16) + (size_t)(l * NG + g) * 2048;
#pragma unroll
      for (int q = 0; q < 4; ++q) bq[q] = *(const GAS bf16x8*)(bb16 + (q * 32 + s) * 16 + 8 * H); }
    float x0r = 0.f, x0i = 0.f, x1r = 0.f, x1i = 0.f;
    const int b = 2 * bp + H;
    if (FULL && cont) { x0r = xcarry[0]; x0i = xcarry[1]; x1r = xcarry[2]; x1i = xcarry[3]; }
    if (FULL && !cont) {
        const float* a8p = (const float*)(sp + SSMP_A128) + (size_t)g * NP * 2;
        const float c0r = a8p[s * 2], c0i = a8p[s * 2 + 1], c1r = a8p[(32 + s) * 2], c1i = a8p[(32 + s) * 2 + 1];
        const float* est = (const float*)(F.ws + WS_EST) + (((size_t)b * NG + g) * NCH * NP) * 2;
        for (int cb = 0; cb < ch; cb += 8) {
            f32x2_t ea[8], eb[8];
#pragma unroll
            for (int k = 0; k < 8; ++k) { const int cc = (cb + k < ch) ? cb + k : ch - 1; ea[k] = *(const GAS f32x2_t*)(est + ((size_t)cc * NP + s) * 2); eb[k] = *(const GAS f32x2_t*)(est + ((size_t)cc * NP + 32 + s) * 2); }
#pragma unroll
            for (int k = 0; k < 8; ++k) if (cb + k < ch) {
                float nr = c0r * x0r - c0i * x0i + ea[k].x, ni = c0r * x0i + c0i * x0r + ea[k].y; x0r = nr; x0i = ni;
                nr = c1r * x1r - c1i * x1i + eb[k].x; ni = c1r * x1i + c1i * x1r + eb[k].y; x1r = nr; x1i = ni; } }
    }
    const int ai = lane & 31;
    const bf16* ap = US + ((size_t)(2 * bp + ((ai >> 2) & 1)) * SEQ + ch * 128 + (ai & 3) + 4 * (ai >> 3)) * DH + g * 16 + 8 * H;
    constexpr int XP = 272;
    LAS unsigned char* xt = F.lds + RING_OFF + F.wave * (32 * XP);
    bf16x8 cq[4]; f32x4 dv = (f32x4){0.f, 0.f, 0.f, 0.f};
    const int fr = lane & 15, G = lane >> 4;
    if (FULL) { const bf16* ct16 = (const bf16*)(F.ws + WS_CT16) + (size_t)(l * NG + g) * 2048;
#pragma unroll
        for (int q = 0; q < 4; ++q) cq[q] = *(const GAS bf16x8*)(ct16 + fr * 128 + q * 32 + 8 * G);
        dv = *(const GAS f32x4*)(A.in[I_SD] + l * DH + g * 16 + 4 * G); }
    bf16x8 af = *(const GAS bf16x8*)ap;
    for (int tb = 0; tb < 8; ++tb) {
        const bf16x8 afn = *(const GAS bf16x8*)(ap + (size_t)((tb < 7 ? tb + 1 : tb) * 16) * DH);
        v2u uwp[2] = {(v2u){0u, 0u}, (v2u){0u, 0u}};
        if (FULL) {
#pragma unroll
            for (int hb = 0; hb < 2; ++hb) uwp[hb] = *(const GAS v2u*)(US + ((size_t)(2 * bp + hb) * SEQ + ch * 128 + tb * 16 + fr) * DH + g * 16 + 4 * G); }
        f32x16 z;
#pragma unroll
        for (int i = 0; i < 16; ++i) z[i] = 0.f;
        f32x16 r0 = __builtin_amdgcn_mfma_f32_32x32x16_bf16(af, bq[0], z, 0, 0, 0);
        f32x16 r1 = __builtin_amdgcn_mfma_f32_32x32x16_bf16(af, bq[1], z, 0, 0, 0);
        f32x16 i0 = __builtin_amdgcn_mfma_f32_32x32x16_bf16(af, bq[2], z, 0, 0, 0);
        f32x16 i1 = __builtin_amdgcn_mfma_f32_32x32x16_bf16(af, bq[3], z, 0, 0, 0);
#pragma unroll
        for (int t = 0; t < 16; ++t) {
            float nr = a0r * x0r - a0i * x0i + r0[t], ni = a0r * x0i + a0i * x0r + i0[t]; x0r = nr; x0i = ni;
            nr = a1r * x1r - a1i * x1i + r1[t]; ni = a1r * x1i + a1i * x1r + i1[t]; x1r = nr; x1i = ni;
            if (FULL) { LAS bf16* xr = (LAS bf16*)(xt + (H * 16 + t) * XP) + s;
                unsigned p0 = pg8::cvt_pk_bf16_raw(x0r, x0r), p1 = pg8::cvt_pk_bf16_raw(x1r, x1r), p2 = pg8::cvt_pk_bf16_raw(x0i, x0i), p3 = pg8::cvt_pk_bf16_raw(x1i, x1i);
                asm volatile("s_nop 1" : "+v"(p0), "+v"(p1), "+v"(p2), "+v"(p3));
                xr[0] = (bf16)p0; xr[32] = (bf16)p1; xr[64] = (bf16)p2; xr[96] = (bf16)p3;
                asm volatile("s_nop 1" :: "v"(p0), "v"(p1), "v"(p2), "v"(p3) : "memory"); }
        }
        if (FULL) {
            LDS_WAIT(); asm volatile("" ::: "memory");
#pragma unroll
            for (int hb = 0; hb < 2; ++hb) {
                pg8::f32x4 y = (pg8::f32x4){0.f, 0.f, 0.f, 0.f};
#pragma unroll
                for (int q = 0; q < 4; ++q) { const bf16x8 xf = *(const LAS bf16x8*)(xt + (hb * 16 + fr) * XP + q * 64 + 16 * G); y = __builtin_amdgcn_mfma_f32_16x16x32_bf16(cq[q], xf, y, 0, 0, 0); }
                const size_t row = (size_t)(2 * bp + hb) * SEQ + ch * 128 + tb * 16 + fr;
                const v2u uw = uwp[hb];
                y[0] += dv.x * bflo(uw.x); y[1] += dv.y * bfhi(uw.x); y[2] += dv.z * bflo(uw.y); y[3] += dv.w * bfhi(uw.y);
                v2u o; o.x = pk2(gelu_tanh(y[0]), gelu_tanh(y[1])); o.y = pk2(gelu_tanh(y[2]), gelu_tanh(y[3]));
                *(GAS v2u*)((bf16*)(F.ws + WS_YG) + row * DH + g * 16 + 4 * G) = o;
            }
            LDS_WAIT(); asm volatile("" ::: "memory");
        }
        af = afn;
    }
    if (FULL && xcarry) { xcarry[0] = x0r; xcarry[1] = x0i; xcarry[2] = x1r; xcarry[3] = x1i; }
    if (!FULL) { float* est = (float*)(F.ws + WS_EST) + ((((size_t)b * NG + g) * NCH + ch) * NP) * 2;
        *(GAS f32x2_t*)(est + s * 2) = (f32x2_t){x0r, x0i}; *(GAS f32x2_t*)(est + (32 + s) * 2) = (f32x2_t){x1r, x1i}; }
}

__device__ __forceinline__ void ph_normb(Frame& F, const Args& A, int l) {
    bf16* MIX = (bf16*)(F.ws + WS_MIX);
    const float* ssp = (const float*)(F.ws + WS_SSP);
    const int gw = F.vcu * NWAVES + F.wave, NGW = F.G * NWAVES;
    for (int mb = gw; mb < M; mb += 8 * NGW) {
        f32x4 p0[8], p1[8]; v4u w[8];
#pragma unroll
        for (int j = 0; j < 8; ++j) { const int m = mb + j * NGW; if (m < M) { p0[j] = *(const GAS f32x4*)(ssp + (size_t)m * 8); p1[j] = *(const GAS f32x4*)(ssp + (size_t)m * 8 + 4); w[j] = *(const GAS v4u*)(MIX + (size_t)m * D + DH + 8 * F.lane); } }
#pragma unroll
        for (int j = 0; j < 8; ++j) { const int m = mb + j * NGW; if (m < M) {
            const float s = 1.0f / sqrtf((((p0[j].x + p0[j].y) + (p0[j].z + p0[j].w)) + ((p1[j].x + p1[j].y) + (p1[j].z + p1[j].w))) * (1.f / DH) + EPS);
            v4u o; o.x = pk2(bflo(w[j].x) * s, bfhi(w[j].x) * s); o.y = pk2(bflo(w[j].y) * s, bfhi(w[j].y) * s); o.z = pk2(bflo(w[j].z) * s, bfhi(w[j].z) * s); o.w = pk2(bflo(w[j].w) * s, bfhi(w[j].w) * s);
            *(GAS v4u*)(MIX + (size_t)m * D + DH + 8 * F.lane) = o; } }
    }
}

__device__ __forceinline__ void ph_route_mfma(Frame& F, const Args& A, int l, int cbank) {
    const bf16* XA = (const bf16*)(F.ws + WS_XA); bf16* H2 = (bf16*)(F.ws + WS_H2);
    int* RE = (int*)(F.ws + WS_RE); int* RK = (int*)(F.ws + WS_RK); float* GW = (float*)(F.ws + WS_GW);
    gu32* cnt = F.ctl + CW_CNT + cbank * NE;
    constexpr int WP = 2064, PL_OFF = 64 * WP, SSQ_OFF = PL_OFF + 2 * 64 * 32 * 4;
    static_assert(SSQ_OFF + 512 + 2048 <= LDSCTL_OFF, "route LDS map");
    LAS unsigned char* wt = F.lds + RING_OFF;
    LAS float* PL = (LAS float*)(F.lds + PL_OFF); LAS float* SSQ = (LAS float*)(F.lds + SSQ_OFF);
    LAS int* lcnt = (LAS int*)(F.lds + LDSCTL_OFF); LAS int* lbase = lcnt + 32;
    LAS int* as_e = (LAS int*)(F.lds + LDSCTL_OFF + 1024); LAS int* as_lr = as_e + 256; LAS float* as_g = (LAS float*)(as_lr + 256);
    const float* rb = A.in[I_RB] + l * NE;
    { const bf16* src = (const bf16*)(F.ws + WS_RWT) + (size_t)l * 2 * NE * D;
      v4u wv[16];
#pragma unroll
      for (int q = 0; q < 16; ++q) { const int i = F.tid + q * (NWAVES * 64), row = i >> 7, ch = i & 127; wv[q] = *(const GAS v4u*)(src + (size_t)row * D + ch * 8); }
#pragma unroll
      for (int q = 0; q < 16; ++q) { const int i = F.tid + q * (NWAVES * 64), row = i >> 7, ch = i & 127; *(LAS v4u*)(wt + row * WP + ch * 16) = wv[q]; } }
    const int fr = F.lane & 15, G = F.lane >> 4, rg = F.wave & 3;
    for (int blk = F.vcu; blk < M / 64; blk += F.G) {
        if (F.tid < 32) lcnt[F.tid] = 0;
        __syncthreads();
        if (F.wave < 4) {
            v4u xall[2][16];
#pragma unroll
            for (int kh = 0; kh < 2; ++kh) { const bf16* xp = XA + (size_t)(blk * 64 + rg * 16 + fr) * D + kh * 512 + 8 * G;
#pragma unroll
                for (int ks = 0; ks < 16; ++ks) xall[kh][ks] = *(const GAS v4u*)(xp + ks * 32); }
#pragma unroll
            for (int kh = 0; kh < 2; ++kh) {
                pg8::f32x4 a0 = (pg8::f32x4){0.f, 0.f, 0.f, 0.f}, a1 = a0; float ssq = 0.f;
                const LAS unsigned char* wp = wt + fr * WP + (kh * 512 + 8 * G) * 2;
#pragma unroll
                for (int ks = 0; ks < 16; ++ks) {
                    const v4u xw = xall[kh][ks]; const bf16x8 xb = __builtin_bit_cast(bf16x8, xw);
                    { const float x0 = bflo(xw.x), x1 = bfhi(xw.x), x2 = bflo(xw.y), x3 = bfhi(xw.y), x4 = bflo(xw.z), x5 = bfhi(xw.z), x6 = bflo(xw.w), x7 = bfhi(xw.w);
                      ssq += ((x0 * x0 + x1 * x1) + (x2 * x2 + x3 * x3)) + ((x4 * x4 + x5 * x5) + (x6 * x6 + x7 * x7)); }
                    const bf16x8 w0h = *(const LAS bf16x8*)(wp + ks * 64), w1h = *(const LAS bf16x8*)(wp + 16 * WP + ks * 64);
                    const bf16x8 w0l = *(const LAS bf16x8*)(wp + 32 * WP + ks * 64), w1l = *(const LAS bf16x8*)(wp + 48 * WP + ks * 64);
                    a0 = __builtin_amdgcn_mfma_f32_16x16x32_bf16(w0h, xb, a0, 0, 0, 0); a1 = __builtin_amdgcn_mfma_f32_16x16x32_bf16(w1h, xb, a1, 0, 0, 0);
                    a0 = __builtin_amdgcn_mfma_f32_16x16x32_bf16(w0l, xb, a0, 0, 0, 0); a1 = __builtin_amdgcn_mfma_f32_16x16x32_bf16(w1l, xb, a1, 0, 0, 0);
                }
                ssq += __shfl_xor(ssq, 16); ssq += __shfl_xor(ssq, 32);
                LAS float* pl = PL + ((kh * 64 + rg * 16 + fr) * 32);
                *(LAS pg8::f32x4*)(pl + 4 * G) = a0; *(LAS pg8::f32x4*)(pl + 16 + 4 * G) = a1;
                if (G == 0) SSQ[kh * 64 + rg * 16 + fr] = ssq;
            }
        }
        __syncthreads();
#pragma unroll 1
        for (int rr = 0; rr < 8; rr += 2) {
            const int L = F.lane, e = L >> 1;
            int lr[2]; float rs[2], val[2], mx[2], ex[2], den[2]; int rank[2]; bool win[2]; v2u xw[2][4];
#pragma unroll
            for (int u = 0; u < 2; ++u) { lr[u] = F.wave * 8 + rr + u; const GAS v2u* xr = (const GAS v2u*)(XA + (size_t)(blk * 64 + lr[u]) * D) + L;
#pragma unroll
                for (int j = 0; j < 4; ++j) xw[u][j] = xr[64 * j]; }
#pragma unroll
            for (int u = 0; u < 2; ++u) { rs[u] = 1.0f / sqrtf((SSQ[lr[u]] + SSQ[64 + lr[u]]) * (1.f / D) + EPS);
                val[u] = (PL[lr[u] * 32 + e] + PL[(64 + lr[u]) * 32 + e]) * rs[u] + rb[e];
                LAS float* lrow = (LAS float*)(F.lds + SSQ_OFF + 512) + (F.wave * 2 + u) * 32;
                if ((L & 1) == 0) lrow[e] = val[u]; }
            LDS_WAIT(); asm volatile("" ::: "memory");
#pragma unroll
            for (int u = 0; u < 2; ++u) { const LAS float* lrow = (const LAS float*)(F.lds + SSQ_OFF + 512) + (F.wave * 2 + u) * 32; const float v = val[u]; int rk = 0;
#pragma unroll
                for (int q = 0; q < 8; ++q) { const f32x4 o = *(const LAS f32x4*)(lrow + 4 * q);
                    rk += (o.x > v || (o.x == v && 4 * q + 0 < e)) ? 1 : 0; rk += (o.y > v || (o.y == v && 4 * q + 1 < e)) ? 1 : 0;
                    rk += (o.z > v || (o.z == v && 4 * q + 2 < e)) ? 1 : 0; rk += (o.w > v || (o.w == v && 4 * q + 3 < e)) ? 1 : 0; }
                rank[u] = rk; mx[u] = v; }
            asm volatile("" ::: "memory");
#pragma unroll
            for (int o = 2; o < 64; o <<= 1) { mx[0] = fmaxf(mx[0], __shfl_xor(mx[0], o)); mx[1] = fmaxf(mx[1], __shfl_xor(mx[1], o)); }
#pragma unroll
            for (int u = 0; u < 2; ++u) { win[u] = (rank[u] < 4) && ((L & 1) == 0); ex[u] = win[u] ? __expf(val[u] - mx[u]) : 0.f; den[u] = ex[u]; }
#pragma unroll
            for (int o = 1; o < 64; o <<= 1) { den[0] += __shfl_xor(den[0], o); den[1] += __shfl_xor(den[1], o); }
#pragma unroll
            for (int u = 0; u < 2; ++u) {
                GAS v2u* o8 = (GAS v2u*)(H2 + (size_t)(blk * 64 + lr[u]) * D) + L;
#pragma unroll
                for (int j = 0; j < 4; ++j) { v2u o; o.x = pk2(bflo(xw[u][j].x) * rs[u], bfhi(xw[u][j].x) * rs[u]); o.y = pk2(bflo(xw[u][j].y) * rs[u], bfhi(xw[u][j].y) * rs[u]); o8[64 * j] = o; }
                if (win[u]) { const int slr = __hip_atomic_fetch_add(lcnt + e, 1, __ATOMIC_RELAXED, __HIP_MEMORY_SCOPE_WORKGROUP);
                    const int ix = lr[u] * 4 + rank[u]; as_e[ix] = e; as_lr[ix] = slr; as_g[ix] = ex[u] / den[u]; } }
            LDS_WAIT(); asm volatile("" ::: "memory");
        }
        __syncthreads();
        if (F.tid < 32) lbase[F.tid] = (int)__hip_atomic_fetch_add(cnt + F.tid, (unsigned)lcnt[F.tid], RLX_AGENT);
        __syncthreads();
        if (F.tid < 256) { const int a = blk * 256 + F.tid, e = as_e[F.tid], rk = lbase[e] + as_lr[F.tid]; RE[a] = e; RK[a] = rk; GW[a] = as_g[F.tid]; ((int*)(F.ws + WS_XS))[e * NAS + rk] = a >> 2; }
        __syncthreads();
    }
}

__device__ __forceinline__ int moe_tables(Frame& F, int l, int NT, int GS, bool build, bool fresh = true) {
    gu32* cnt = F.ctl + CW_CNT + l * NE;
    LAS int* offL = (LAS int*)(F.lds + TAB_OFF); LAS int* cntL = offL + 64; LAS unsigned* tab = (LAS unsigned*)(F.lds + TAB_OFF + 1024);
    if (fresh) {
    if (F.tid < NE) cntL[F.tid] = (int)__hip_atomic_load(cnt + F.tid, RLX_AGENT);
    __syncthreads();
    if (F.tid == 0) { int o = 0; for (int e = 0; e < NE; ++e) { offL[e] = o; o += (cntL[e] + 255) & ~255; } offL[NE] = o; }
    __syncthreads();
    }
    if (build && F.tid < NE) { const int e = F.tid, t0 = offL[e] >> 8, mt = (offL[e + 1] - offL[e]) >> 8;
        int idx = t0 * NT;
        for (int pg = 0; pg * GS < mt; ++pg) { const int gs = (mt - pg * GS) < GS ? (mt - pg * GS) : GS;
            for (int pn = 0; pn < NT; ++pn) for (int pi = 0; pi < gs; ++pi) { tab[idx] = (unsigned)(t0 + pg * GS + pi) | ((unsigned)(e * NT + pn) << 12); ++idx; } } }
    __syncthreads();
    return (offL[NE] >> 8) * NT;
}

__device__ __forceinline__ void ph_combine(Frame& F, const Args& A, int l) {
    const bf16* XA = (const bf16*)(F.ws + WS_XA); bf16* XC = (bf16*)(F.ws + WS_XC); float* RSI = (float*)(F.ws + WS_RSI) + M;
    const bf16* YB = (const bf16*)(F.ws + WS_YB); const int* RE = (const int*)(F.ws + WS_RE); const int* RK = (const int*)(F.ws + WS_RK); const float* GW = (const float*)(F.ws + WS_GW);
    (void)moe_tables(F, l, 4, 8, false, false);
    const LAS int* offL = (const LAS int*)(F.lds + TAB_OFF);
    const int gw = F.vcu * NWAVES + F.wave, NGW = F.G * NWAVES;
    const bool last = (l == DEPTH - 1);
    for (int jb = 0; gw + jb * NGW < M; jb += 16) {
        int slot_l = 0; float g_l = 0.f;
        { const int ml = gw + (jb + (F.lane >> 2)) * NGW;
          if (ml < M) { const int a = ml * 4 + (F.lane & 3); slot_l = offL[__hip_atomic_load(RE + a, RLX_AGENT)] + __hip_atomic_load(RK + a, RLX_AGENT); g_l = __hip_atomic_load(GW + a, RLX_AGENT); } }
        v2u xa[4], ya[4][4], xb[4], yb[4][4];
#define COMB_LOAD(X, Y, J) do { const int m_ = gw + (jb + (J)) * NGW; const GAS v2u* xr_ = (const GAS v2u*)(XA + (size_t)m_ * D) + F.lane; \
            _Pragma("unroll") for (int q = 0; q < 4; ++q) (X)[q] = xr_[64 * q]; \
            _Pragma("unroll") for (int k = 0; k < 4; ++k) { const int slot_ = __builtin_amdgcn_readlane(slot_l, 4 * (J) + k); const GAS v2u* yp_ = (const GAS v2u*)(YB + (size_t)slot_ * D) + F.lane; \
                _Pragma("unroll") for (int q = 0; q < 4; ++q) (Y)[k][q] = yp_[64 * q]; } } while (0)
        COMB_LOAD(xa, ya, 0);
#pragma unroll 1
        for (int jj = 0; jj < 16; ++jj) {
            const int m = gw + (jb + jj) * NGW;
            if (m >= M) break;
            const bool more = (jj < 15) && (m + NGW < M);
            if (more) COMB_LOAD(xb, yb, jj + 1);
            f32x4 v[4];
#pragma unroll
            for (int q = 0; q < 4; ++q) v[q] = (f32x4){bflo(xa[q].x), bfhi(xa[q].x), bflo(xa[q].y), bfhi(xa[q].y)};
#pragma unroll
            for (int k = 0; k < 4; ++k) { const float g = __builtin_bit_cast(float, __builtin_amdgcn_readlane(__builtin_bit_cast(int, g_l), 4 * jj + k));
#pragma unroll
                for (int q = 0; q < 4; ++q) { const v2u w = ya[k][q]; v[q].x += g * bflo(w.x); v[q].y += g * bfhi(w.x); v[q].z += g * bflo(w.y); v[q].w += g * bfhi(w.y); } }
            float sq = 0.f;
#pragma unroll
            for (int q = 0; q < 4; ++q) sq += (v[q].x * v[q].x + v[q].y * v[q].y) + (v[q].z * v[q].z + v[q].w * v[q].w);
            const float rs = 1.0f / sqrtf(wave_sum(sq) * (1.f / D) + EPS);
            if (!last) {
                GAS unsigned long long* o8 = (GAS unsigned long long*)(XC + (size_t)m * D) + F.lane;
#pragma unroll
                for (int q = 0; q < 4; ++q) o8[64 * q] = (unsigned long long)pk2(v[q].x, v[q].y) | ((unsigned long long)pk2(v[q].z, v[q].w) << 32);
                if (F.lane == 0) RSI[m] = rs;
            } else {
                GAS f32x4* oo = (GAS f32x4*)(A.out + (size_t)m * D) + F.lane; const GAS f32x4* fw = (const GAS f32x4*)A.in[I_FINW] + F.lane;
#pragma unroll
                for (int q = 0; q < 4; ++q) { const f32x4 w = fw[64 * q]; oo[64 * q] = v[q] * rs * w; }
            }
            if (more) {
#pragma unroll
                for (int q = 0; q < 4; ++q) { xa[q] = xb[q];
#pragma unroll
                    for (int k = 0; k < 4; ++k) ya[k][q] = yb[k][q]; } }
        }
#undef COMB_LOAD
    }
}
template <class Epi, class Sched>
__device__ __forceinline__ void run_gemm(Frame& F, const pg8::Gemm& g, const Sched& S, const Epi& E) {
    pg8::gemm_phase<Epi, Sched, true>(F.lds + RING_OFF, g, S, E);
}
__global__ void __launch_bounds__(NWAVES * 64, 2) mk_fwd(Args args) {
    extern __shared__ __attribute__((aligned(16))) unsigned char lds[];
    Frame F;
    F.lds = (LAS unsigned char*)lds;
    F.MISC = (volatile LAS unsigned*)(F.lds + MISC_OFF);
    F.tid = threadIdx.x; F.lane = F.tid & 63; F.wave = __builtin_amdgcn_readfirstlane(F.tid >> 6);
    F.G = gridDim.x; { const int bx = blockIdx.x; F.vcu = (F.G % 8 == 0) ? (bx % 8) * (F.G / 8) + bx / 8 : bx; }
    F.ws = args.ws; F.ctl = (gu32*)(args.ws + WS_CTL);
    for (int u = F.tid; u < (LDS_BYTES - LDSCTL_OFF) / 4; u += NWAVES * 64) ((LAS unsigned*)(F.lds + LDSCTL_OFF))[u] = 0u;
    __syncthreads();
#if N_LAUNCH_MODE == 1
    XcdBarrier bar = xcd_barrier_post((unsigned*)(F.ctl + CW_BAR), F.MISC + 8);
#define GRID_BAR() xcd_barrier(bar)
#else
#define GRID_BAR() do { } while (0)
#endif
    const int lo = args.ph_lo, hi = args.ph_hi;
#define IN(k) (lo <= (k) && (k) < hi)
#define SEAM(k) do { if (IN(k) && IN((k) + 1)) GRID_BAR(); } while (0)

#ifndef PH_MASK
#define PH_MASK 0xfff
#endif
#define PHX(k) (((PH_MASK) >> (k)) & 1)
#ifndef DUP_MASK
#define DUP_MASK 0
#endif
#define REPS(k) (1 + (((DUP_MASK) >> (k)) & 1))
    if (PHX(11) && IN(0)) { for (int rep = 0; rep < REPS(11); ++rep) { if (rep) GRID_BAR(); ph_prep(F, args); __syncthreads(); conv_pull(F, args, 1 << 20, QN); }     SEAM(0); }

#define LAUNDER() do { asm volatile("" : "+v"(F.tid)); F.lane = F.tid & 63; F.wave = __builtin_amdgcn_readfirstlane(F.tid >> 6); } while (0)
    for (int l = 0; l < DEPTH; ++l) {
        const int pb = 1 + l * PH_PER_LAYER;
        unsigned char* wb = F.ws + WS_W + (size_t)l * W_STRIDE;
        const bf16* xin = (l == 0) ? (const bf16*)(F.ws + WS_XB) : (const bf16*)(F.ws + WS_XC);
        if (PHX(0) && IN(pb + 0)) { for (int rep = 0; rep < REPS(0); ++rep) { if (rep) GRID_BAR();
            pg8::Gemm g{xin, (const bf16*)(wb + W_IN), M, NPROJ, D}; pg8::StaticOrder S; S.init(M, NPROJ, F.G, (int)blockIdx.x);
            EpiInProj E{(bf16*)(F.ws + WS_P), (const float*)(F.ws + WS_RSI) + (size_t)l * M};
            run_gemm(F, g, S, E);
            } SEAM(pb + 0);
        }
        if (PHX(1) && IN(pb + 1)) { for (int rep = 0; rep < REPS(1); ++rep) { if (rep) GRID_BAR(); LAUNDER();
            for (int bi = (int)blockIdx.x; bi < 256; bi += F.G) { const int wi = bi * 8 + F.wave; ssm_item<false>(F, args, l, wi >> 6, (wi >> 5) & 1, wi & 31); }
            } SEAM(pb + 1);
        }
        if (PHX(2) && IN(pb + 2)) { for (int rep = 0; rep < REPS(2); ++rep) { if (rep) GRID_BAR(); LAUNDER();
            for (int bi = (int)blockIdx.x; bi < 256; bi += F.G) { if (F.wave < 4) { float xs[4]; const int wi = bi * 8 + 2 * F.wave;
                ssm_item<true>(F, args, l, wi >> 6, (wi >> 5) & 1, wi & 31, xs, false); ssm_item<true>(F, args, l, wi >> 6, (wi >> 5) & 1, (wi & 31) + 1, xs, true); } }
            } SEAM(pb + 2);
        }
        if (PHX(3) && IN(pb + 3)) { for (int rep = 0; rep < REPS(3); ++rep) { if (rep) GRID_BAR();
            pg8::Gemm g{(const bf16*)(F.ws + WS_YG), (const bf16*)(wb + W_GLU), M, DH, DH}; pg8::StaticOrder S; S.init(M, DH, F.G, (int)blockIdx.x);
            EpiGlu E{(const bf16*)(F.ws + WS_YG), (bf16*)(F.ws + WS_MIX), args.in[I_GLUB] + l * DH, (float*)(F.ws + WS_SSP)};
            run_gemm(F, g, S, E);
            LAUNDER();
            if (F.G >= 256) { for (int c = (int)blockIdx.x - 128; c >= 0 && c < 128; c += F.G) sgu_chunk_mfma(F, args, l, c); }
            else { for (int c = (int)blockIdx.x; c < 128; c += F.G) sgu_chunk_mfma(F, args, l, c); }
            } SEAM(pb + 3);
        }
        if (PHX(4) && IN(pb + 4)) { for (int rep = 0; rep < REPS(4); ++rep) { if (rep) GRID_BAR(); LAUNDER(); ph_normb(F, args, l); } SEAM(pb + 4); }
        if (PHX(5) && IN(pb + 5)) { for (int rep = 0; rep < REPS(5); ++rep) { if (rep) GRID_BAR();
            pg8::Gemm g{(const bf16*)(F.ws + WS_MIX), (const bf16*)(wb + W_OUT), M, D, D}; pg8::StaticOrder S; S.init(M, D, F.G, (int)blockIdx.x);
            EpiResid E{xin, (bf16*)(F.ws + WS_XA)};
            run_gemm(F, g, S, E);
            } SEAM(pb + 5);
        }
        if (PHX(6) && IN(pb + 6)) { for (int rep = 0; rep < REPS(6); ++rep) { if (rep) GRID_BAR(); LAUNDER(); ph_route_mfma(F, args, l, (REPS(6) == 2 && rep == 0) ? 2 + l : l); } SEAM(pb + 6); }
        if (PHX(7) && IN(pb + 7)) { for (int rep = 0; rep < REPS(7); ++rep) { if (rep) GRID_BAR();
            const int n = moe_tables(F, l, 8, 4, true);
            pg8::Gemm g{(const bf16*)(F.ws + WS_H2), (const bf16*)(wb + W_GU), M, NE * 2048, D};
            LdsOrder<true> S{(const LAS unsigned*)(F.lds + TAB_OFF + 1024), n, F.G, (int)blockIdx.x, (const LAS int*)(F.lds + TAB_OFF), (const LAS int*)(F.lds + TAB_OFF) + 64, (const int*)(F.ws + WS_XS), (const LAS unsigned*)(F.lds + TAB_OFF + 10240)};
            EpiSwiglu E{(bf16*)(F.ws + WS_ACT), args.in[I_BGU] + (size_t)l * NE * 2048};
            S.fill_rows((LAS unsigned*)(F.lds + TAB_OFF + 10240), F.tid); __syncthreads();
            run_gemm(F, g, S, E);
            } SEAM(pb + 7);
        }
        if (PHX(8) && IN(pb + 8)) { for (int rep = 0; rep < REPS(8); ++rep) { if (rep) GRID_BAR();
            const int n = moe_tables(F, l, 4, 8, true, REPS(8) == 2 || REPS(9) == 2);
            pg8::Gemm g{(const bf16*)(F.ws + WS_ACT), (const bf16*)(wb + W_DN), SLOTS, NE * D, D};
            LdsOrder<false> S{(const LAS unsigned*)(F.lds + TAB_OFF + 1024), n, F.G, (int)blockIdx.x, (const LAS int*)(F.lds + TAB_OFF), (const LAS int*)(F.lds + TAB_OFF) + 64, (const int*)(F.ws + WS_XS), (const LAS unsigned*)(F.lds + TAB_OFF + 10240)};
            EpiDown E{(bf16*)(F.ws + WS_YB), args.in[I_BDN] + (size_t)l * NE * D};
            run_gemm(F, g, S, E);
            } SEAM(pb + 8);
        }
        if (PHX(9) && IN(pb + 9)) { for (int rep = 0; rep < REPS(9); ++rep) { if (rep) GRID_BAR(); LAUNDER(); ph_combine(F, args, l); } SEAM(pb + 9); }
    }
#undef IN
#undef SEAM
}

extern "C" void kernel_launch(void* const* d_in, const int* in_sizes, int n_in, void* d_out, int out_size, void* d_ws, size_t ws_size, hipStream_t stream) {
    static int grid = 0;
    if (grid == 0) {
        if (n_in != 28 || in_sizes[0] != M * D || out_size != M * D || ws_size < WS_END) { fprintf(stderr, "kernel_launch: unexpected shapes (n_in %d, in0 %d, out %d, ws %zu < %zu); nothing launched\n", n_in, n_in > 0 ? in_sizes[0] : -1, out_size, ws_size, (size_t)WS_END); grid = -1; return; }
        int dev = 0, cus = 0, per_cu = 0;
        if (hipGetDevice(&dev) != hipSuccess || hipDeviceGetAttribute(&cus, hipDeviceAttributeMultiprocessorCount, dev) != hipSuccess) { grid = -1; return; }
        if (hipFuncSetAttribute((const void*)mk_fwd, hipFuncAttributeMaxDynamicSharedMemorySize, LDS_BYTES) != hipSuccess) { fprintf(stderr, "kernel_launch: hipFuncSetAttribute failed\n"); grid = -1; return; }
        if (hipOccupancyMaxActiveBlocksPerMultiprocessor(&per_cu, (const void*)mk_fwd, NWAVES * 64, LDS_BYTES) != hipSuccess || per_cu < 1) { fprintf(stderr, "kernel_launch: occupancy query reports %d workgroups per CU\n", per_cu); }
        (void)hipGetLastError();
        grid = cus;
        if (grid % 8 != 0 || grid < 8) { fprintf(stderr, "kernel_launch: %d CUs: unsupported\n", grid); grid = -1; return; }
    }
    if (grid < 0) return;
    if (hipMemsetAsync((char*)d_ws + WS_CTL, 0, CTL_ZERO_BYTES, stream) != hipSuccess) return;
    Args a{};
    for (int i = 0; i < 28; ++i) a.in[i] = (const float*)d_in[i];
    a.out = (float*)d_out; a.ws = (unsigned char*)d_ws;
#if N_LAUNCH_MODE == 1
    a.ph_lo = 0; a.ph_hi = N_PHASES;
    hipLaunchKernelGGL(mk_fwd, dim3(grid), dim3(NWAVES * 64), LDS_BYTES, stream, a);
#else
    for (int p = 0; p < N_PHASES; ++p) { a.ph_lo = p; a.ph_hi = p + 1; hipLaunchKernelGGL(mk_fwd, dim3(grid), dim3(NWAVES * 64), LDS_BYTES, stream, a); }
#endif
}
```

```cpp
#include <hip/hip_runtime.h>
#include <cstdio>
#include <cstdint>
#ifndef N_LAUNCH_MODE
#define N_LAUNCH_MODE 1
#endif
namespace pg8 {
#define PG8_LAS __attribute__((address_space(3)))
typedef unsigned short bf16_t;
typedef short bf16x8 __attribute__((ext_vector_type(8)));
typedef float f32x4 __attribute__((ext_vector_type(4)));
typedef unsigned u32x4 __attribute__((ext_vector_type(4)));
constexpr int BM = 256, BK = 64, HALF = 128, HTB = HALF * BK * 2  , STAGE_BYTES = 8 * HTB, NXCD = 8, WGM = 8;

__host__ __device__ __forceinline__ int lds_byte(int r, int c) { const int st = (r >> 4) * 2 + (c >> 5), rr = r & 15, cc = c & 31, ob = rr * 64 + cc * 2; return st * 1024 + (ob ^ (((ob >> 9) & 1) << 5)); }
__host__ __device__ __forceinline__ void stage_rc(int b, int& R, int& C) { const int st = b / 1024, sb = b % 1024, swz = sb ^ (((sb >> 9) & 1) << 5); R = (st >> 1) * 16 + swz / 64; C = (st & 1) * 32 + (swz % 64) / 2; }
__host__ __device__ __forceinline__ int perm32(int rho) { const int n = rho >> 4, i = rho & 15; return 8 * (i >> 2) + 4 * n + (i & 3); }

struct Unit { int pm, pn, li; };
struct Gemm { const bf16_t* A; const bf16_t* Bt; int M, N, K; };

struct StaticOrder {
    static constexpr bool GATHER = false;
    int nM, nN, nwg, G, c;
    __host__ __device__ void init(int M, int N, int G_, int c_) { nM = M / BM; nN = N / BM; nwg = nM * nN; G = G_; c = c_; }
    __host__ __device__ bool next(int i, Unit& u) const {
        const long L = (long)i * G + c; if (L >= nwg) return false;
        int wgid = (int)L; { const int q = nwg / NXCD, r = nwg % NXCD, xcd = wgid % NXCD, off = wgid / NXCD; wgid = (xcd < r ? xcd * (q + 1) : r * (q + 1) + (xcd - r) * q) + off; }
        const int nig = WGM * nN, gid = wgid / nig, fm = gid * WGM, gsz = (nM - fm) < WGM ? (nM - fm) : WGM;
        u.pm = fm + ((wgid % nig) % gsz); u.pn = (wgid % nig) / gsz; u.li = i; return true;
    }
    __device__ __forceinline__ void a_ready(const Unit&) const {}
    __device__ __forceinline__ void done(const Unit&) const {}
};

typedef __bf16 bf16x2_t __attribute__((ext_vector_type(2)));
typedef float f32x2c_t __attribute__((ext_vector_type(2)));
__device__ __forceinline__ unsigned cvt_pk_bf16(float lo, float hi) { const bf16x2_t r = __builtin_convertvector((f32x2c_t){lo, hi}, bf16x2_t); unsigned u = __builtin_bit_cast(unsigned, r); asm volatile("s_nop 1" : "+v"(u)); return u; }
__device__ __forceinline__ unsigned cvt_pk_bf16_raw(float lo, float hi) { const bf16x2_t r = __builtin_convertvector((f32x2c_t){lo, hi}, bf16x2_t); return __builtin_bit_cast(unsigned, r); }
template <class Epi, class Sched, bool ALIGN_EPI = true>
__device__ __forceinline__ void gemm_phase(PG8_LAS unsigned char* lds, const Gemm g, const Sched& S, const Epi& E) {
    int tid_ = threadIdx.x; asm volatile("" : "+v"(tid_));
    const int tid = tid_, wid = __builtin_amdgcn_readfirstlane(tid >> 6), lane = tid & 63, wr = wid >> 2, wc = wid & 3, fr = lane & 15, fq = lane >> 4;
    const int K = g.K, nt = K / BK;
    int RA[2]; unsigned cofA[2], voffB[2];
#pragma unroll
    for (int i = 0; i < 2; ++i) { int R, C; stage_rc(tid * 16 + i * 8192, R, C); const int Rb = Epi::PERM ? ((R & ~31) + perm32(R & 31)) : R;
        RA[i] = R; cofA[i] = (unsigned)C * 2u; voffB[i] = (unsigned)(Rb * K + C) * 2u; }
    const size_t kstep = (size_t)(BK * 2);
    const size_t hstep = (size_t)HALF * K * 2;
    const size_t tstep = 2 * hstep;
    const unsigned ldsw = (unsigned)wid * 1024u;
    const int aoff = lds_byte(wr * 64 + fr, fq * 8), boff = lds_byte(wc * 32 + fr, fq * 8);
    const char* gA = (const char*)g.A;
#define PG8_AOFF(dst, u) do { _Pragma("unroll") for (int _h = 0; _h < 2; ++_h) _Pragma("unroll") for (int _i = 0; _i < 2; ++_i) { \
        if constexpr (Sched::GATHER) dst[_h][_i] = S.arow((u), _h * HALF + RA[_i]) + cofA[_i]; \
        else dst[_h][_i] = (unsigned)(((u).pm * BM + _h * HALF + RA[_i]) * K) * 2u + cofA[_i]; } } while (0)
#define PG8_SA(b, h) (((b) * 2 + (h)) * HTB)
#define PG8_SB(b, h) ((4 + (b) * 2 + (h)) * HTB)
#define PG8_STAGE(bufoff, gbase, voff) do { _Pragma("unroll") for (int _i = 0; _i < 2; ++_i) \
        __builtin_amdgcn_global_load_lds((const unsigned*)((const char*)(gbase) + (voff)[_i]), (PG8_LAS unsigned*)(lds + (bufoff) + ldsw + _i * 8192), 16, 0, 0); } while (0)
#define PG8_LDA(dst, b, h) do { _Pragma("unroll") for (int m = 0; m < 4; ++m) _Pragma("unroll") for (int k = 0; k < 2; ++k) dst[m][k] = *(const PG8_LAS bf16x8*)(lds + PG8_SA(b, h) + aoff + m * 2048 + k * 1024); } while (0)
#define PG8_LDB(dst, b, h) do { _Pragma("unroll") for (int n = 0; n < 2; ++n) _Pragma("unroll") for (int k = 0; k < 2; ++k) dst[n][k] = *(const PG8_LAS bf16x8*)(lds + PG8_SB(b, h) + boff + n * 2048 + k * 1024); } while (0)
#define PG8_MMA(ai, bj, At, Bt) do { __builtin_amdgcn_s_setprio(1); _Pragma("unroll") for (int m = 0; m < 4; ++m) _Pragma("unroll") for (int n = 0; n < 2; ++n) _Pragma("unroll") for (int k = 0; k < 2; ++k) \
        acc[ai][bj][m][n] = __builtin_amdgcn_mfma_f32_16x16x32_bf16(Bt[n][k], At[m][k], acc[ai][bj][m][n], 0, 0, 0); __builtin_amdgcn_s_setprio(0); } while (0)
#define PG8_WAIT_V(n) asm volatile("s_waitcnt vmcnt(" #n ")" ::: "memory")
#define PG8_WAIT_L(n) asm volatile("s_waitcnt lgkmcnt(" #n ")" ::: "memory")
#define PG8_BAR __builtin_amdgcn_s_barrier()
#define PG8_SCHED __builtin_amdgcn_sched_barrier(0)
    Unit cur, nxt; int ui = 0;
    if (!S.next(0, cur)) return;
    f32x4 acc[2][2][4][2];
#pragma unroll
    for (int a = 0; a < 2; ++a)
#pragma unroll
        for (int b = 0; b < 2; ++b)
#pragma unroll
            for (int m = 0; m < 4; ++m)
#pragma unroll
                for (int n = 0; n < 2; ++n) acc[a][b][m][n] = (f32x4){0.f, 0.f, 0.f, 0.f};
    bf16x8 At[4][2], B0[2][2], B1[2][2];
    unsigned oC[2][2], oN[2][2];
    PG8_AOFF(oC, cur);
    const char* cB = (const char*)g.Bt + (size_t)cur.pn * tstep;
    S.a_ready(cur);
    PG8_STAGE(PG8_SB(0, 0), cB, voffB); PG8_STAGE(PG8_SB(0, 1), cB + hstep, voffB); PG8_STAGE(PG8_SA(0, 0), gA, oC[0]); PG8_STAGE(PG8_SA(0, 1), gA, oC[1]);
    if (wr == 1) PG8_BAR;
    PG8_WAIT_V(2); PG8_BAR;
    PG8_STAGE(PG8_SB(1, 0), cB + kstep, voffB); PG8_STAGE(PG8_SA(1, 0), gA + kstep, oC[0]); PG8_STAGE(PG8_SB(1, 1), cB + hstep + kstep, voffB);
    PG8_WAIT_V(6); PG8_BAR;
    for (;;) {
        const bool has_next = S.next(ui + 1, nxt);
        if (has_next) PG8_AOFF(oN, nxt);
        else {
#pragma unroll
            for (int _h = 0; _h < 2; ++_h)
#pragma unroll
                for (int _i = 0; _i < 2; ++_i) oN[_h][_i] = oC[_h][_i]; }
        const char* nB = has_next ? (const char*)g.Bt + (size_t)nxt.pn * tstep : cB;
        for (int t = 0; t < nt; t += 2) {
            const bool last = (t == nt - 2);
            if constexpr (Epi::MIDK) { if (t == (nt >> 1)) E.midk(acc, cur, wr, wc, fr, fq); }
            const char* a1 = gA + (size_t)(t + 1) * kstep;
            const char* a2 = last ? gA : gA + (size_t)(t + 2) * kstep; const char* b2 = last ? nB : cB + (size_t)(t + 2) * kstep;
            const char* a3 = a2 + kstep; const char* b3 = b2 + kstep;
            unsigned o2[2][2];
#pragma unroll
            for (int _h = 0; _h < 2; ++_h)
#pragma unroll
                for (int _i = 0; _i < 2; ++_i) o2[_h][_i] = last ? oN[_h][_i] : oC[_h][_i];
            if (last && has_next) S.a_ready(nxt);
            PG8_LDB(B0, 0, 0); PG8_LDB(B1, 0, 1); PG8_SCHED; PG8_LDA(At, 0, 0); PG8_STAGE(PG8_SA(1, 1), a1, oC[1]);
            PG8_WAIT_V(8); PG8_WAIT_L(0); PG8_BAR; PG8_MMA(0, 0, At, B0); PG8_MMA(0, 1, At, B1); PG8_BAR; PG8_SCHED;
            PG8_LDA(At, 0, 1); PG8_STAGE(PG8_SB(0, 0), b2, voffB); PG8_STAGE(PG8_SB(0, 1), b2 + hstep, voffB); PG8_STAGE(PG8_SA(0, 0), a2, o2[0]);
            PG8_WAIT_V(8); PG8_WAIT_L(0); PG8_BAR; PG8_MMA(1, 0, At, B0); PG8_MMA(1, 1, At, B1); PG8_BAR; PG8_SCHED;
            PG8_LDB(B0, 1, 0); PG8_LDB(B1, 1, 1); PG8_SCHED; PG8_LDA(At, 1, 0); PG8_STAGE(PG8_SA(0, 1), a2, o2[1]);
            PG8_WAIT_V(8); PG8_WAIT_L(0); PG8_BAR; PG8_MMA(0, 0, At, B0); PG8_MMA(0, 1, At, B1); PG8_BAR; PG8_SCHED;
            PG8_LDA(At, 1, 1); PG8_STAGE(PG8_SB(1, 0), b3, voffB); PG8_STAGE(PG8_SB(1, 1), b3 + hstep, voffB); PG8_STAGE(PG8_SA(1, 0), a3, o2[0]);
            PG8_WAIT_V(8); PG8_WAIT_L(0); PG8_BAR; PG8_MMA(1, 0, At, B0); PG8_MMA(1, 1, At, B1); PG8_BAR; PG8_SCHED;
        }
        if constexpr (ALIGN_EPI) { if (wr == 0) PG8_BAR; }
        E(acc, cur, wr, wc, fr, fq); S.done(cur);
        if (!has_next) break;
#pragma unroll
        for (int a = 0; a < 2; ++a)
#pragma unroll
            for (int b = 0; b < 2; ++b)
#pragma unroll
                for (int m = 0; m < 4; ++m)
#pragma unroll
                    for (int n = 0; n < 2; ++n) acc[a][b][m][n] = (f32x4){0.f, 0.f, 0.f, 0.f};
        cur = nxt; cB = nB; ++ui;
#pragma unroll
        for (int _h = 0; _h < 2; ++_h)
#pragma unroll
            for (int _i = 0; _i < 2; ++_i) oC[_h][_i] = oN[_h][_i];
        if constexpr (ALIGN_EPI) { if (wr == 1) PG8_BAR; }
    }
    PG8_WAIT_V(0);
    if constexpr (!ALIGN_EPI) { if (wr == 0) PG8_BAR; }
    PG8_BAR;
#undef PG8_AOFF
#undef PG8_SA
#undef PG8_SB
#undef PG8_STAGE
#undef PG8_LDA
#undef PG8_LDB
#undef PG8_MMA
#undef PG8_WAIT_V
#undef PG8_WAIT_L
#undef PG8_BAR
#undef PG8_SCHED
}
}
#define GAS __attribute__((address_space(1)))
#define LAS __attribute__((address_space(3)))
typedef unsigned short bf16;
typedef unsigned v4u __attribute__((ext_vector_type(4)));
typedef float f32x4 __attribute__((ext_vector_type(4)));
typedef short bf16x8 __attribute__((ext_vector_type(8)));
typedef GAS unsigned gu32;
typedef GAS unsigned long long gu64;
#define RLX_AGENT __ATOMIC_RELAXED, __HIP_MEMORY_SCOPE_AGENT
#define LDS_WAIT() asm volatile("s_waitcnt lgkmcnt(0)" ::: "memory")
#define VM_WAIT() asm volatile("s_waitcnt vmcnt(0)" ::: "memory")
__device__ __forceinline__ unsigned long long rt() { return __builtin_amdgcn_s_memrealtime(); }
__device__ __forceinline__ unsigned f2bf(float f) { unsigned u = __builtin_bit_cast(unsigned, f); return (u + 0x7fffu + ((u >> 16) & 1u)) >> 16; }
__device__ __forceinline__ unsigned pk2(float lo, float hi) { return f2bf(lo) | (f2bf(hi) << 16); }

#define XB_TMO      128
#define XB_XCNT(j)  (256  + 64 * (j))
#define XB_XSUB(j)  (1280 + 64 * (j))
#define XB_XGEN(j)  (2304 + 64 * (j))
#define XB_TOP      3328
#define XB_TOPGEN   3392
#define XCD_BAR_WORDS 3456
#define XB_SPIN_CAP (1u << 18)

__device__ __forceinline__ unsigned xb_ld(unsigned* p)              { return __hip_atomic_load(p, __ATOMIC_RELAXED, __HIP_MEMORY_SCOPE_AGENT); }
__device__ __forceinline__ unsigned xb_add(unsigned* p, unsigned v) { return __hip_atomic_fetch_add(p, v, __ATOMIC_RELAXED, __HIP_MEMORY_SCOPE_AGENT); }
__device__ __forceinline__ unsigned xb_xcc_id() { return (unsigned)__builtin_amdgcn_s_getreg((3 << 11) | 20) & 0xFu; }
#define XB_SPIN(cond, bar) do { unsigned _sp = 0; while (cond) { __builtin_amdgcn_s_sleep(1); \
    if ((++_sp & 255u) == 0u) { if (xb_ld(&(bar)[XB_TMO])) break; if (_sp > XB_SPIN_CAP) { atomicAdd(&(bar)[XB_TMO], 1u); break; } } } } while (0)

struct XcdBarrier {
    unsigned* bar; unsigned x;
    volatile LAS unsigned* st;
};

__device__ __forceinline__ XcdBarrier xcd_barrier_post(unsigned* bar, volatile LAS unsigned* st) {
    XcdBarrier b; b.bar = bar; b.x = xb_xcc_id(); b.st = st;
    if (threadIdx.x == 0) (void)xb_add(&bar[XB_XCNT(b.x)], 1u);
    return b;
}
__device__ __forceinline__ void xcd_barrier_complete(unsigned* bar, unsigned x, unsigned& nloc, unsigned& nx) {
    const unsigned G = gridDim.x * gridDim.y * gridDim.z;
    unsigned sum, cnt, mine, sp = 0u;
    for (;;) {
        sum = 0u; cnt = 0u; mine = 0u;
#pragma unroll
        for (unsigned j = 0; j < 16; ++j) { const unsigned c = xb_ld(&bar[XB_XCNT(j)]); sum += c; cnt += (c > 0u) ? 1u : 0u; mine = (j == x) ? c : mine; }
        if (sum == G) break;
        __builtin_amdgcn_s_sleep(1);
        if ((++sp & 255u) == 0u) { if (xb_ld(&bar[XB_TMO])) break; if (sp > XB_SPIN_CAP) { atomicAdd(&bar[XB_TMO], 1u); break; } }
    }
    nloc = mine > 0u ? mine : 1u; nx = cnt > 0u ? cnt : 1u;
}

__device__ __forceinline__ void xcd_barrier(const XcdBarrier& b) {
    asm volatile("s_waitcnt vmcnt(0)" ::: "memory");
    __syncthreads();
    if (threadIdx.x == 0) {
        unsigned* bar = b.bar;
        __builtin_amdgcn_s_waitcnt(0);
        unsigned nloc = b.st[0], nx = b.st[1];
        if (nloc == 0u) { xcd_barrier_complete(bar, b.x, nloc, nx); b.st[0] = nloc; b.st[1] = nx; }
        const unsigned old = xb_add(&bar[XB_XSUB(b.x)], 1u);
        const unsigned gen = old / nloc;
        if (old + 1u == (gen + 1u) * nloc) {
            __builtin_amdgcn_fence(__ATOMIC_RELEASE, "agent");
            asm volatile("s_waitcnt vmcnt(0)" ::: "memory");
            const unsigned og = xb_add(&bar[XB_TOP], 1u);
            const unsigned tg = og / nx;
            if (og + 1u == (tg + 1u) * nx) xb_add(&bar[XB_TOPGEN], 1u);
            else XB_SPIN(xb_ld(&bar[XB_TOPGEN]) == tg, bar);
            __builtin_amdgcn_fence(__ATOMIC_ACQUIRE, "agent");
            xb_add(&bar[XB_XGEN(b.x)], 1u);
            asm volatile("s_waitcnt vmcnt(0)" ::: "memory");
        } else {
            XB_SPIN(xb_ld(&bar[XB_XGEN(b.x)]) == gen, bar);
            __builtin_amdgcn_fence(__ATOMIC_ACQUIRE, "agent");
            asm volatile("s_waitcnt vmcnt(0)" ::: "memory");
        }
    }
    __syncthreads();
}
constexpr int M = 16384, D = 1024, DH = 512, NPROJ = 1536, NE = 32, TOPK = 4, NAS = M * TOPK, SLOTS = NAS + NE * 256, SEQ = 4096, NBATCH = 4, NCH = 32, NG = 32, NP = 64, DEPTH = 2;
constexpr float EPS = 1e-5f;
constexpr int NWAVES = 8;
constexpr size_t MiB = 1u << 20;
constexpr size_t WS_CTL = 0, CTL_ZERO_BYTES = 512 * 1024;
constexpr int CW_BAR = 1024;
constexpr int CW_Q = 6144;
constexpr int CW_CNT = 8192;
constexpr int CW_SS = 16384;
static_assert((CW_SS + DEPTH * 2 * M) * 4 <= (int)CTL_ZERO_BYTES, "CTL words inside the memset region");
constexpr size_t WS_RE = 1 * MiB;
constexpr size_t WS_RK = WS_RE + (size_t)NAS * 4;
constexpr size_t WS_GW = WS_RK + (size_t)NAS * 4;
constexpr size_t WS_SO = WS_GW + (size_t)NAS * 4;
constexpr size_t WS_TGU = WS_SO + (size_t)NAS * 4;
constexpr size_t WS_TDN = WS_TGU + 288 * 8 * 8;
constexpr size_t WS_META = WS_TDN + 288 * 4 * 8;
constexpr size_t WS_SSMP = 3 * MiB;
constexpr size_t SSMP_ABAR = 0, SSMP_A128 = 16384, SSMP_BBAR = 32768, SSMP_CTAB = SSMP_BBAR + 262144, SSMP_STRIDE = SSMP_CTAB + 262144;
constexpr size_t WS_BB16 = 5 * MiB;
constexpr size_t WS_CT16 = WS_BB16 + 512 * 1024;
constexpr size_t WS_RWT = 6 * MiB + 512 * 1024;
constexpr size_t WS_RSI = 7 * MiB;
constexpr size_t WS_WM = 6 * MiB;
static_assert(WS_META + 256 <= WS_SSMP && WS_SSMP + DEPTH * SSMP_STRIDE <= WS_BB16 && WS_WM + DEPTH * 4 * 128 * 128 * 2 <= 8 * MiB, "small tables");
constexpr size_t WS_W = 8 * MiB, W_IN = 0, W_OUT = 3 * MiB, W_GLU = 5 * MiB, W_GU = 6 * MiB, W_DN = 134 * MiB, W_STRIDE = 198 * MiB;
constexpr size_t WS_XB = WS_W + DEPTH * W_STRIDE;
constexpr size_t WS_P = WS_XB + 32 * MiB;
constexpr size_t WS_YG = WS_P + 48 * MiB;
constexpr size_t WS_MIX = WS_YG + 16 * MiB;
constexpr size_t WS_XA = WS_MIX + 32 * MiB;
constexpr size_t WS_XC = WS_XA + 64 * MiB;
constexpr size_t WS_H2 = WS_XC + 64 * MiB;
constexpr size_t WS_XS = WS_H2 + 32 * MiB;
constexpr size_t WS_ACT = WS_XS + 144 * MiB;
constexpr size_t WS_YB = WS_ACT + 144 * MiB;
constexpr size_t WS_EST = WS_YB + 144 * MiB;
constexpr size_t WS_SSP = WS_EST + 2 * MiB;
constexpr size_t WS_END = WS_SSP + 1 * MiB;
static_assert((size_t)SLOTS * D * 2 == 144 * MiB, "slot buffers");
constexpr int RING_OFF = 0, RING_BYTES = 131072;
constexpr int TAB_OFF = 131072;
constexpr int LDSCTL_OFF = 151552, MISC_OFF = LDSCTL_OFF + 6144;
constexpr int LDS_BYTES = 159744;
static_assert(MISC_OFF + 128 <= LDS_BYTES, "LDS map");
constexpr int PH_PER_LAYER = 10, N_PHASES = 1 + DEPTH * PH_PER_LAYER;
__device__ __forceinline__ float wave_sum(float v) {
#pragma unroll
    for (int o = 1; o < 64; o <<= 1) v += __shfl_xor(v, o);
    return v;
}
__device__ __forceinline__ float fast_sigmoid(float x) { return __builtin_amdgcn_rcpf(1.0f + __builtin_amdgcn_exp2f(-1.4426950409f * x)); }
__device__ __forceinline__ float gelu_tanh(float x) { const float u = x * (1.5957691216f + 0.0713548163f * x * x); return x * fast_sigmoid(u); }
__device__ __forceinline__ float bf2f(unsigned short b) { return __builtin_bit_cast(float, (unsigned)b << 16); }
__device__ __forceinline__ float bflo(unsigned w) { return __builtin_bit_cast(float, w << 16); }
__device__ __forceinline__ float bfhi(unsigned w) { return __builtin_bit_cast(float, w & 0xffff0000u); }
typedef unsigned v2u __attribute__((ext_vector_type(2)));
typedef float f32x2_t __attribute__((ext_vector_type(2)));

struct EpiInProj {
    static constexpr bool PERM = true, MIDK = false;
    bf16* P; const float* rs;
    __device__ __forceinline__ void operator()(const pg8::f32x4 (&acc)[2][2][4][2], const pg8::Unit& u, int wr, int wc, int fr, int fq) const {
        const int t = u.pn >> 1; const bool act = t < 2;
        bf16* base = P + (size_t)t * M * DH;
        const int row0 = u.pm * 256 + wr * 64 + fr, col0 = (u.pn & 1) * 256 + wc * 32 + 8 * fq;
#pragma unroll
        for (int ai = 0; ai < 2; ++ai)
#pragma unroll
            for (int m = 0; m < 4; ++m) { bf16* rowp = base + (size_t)(row0 + ai * 128 + m * 16) * DH + col0; const float rsv = rs[row0 + ai * 128 + m * 16];
#pragma unroll
                for (int bj = 0; bj < 2; ++bj) { pg8::f32x4 v0 = acc[ai][bj][m][0] * rsv, v1 = acc[ai][bj][m][1] * rsv;
                    if (act) {
#pragma unroll
                        for (int j = 0; j < 4; ++j) { v0[j] = gelu_tanh(v0[j]); v1[j] = gelu_tanh(v1[j]); } }
                    v4u w; w.x = pg8::cvt_pk_bf16(v0[0], v0[1]); w.y = pg8::cvt_pk_bf16(v0[2], v0[3]); w.z = pg8::cvt_pk_bf16(v1[0], v1[1]); w.w = pg8::cvt_pk_bf16(v1[2], v1[3]);
                    *(v4u*)(rowp + bj * 128) = w; } }
    }
};
struct EpiGlu {
    static constexpr bool PERM = true, MIDK = false;
    const bf16* YG; bf16* MIX; const float* bias; float* ss;
    __device__ __forceinline__ void operator()(const pg8::f32x4 (&acc)[2][2][4][2], const pg8::Unit& u, int wr, int wc, int fr, int fq) const {
        const int row0 = u.pm * 256 + wr * 64 + fr, col0 = u.pn * 256 + wc * 32 + 8 * fq;
        pg8::f32x4 bv[2][2];
#pragma unroll
        for (int bj = 0; bj < 2; ++bj)
#pragma unroll
            for (int n = 0; n < 2; ++n) bv[bj][n] = *(const pg8::f32x4*)(bias + col0 + bj * 128 + 4 * n);
#pragma unroll
        for (int ai = 0; ai < 2; ++ai)
#pragma unroll
            for (int m = 0; m < 4; ++m) { const int row = row0 + ai * 128 + m * 16; float sq = 0.f;
#pragma unroll
                for (int bj = 0; bj < 2; ++bj) { const int col = col0 + bj * 128;
                    const v4u yw = *(const v4u*)(YG + (size_t)row * DH + col);
                    const pg8::f32x4 g0 = acc[ai][bj][m][0] + bv[bj][0], g1 = acc[ai][bj][m][1] + bv[bj][1];
                    float o[8];
                    o[0] = bflo(yw.x) * fast_sigmoid(g0[0]); o[1] = bfhi(yw.x) * fast_sigmoid(g0[1]); o[2] = bflo(yw.y) * fast_sigmoid(g0[2]); o[3] = bfhi(yw.y) * fast_sigmoid(g0[3]);
                    o[4] = bflo(yw.z) * fast_sigmoid(g1[0]); o[5] = bfhi(yw.z) * fast_sigmoid(g1[1]); o[6] = bflo(yw.w) * fast_sigmoid(g1[2]); o[7] = bfhi(yw.w) * fast_sigmoid(g1[3]);
#pragma unroll
                    for (int j = 0; j < 8; ++j) sq += o[j] * o[j];
                    v4u w; w.x = pg8::cvt_pk_bf16(o[0], o[1]); w.y = pg8::cvt_pk_bf16(o[2], o[3]); w.z = pg8::cvt_pk_bf16(o[4], o[5]); w.w = pg8::cvt_pk_bf16(o[6], o[7]);
                    *(v4u*)(MIX + (size_t)row * D + DH + col) = w; }
                sq += __shfl_xor(sq, 16); sq += __shfl_xor(sq, 32);
                if (fq == 0) ss[(size_t)row * 8 + u.pn * 4 + wc] = sq; }
    }
};
struct EpiResid {
    static constexpr bool PERM = true, MIDK = false;
    const bf16* resid; bf16* out;
    __device__ __forceinline__ void operator()(const pg8::f32x4 (&acc)[2][2][4][2], const pg8::Unit& u, int wr, int wc, int fr, int fq) const {
        const int row0 = u.pm * 256 + wr * 64 + fr, col0 = u.pn * 256 + wc * 32 + 8 * fq;
#pragma unroll
        for (int ai = 0; ai < 2; ++ai)
#pragma unroll
            for (int m = 0; m < 4; ++m) { const size_t off = (size_t)(row0 + ai * 128 + m * 16) * D + col0;
#pragma unroll
                for (int bj = 0; bj < 2; ++bj) { const v4u r = *(const v4u*)(resid + off + bj * 128); const pg8::f32x4 a0 = acc[ai][bj][m][0], a1 = acc[ai][bj][m][1];
                    v4u w; w.x = pg8::cvt_pk_bf16(bflo(r.x) + a0[0], bfhi(r.x) + a0[1]); w.y = pg8::cvt_pk_bf16(bflo(r.y) + a0[2], bfhi(r.y) + a0[3]);
                    w.z = pg8::cvt_pk_bf16(bflo(r.z) + a1[0], bfhi(r.z) + a1[1]); w.w = pg8::cvt_pk_bf16(bflo(r.w) + a1[2], bfhi(r.w) + a1[3]);
                    *(v4u*)(out + off + bj * 128) = w; } }
    }
};
struct EpiSwiglu {
    static constexpr bool PERM = true, MIDK = false;
    bf16* ACT; const float* bgu;
    const float* rse; const LAS int* offL; const LAS int* cntL;
    __device__ __forceinline__ void operator()(const pg8::f32x4 (&acc)[2][2][4][2], const pg8::Unit& u, int wr, int wc, int fr, int fq) const {
        const int e = u.pn >> 3, pn = u.pn & 7;
        const int row0 = u.pm * 256 + wr * 64 + fr, col0 = pn * 128 + wc * 32 + 8 * fq;
        const float* bg = bgu + (size_t)e * 2048 + col0;
        pg8::f32x4 bgl[2], bli[2];
#pragma unroll
        for (int n = 0; n < 2; ++n) { bgl[n] = *(const pg8::f32x4*)(bg + 4 * n); bli[n] = *(const pg8::f32x4*)(bg + 1024 + 4 * n); }
        float rsa[2][4];
        { const int o0 = offL[e], cn = cntL[e];
#pragma unroll
          for (int ai = 0; ai < 2; ++ai)
#pragma unroll
            for (int m = 0; m < 4; ++m) { const int rank = row0 + ai * 128 + m * 16 - o0; rsa[ai][m] = rse[(size_t)e * NAS + (rank < cn ? rank : cn - 1)]; } }
#pragma unroll
        for (int ai = 0; ai < 2; ++ai)
#pragma unroll
            for (int m = 0; m < 4; ++m) { float o[8]; const float rsv = rsa[ai][m];
#pragma unroll
                for (int n = 0; n < 2; ++n)
#pragma unroll
                    for (int j = 0; j < 4; ++j) { float gl = acc[ai][0][m][n][j] * rsv + bgl[n][j], li = acc[ai][1][m][n][j] * rsv + bli[n][j];
                        gl = fminf(gl, 7.0f); li = fminf(fmaxf(li, -7.0f), 7.0f);
                        o[4 * n + j] = gl * fast_sigmoid(1.702f * gl) * (li + 1.0f); }
                v4u w; w.x = pg8::cvt_pk_bf16(o[0], o[1]); w.y = pg8::cvt_pk_bf16(o[2], o[3]); w.z = pg8::cvt_pk_bf16(o[4], o[5]); w.w = pg8::cvt_pk_bf16(o[6], o[7]);
                *(v4u*)(ACT + (size_t)(row0 + ai * 128 + m * 16) * D + col0) = w; }
    }
};
struct EpiDown {
    static constexpr bool PERM = true, MIDK = false;
    bf16* YB; const float* bdn;
    __device__ __forceinline__ void operator()(const pg8::f32x4 (&acc)[2][2][4][2], const pg8::Unit& u, int wr, int wc, int fr, int fq) const {
        const int e = u.pn >> 2, pn = u.pn & 3;
        const int row0 = u.pm * 256 + wr * 64 + fr, col0 = pn * 256 + wc * 32 + 8 * fq;
        const float* bb = bdn + (size_t)e * D + col0;
        pg8::f32x4 bv[2][2];
#pragma unroll
        for (int bj = 0; bj < 2; ++bj)
#pragma unroll
            for (int n = 0; n < 2; ++n) bv[bj][n] = *(const pg8::f32x4*)(bb + bj * 128 + 4 * n);
#pragma unroll
        for (int ai = 0; ai < 2; ++ai)
#pragma unroll
            for (int m = 0; m < 4; ++m) { bf16* rowp = YB + (size_t)(row0 + ai * 128 + m * 16) * D + col0;
#pragma unroll
                for (int bj = 0; bj < 2; ++bj) { const pg8::f32x4 v0 = acc[ai][bj][m][0] + bv[bj][0], v1 = acc[ai][bj][m][1] + bv[bj][1];
                    v4u w; w.x = pg8::cvt_pk_bf16(v0[0], v0[1]); w.y = pg8::cvt_pk_bf16(v0[2], v0[3]); w.z = pg8::cvt_pk_bf16(v1[0], v1[1]); w.w = pg8::cvt_pk_bf16(v1[2], v1[3]);
                    *(v4u*)(rowp + bj * 128) = w; } }
    }
};
template <bool GATHER_>
struct LdsOrder {
    static constexpr bool GATHER = GATHER_;
    const LAS unsigned* tab; int n, G, c;
    const LAS int* offL; const LAS int* cntL; const int* tok; const LAS unsigned* rows;
    __device__ __forceinline__ bool next(int i, pg8::Unit& u) const {
        const int per = G >> 3, L = (i * 8 + (c & 7)) * per + (c >> 3);
        if (L >= n) return false;
        const unsigned e = (unsigned)__builtin_amdgcn_readfirstlane((int)tab[L]);
        u.pm = (int)(e & 0xfffu); u.pn = (int)(e >> 12); u.li = i;
        return true;
    }
    __device__ __forceinline__ unsigned arow(const pg8::Unit& u, int r) const { return rows[u.li * 256 + r]; }
    __device__ __forceinline__ void fill_rows(LAS unsigned* rw, int tid) const {
        pg8::Unit u;
        for (int i = 0; i < 10 && next(i, u); ++i)
            for (int r = tid; r < 256; r += NWAVES * 64) { const int e = u.pn >> 3, rank = u.pm * 256 + r - offL[e], cn = cntL[e], idx = rank < cn ? rank : cn - 1;
                rw[i * 256 + r] = (unsigned)tok[e * NAS + idx] * (unsigned)(D * 2); }
    }
    __device__ __forceinline__ void a_ready(const pg8::Unit&) const {}
    __device__ __forceinline__ void done(const pg8::Unit&) const {}
};
struct Frame {
    LAS unsigned char* lds;
    volatile LAS unsigned* MISC;
    gu32* ctl;
    unsigned char* ws;
    int tid, lane, wave, vcu, G;
};
struct Args { const float* in[28]; float* out; unsigned char* ws; int ph_lo, ph_hi; };
enum { I_X = 0, I_ANW, I_WIN, I_LNW, I_LNB, I_SGUW, I_SGUB, I_ARE, I_AIM, I_BRE, I_BIM, I_CRE, I_CIM, I_SD, I_LOGDT, I_GLUW, I_GLUB, I_ONA, I_ONB, I_WOUT, I_FNW, I_RW, I_RB, I_WGU, I_BGU, I_WDN, I_BDN, I_FINW };

__device__ __forceinline__ void tr_item(const float* W, int K, int N, bf16* WT, int k0, int n0, int drow0, const float* sc, LAS float* scr, int lane) {
    const int c4 = lane & 15, kr = lane >> 4;
    f32x4 v[16];
#pragma unroll
    for (int i = 0; i < 16; ++i) v[i] = __builtin_nontemporal_load((const GAS f32x4*)(W + (size_t)(k0 + 4 * i + kr) * N + n0 + 4 * c4));
#pragma unroll
    for (int i = 0; i < 16; ++i) { const int k = 4 * i + kr; const float s = sc ? sc[k0 + k] : 1.0f; LAS float* d = scr + k * 65 + 4 * c4;
        d[0] = v[i].x * s; d[1] = v[i].y * s; d[2] = v[i].z * s; d[3] = v[i].w * s; }
    LDS_WAIT(); asm volatile("" ::: "memory");
    const int nl = lane & 7, kc = lane >> 3;
#pragma unroll
    for (int j = 0; j < 8; ++j) { const int n = nl + 8 * j; const LAS float* s = scr + (8 * kc) * 65 + n;
        v4u o; o.x = pk2(s[0 * 65], s[1 * 65]); o.y = pk2(s[2 * 65], s[3 * 65]); o.z = pk2(s[4 * 65], s[5 * 65]); o.w = pk2(s[6 * 65], s[7 * 65]);
        __builtin_nontemporal_store(o, (GAS v4u*)(WT + (size_t)(drow0 + n) * K + k0 + 8 * kc)); }
    LDS_WAIT(); asm volatile("" ::: "memory");
}
__device__ __forceinline__ void rms_row_to_bf16(const float* xrow, bf16* orow, float* rsp, int lane) {
    const GAS f32x4* xr = (const GAS f32x4*)xrow + lane;
    f32x4 v[4]; float s = 0.f;
#pragma unroll
    for (int j = 0; j < 4; ++j) { v[j] = xr[64 * j]; s += (v[j].x * v[j].x + v[j].y * v[j].y) + (v[j].z * v[j].z + v[j].w * v[j].w); }
    const float rs = 1.0f / sqrtf(wave_sum(s) * (1.f / D) + EPS);
    GAS unsigned long long* o8 = (GAS unsigned long long*)orow + lane;
#pragma unroll
    for (int j = 0; j < 4; ++j) o8[64 * j] = (unsigned long long)pk2(v[j].x, v[j].y) | ((unsigned long long)pk2(v[j].z, v[j].w) << 32);
    if (lane == 0) *rsp = rs;
}
constexpr int I_IN = 16 * 24, I_OUT = 16 * 16, I_GLU = 8 * 8, I_GU = NE * 16 * 32, I_DN = NE * 16 * 16;
constexpr int Q_L0GU = I_GU, Q_L0DN = Q_L0GU + I_DN, Q_L1GU = Q_L0DN + I_GU, QN = Q_L1GU + I_DN;
__device__ __forceinline__ void conv_gu_item(Frame& F, const Args& A, int l, int r, LAS float* scr) {
    unsigned char* wb = F.ws + WS_W + (size_t)l * W_STRIDE;
    const int e = r / 512, rr = r % 512, kb = rr / 32, nb = rr % 32, n0 = 64 * nb, j = n0 & 1023, half = n0 >> 10, drow0 = (j >> 7) * 256 + half * 128 + (j & 127);
    tr_item(A.in[I_WGU] + ((size_t)l * NE + e) * D * 2048, D, 2048, (bf16*)(wb + W_GU) + (size_t)e * 2048 * D, 64 * kb, n0, drow0, A.in[I_FNW] + l * D, scr, F.lane);
}
__device__ __forceinline__ void conv_dn_item(Frame& F, const Args& A, int l, int r, LAS float* scr) {
    unsigned char* wb = F.ws + WS_W + (size_t)l * W_STRIDE;
    const int e = r / 256, rr = r % 256, kb = rr / 16, nb = rr % 16;
    tr_item(A.in[I_WDN] + ((size_t)l * NE + e) * D * D, D, D, (bf16*)(wb + W_DN) + (size_t)e * D * D, 64 * kb, 64 * nb, 64 * nb, nullptr, scr, F.lane);
}
__device__ __forceinline__ void conv_pull(Frame& F, const Args& A, int nb, int until) {
    LAS float* scr = (LAS float*)(F.lds + RING_OFF + F.wave * 16640);
    LAS int* qb = (LAS int*)(F.lds + LDSCTL_OFF + 768);
    for (int b = 0; b < nb; ++b) {
        if (F.tid == 0) qb[0] = (int)__hip_atomic_fetch_add(F.ctl + CW_Q, 8u, RLX_AGENT);
        __syncthreads();
        const int base = qb[0];
        __syncthreads();
        if (base >= QN) break;
        const int q = base + F.wave;
        if (q < Q_L0GU) conv_gu_item(F, A, 0, q, scr);
        else if (q < Q_L0DN) conv_dn_item(F, A, 0, q - Q_L0GU, scr);
        else if (q < Q_L1GU) conv_gu_item(F, A, 1, q - Q_L0DN, scr);
        else if (q < QN) conv_dn_item(F, A, 1, q - Q_L1GU, scr);
        if (base >= until) break;
    }
}
__device__ __forceinline__ void ph_prep(Frame& F, const Args& A) {
    LAS float* scr = (LAS float*)(F.lds + RING_OFF + F.wave * 16640);
    const int gw = F.vcu * NWAVES + F.wave, NGW = F.G * NWAVES;
    constexpr int PER_S = I_IN + I_OUT + I_GLU;
    for (int it = gw; it < DEPTH * PER_S; it += NGW) {
        const int l = it / PER_S; int r = it - l * PER_S;
        unsigned char* wb = F.ws + WS_W + (size_t)l * W_STRIDE;
        if (r < I_IN) { const int kb = r / 24, nb = r % 24; tr_item(A.in[I_WIN] + (size_t)l * D * NPROJ, D, NPROJ, (bf16*)(wb + W_IN), 64 * kb, 64 * nb, 64 * nb, A.in[I_ANW] + l * D, scr, F.lane); continue; } r -= I_IN;
        if (r < I_OUT) { const int kb = r / 16, nb = r % 16; const float* sc = (kb < 8) ? A.in[I_ONA] + l * DH : A.in[I_ONB] + l * DH - DH;
            tr_item(A.in[I_WOUT] + (size_t)l * D * D, D, D, (bf16*)(wb + W_OUT), 64 * kb, 64 * nb, 64 * nb, sc, scr, F.lane); continue; } r -= I_OUT;
        { const int kb = r / 8, nb = r % 8; tr_item(A.in[I_GLUW] + (size_t)l * DH * DH, DH, DH, (bf16*)(wb + W_GLU), 64 * kb, 64 * nb, 64 * nb, nullptr, scr, F.lane); }
    }
    for (int m = gw; m < M; m += NGW) rms_row_to_bf16(A.in[I_X] + (size_t)m * D, (bf16*)(F.ws + WS_XB) + (size_t)m * D, (float*)(F.ws + WS_RSI) + m, F.lane);
    for (int i = (F.vcu * NWAVES + F.wave) * 64 + F.lane; i < DEPTH * NG * NP; i += F.G * NWAVES * 64) {
        const int l = i / (NG * NP), gp = i % (NG * NP), g = gp / NP, p = gp % NP;
        unsigned char* sp = F.ws + WS_SSMP + (size_t)l * SSMP_STRIDE;
        const float dt = expf(A.in[I_LOGDT][l * NG + g]), ar = A.in[I_ARE][i], ai = A.in[I_AIM][i];
        const float ex = expf(dt * ar); float sn, cs; sincosf(dt * ai, &sn, &cs);
        const float abr = ex * cs, abi = ex * sn;
        const float nr = abr - 1.0f, ni = abi, den = ar * ar + ai * ai, cr = (nr * ar + ni * ai) / den, ci = (ni * ar - nr * ai) / den;
        ((float*)(sp + SSMP_ABAR))[gp * 2] = abr; ((float*)(sp + SSMP_ABAR))[gp * 2 + 1] = abi;
        float pr = abr, pi = abi;
#pragma unroll
        for (int k = 0; k < 7; ++k) { const float t = pr * pr - pi * pi; pi = 2.0f * pr * pi; pr = t; }
        ((float*)(sp + SSMP_A128))[gp * 2] = pr; ((float*)(sp + SSMP_A128))[gp * 2 + 1] = pi;
        float* bb = (float*)(sp + SSMP_BBAR) + (size_t)gp * 32;
        const float* bre = A.in[I_BRE] + (size_t)i * 16; const float* bim = A.in[I_BIM] + (size_t)i * 16;
#pragma unroll
        for (int h = 0; h < 16; ++h) { const float br = bre[h], bi = bim[h]; bb[h] = cr * br - ci * bi; bb[16 + h] = cr * bi + ci * br; }
        float* ct = (float*)(sp + SSMP_CTAB) + (size_t)g * 128 * 16;
        const float* cre = A.in[I_CRE] + (size_t)(l * NG + g) * 16 * NP; const float* cim = A.in[I_CIM] + (size_t)(l * NG + g) * 16 * NP;
#pragma unroll
        for (int h = 0; h < 16; ++h) { ct[p * 16 + h] = cre[h * NP + p]; ct[(64 + p) * 16 + h] = -cim[h * NP + p]; }
        bf16* bb16 = (bf16*)(F.ws + WS_BB16) + (size_t)(l * NG + g) * 2048; bf16* ct16 = (bf16*)(F.ws + WS_CT16) + (size_t)(l * NG + g) * 2048;
#pragma unroll
        for (int h = 0; h < 16; ++h) { bb16[((p >> 5) * 32 + (p & 31)) * 16 + h] = (bf16)f2bf(bb[h]); bb16[((2 + (p >> 5)) * 32 + (p & 31)) * 16 + h] = (bf16)f2bf(bb[16 + h]);
            ct16[h * 128 + p] = (bf16)f2bf(cre[h * NP + p]); ct16[h * 128 + 64 + p] = (bf16)f2bf(-cim[h * NP + p]); }
    }
    for (int i = (F.vcu * NWAVES + F.wave) * 64 + F.lane; i < DEPTH * D * NE; i += F.G * NWAVES * 64) { const int l = i / (D * NE), k = (i / NE) % D, e = i % NE;
        const float w = A.in[I_RW][i] * A.in[I_FNW][l * D + k]; const unsigned hi = f2bf(w); const float lo = w - __builtin_bit_cast(float, hi << 16);
        bf16* t = (bf16*)(F.ws + WS_RWT) + (size_t)l * 2 * NE * D; t[e * D + k] = (bf16)hi; t[(NE + e) * D + k] = (bf16)f2bf(lo); }
    for (int i = (F.vcu * NWAVES + F.wave) * 64 + F.lane; i < DEPTH * 4 * 128 * 128; i += F.G * NWAVES * 64) { const int t = (i >> 7) & 127, sx = i & 127;
        ((bf16*)(F.ws + WS_WM))[i] = (sx <= t) ? (bf16)f2bf(A.in[I_SGUW][i]) : (bf16)0; }
}

typedef short v4i16_t __attribute__((ext_vector_type(4)));
__device__ __forceinline__ void sgu_chunk_mfma(Frame& F, const Args& A, int l, int c) {
    const bf16* UG = (const bf16*)(F.ws + WS_P); const bf16* VG = UG + (size_t)M * DH;
    bf16* MIX = (bf16*)(F.ws + WS_MIX);
    const bf16* Wm = (const bf16*)(F.ws + WS_WM) + (size_t)l * 4 * 128 * 128;
    constexpr int PITCH = 1056;
    LAS unsigned char* vn = F.lds + RING_OFF;
    const float* lnw = A.in[I_LNW] + l * DH; const float* lnb = A.in[I_LNB] + l * DH;
    {
        const f32x4 w0 = *(const GAS f32x4*)(lnw + 8 * F.lane), w1 = *(const GAS f32x4*)(lnw + 8 * F.lane + 4), b0 = *(const GAS f32x4*)(lnb + 8 * F.lane), b1 = *(const GAS f32x4*)(lnb + 8 * F.lane + 4);
        const float ww[8] = {w0.x, w0.y, w0.z, w0.w, w1.x, w1.y, w1.z, w1.w}, bb[8] = {b0.x, b0.y, b0.z, b0.w, b1.x, b1.y, b1.z, b1.w};
#pragma unroll 4
        for (int r = F.wave * 16; r < F.wave * 16 + 16; ++r) {
            const v4u w = *(const GAS v4u*)(VG + (size_t)(c * 128 + r) * DH + 8 * F.lane);
            float v[8] = {bflo(w.x), bfhi(w.x), bflo(w.y), bfhi(w.y), bflo(w.z), bfhi(w.z), bflo(w.w), bfhi(w.w)};
            float s = 0.f, s2 = 0.f;
#pragma unroll
            for (int j = 0; j < 8; ++j) { s += v[j]; s2 += v[j] * v[j]; }
            s = wave_sum(s); s2 = wave_sum(s2);
            const float mean = s * (1.f / DH), var = fmaxf(s2 * (1.f / DH) - mean * mean, 0.f), rstd = 1.0f / sqrtf(var + EPS);
            float o[8];
#pragma unroll
            for (int j = 0; j < 8; ++j) o[j] = (v[j] - mean) * rstd * ww[j] + bb[j];
            v4u ow; ow.x = pk2(o[0], o[1]); ow.y = pk2(o[2], o[3]); ow.z = pk2(o[4], o[5]); ow.w = pk2(o[6], o[7]);
            *(LAS v4u*)(vn + r * PITCH + 16 * F.lane) = ow;
        }
    }
    __syncthreads();
    const int w = F.wave, fr = F.lane & 15, G = F.lane >> 4, rr = (F.lane >> 2) & 3, cc = F.lane & 3;
    const int nks = (w >> 1) + 1;
    const int trow = c * 128 + w * 16 + fr;
    LAS unsigned char* trb = vn + (4 * G + rr) * PITCH + 8 * cc;
    pg8::f32x4 acc[4][8];
#pragma unroll
    for (int h = 0; h < 4; ++h)
#pragma unroll
        for (int dt = 0; dt < 8; ++dt) acc[h][dt] = (pg8::f32x4){0.f, 0.f, 0.f, 0.f};
    for (int ks = 0; ks < nks; ++ks) {
#pragma unroll
        for (int h = 0; h < 4; ++h) {
            const bf16* wp = Wm + ((size_t)h * 128 + w * 16 + fr) * 128 + ks * 32 + 4 * G;
            const v2u wlo = *(const GAS v2u*)wp, whi = *(const GAS v2u*)(wp + 16);
            const v4u wf4 = (v4u){wlo.x, wlo.y, whi.x, whi.y};
            const bf16x8 wf = __builtin_bit_cast(bf16x8, wf4);
#pragma unroll
            for (int dt = 0; dt < 8; ++dt) {
                const LAS unsigned char* pa = trb + ks * 32 * PITCH + (h * 128 + dt * 16) * 2;
                const v4i16_t a0 = __builtin_amdgcn_ds_read_tr16_b64_v4i16((LAS v4i16_t*)pa), a1 = __builtin_amdgcn_ds_read_tr16_b64_v4i16((LAS v4i16_t*)(pa + 16 * PITCH));
                const bf16x8 af = (bf16x8){a0[0], a0[1], a0[2], a0[3], a1[0], a1[1], a1[2], a1[3]};
                acc[h][dt] = __builtin_amdgcn_mfma_f32_16x16x32_bf16(af, wf, acc[h][dt], 0, 0, 0);
            }
        }
    }
    float ss = 0.f;
#pragma unroll
    for (int h = 0; h < 4; ++h) { const float bt = A.in[I_SGUB][(size_t)(l * 4 + h) * 128 + w * 16 + fr];
#pragma unroll
        for (int dt = 0; dt < 8; ++dt) { const v2u uw = *(const GAS v2u*)(UG + (size_t)trow * DH + h * 128 + dt * 16 + 4 * G);
            pg8::f32x4 y = acc[h][dt] + bt; y[0] *= bflo(uw.x); y[1] *= bfhi(uw.x); y[2] *= bflo(uw.y); y[3] *= bfhi(uw.y);
            acc[h][dt] = y; ss += (y[0] * y[0] + y[1] * y[1]) + (y[2] * y[2] + y[3] * y[3]); } }
    ss += __shfl_xor(ss, 16); ss += __shfl_xor(ss, 32);
    const float rs = 1.0f / sqrtf(ss * (1.f / DH) + EPS);
#pragma unroll
    for (int h = 0; h < 4; ++h)
#pragma unroll
        for (int dt = 0; dt < 8; ++dt) { const pg8::f32x4 y = acc[h][dt] * rs; v2u o; o.x = pk2(y[0], y[1]); o.y = pk2(y[2], y[3]);
            *(GAS v2u*)(MIX + (size_t)trow * D + h * 128 + dt * 16 + 4 * G) = o; }
    __syncthreads();
}

typedef float f32x16 __attribute__((ext_vector_type(16)));
template <bool FULL>
__device__ __forceinline__ void ssm_item(Frame& F, const Args& A, int l, int g, int bp, int ch, float* xcarry = nullptr, bool cont = false) {
    const unsigned char* sp = F.ws + WS_SSMP + (size_t)l * SSMP_STRIDE;
    const bf16* US = (const bf16*)(F.ws + WS_P) + (size_t)2 * M * DH;
    const int lane = F.lane, H = lane >> 5, s = lane & 31;
    const float* abp = (const float*)(sp + SSMP_ABAR) + (size_t)g * NP * 2;
    const float a0r = abp[s * 2], a0i = abp[s * 2 + 1], a1r = abp[(32 + s) * 2], a1i = abp[(32 + s) * 2 + 1];
    bf16x8 bq[4];
    { const bf16* bb16 = (const bf16*)(F.ws + WS_BB16) + (size_t)(l * NG + g) * 2048;
#pragma unroll
      for (int q = 0; q < 4; ++q) bq[q] = *(const GAS bf16x8*)(bb16 + (q * 32 + s) * 16 + 8 * H); }
    float x0r = 0.f, x0i = 0.f, x1r = 0.f, x1i = 0.f;
    const int b = 2 * bp + H;
    if (FULL && cont) { x0r = xcarry[0]; x0i = xcarry[1]; x1r = xcarry[2]; x1i = xcarry[3]; }
    if (FULL && !cont) {
        const float* a8p = (const float*)(sp + SSMP_A128) + (size_t)g * NP * 2;
        const float c0r = a8p[s * 2], c0i = a8p[s * 2 + 1], c1r = a8p[(32 + s) * 2], c1i = a8p[(32 + s) * 2 + 1];
        const float* est = (const float*)(F.ws + WS_EST) + (((size_t)b * NG + g) * NCH * NP) * 2;
        for (int cb = 0; cb < ch; cb += 8) {
            f32x2_t ea[8], eb[8];
#pragma unroll
            for (int k = 0; k < 8; ++k) { const int cc = (cb + k < ch) ? cb + k : ch - 1; ea[k] = *(const GAS f32x2_t*)(est + ((size_t)cc * NP + s) * 2); eb[k] = *(const GAS f32x2_t*)(est + ((size_t)cc * NP + 32 + s) * 2); }
#pragma unroll
            for (int k = 0; k < 8; ++k) if (cb + k < ch) {
                float nr = c0r * x0r - c0i * x0i + ea[k].x, ni = c0r * x0i + c0i * x0r + ea[k].y; x0r = nr; x0i = ni;
                nr = c1r * x1r - c1i * x1i + eb[k].x; ni = c1r * x1i + c1i * x1r + eb[k].y; x1r = nr; x1i = ni; } }
    }
    const int ai = lane & 31;
    const bf16* ap = US + ((size_t)(2 * bp + ((ai >> 2) & 1)) * SEQ + ch * 128 + (ai & 3) + 4 * (ai >> 3)) * DH + g * 16 + 8 * H;
    constexpr int XP = 272;
    LAS unsigned char* xt = F.lds + RING_OFF + F.wave * (32 * XP);
    bf16x8 cq[4]; f32x4 dv = (f32x4){0.f, 0.f, 0.f, 0.f};
    const int fr = lane & 15, G = lane >> 4;
    if (FULL) { const bf16* ct16 = (const bf16*)(F.ws + WS_CT16) + (size_t)(l * NG + g) * 2048;
#pragma unroll
        for (int q = 0; q < 4; ++q) cq[q] = *(const GAS bf16x8*)(ct16 + fr * 128 + q * 32 + 8 * G);
        dv = *(const GAS f32x4*)(A.in[I_SD] + l * DH + g * 16 + 4 * G); }
    bf16x8 af = *(const GAS bf16x8*)ap;
    for (int tb = 0; tb < 8; ++tb) {
        const bf16x8 afn = *(const GAS bf16x8*)(ap + (size_t)((tb < 7 ? tb + 1 : tb) * 16) * DH);
        v2u uwp[2] = {(v2u){0u, 0u}, (v2u){0u, 0u}};
        if (FULL) {
#pragma unroll
            for (int hb = 0; hb < 2; ++hb) uwp[hb] = *(const GAS v2u*)(US + ((size_t)(2 * bp + hb) * SEQ + ch * 128 + tb * 16 + fr) * DH + g * 16 + 4 * G); }
        f32x16 z;
#pragma unroll
        for (int i = 0; i < 16; ++i) z[i] = 0.f;
        f32x16 r0 = __builtin_amdgcn_mfma_f32_32x32x16_bf16(af, bq[0], z, 0, 0, 0);
        f32x16 r1 = __builtin_amdgcn_mfma_f32_32x32x16_bf16(af, bq[1], z, 0, 0, 0);
        f32x16 i0 = __builtin_amdgcn_mfma_f32_32x32x16_bf16(af, bq[2], z, 0, 0, 0);
        f32x16 i1 = __builtin_amdgcn_mfma_f32_32x32x16_bf16(af, bq[3], z, 0, 0, 0);
#pragma unroll
        for (int t = 0; t < 16; ++t) {
            float nr = a0r * x0r - a0i * x0i + r0[t], ni = a0r * x0i + a0i * x0r + i0[t]; x0r = nr; x0i = ni;
            nr = a1r * x1r - a1i * x1i + r1[t]; ni = a1r * x1i + a1i * x1r + i1[t]; x1r = nr; x1i = ni;
            if (FULL) { LAS bf16* xr = (LAS bf16*)(xt + (H * 16 + t) * XP) + s;
                unsigned p0 = pg8::cvt_pk_bf16_raw(x0r, x0r), p1 = pg8::cvt_pk_bf16_raw(x1r, x1r), p2 = pg8::cvt_pk_bf16_raw(x0i, x0i), p3 = pg8::cvt_pk_bf16_raw(x1i, x1i);
                asm volatile("s_nop 1" : "+v"(p0), "+v"(p1), "+v"(p2), "+v"(p3));
                xr[0] = (bf16)p0; xr[32] = (bf16)p1; xr[64] = (bf16)p2; xr[96] = (bf16)p3;
                asm volatile("s_nop 1" :: "v"(p0), "v"(p1), "v"(p2), "v"(p3) : "memory"); }
        }
        if (FULL) {
            LDS_WAIT(); asm volatile("" ::: "memory");
#pragma unroll
            for (int hb = 0; hb < 2; ++hb) {
                pg8::f32x4 y = (pg8::f32x4){0.f, 0.f, 0.f, 0.f};
#pragma unroll
                for (int q = 0; q < 4; ++q) { const bf16x8 xf = *(const LAS bf16x8*)(xt + (hb * 16 + fr) * XP + q * 64 + 16 * G); y = __builtin_amdgcn_mfma_f32_16x16x32_bf16(cq[q], xf, y, 0, 0, 0); }
                const size_t row = (size_t)(2 * bp + hb) * SEQ + ch * 128 + tb * 16 + fr;
                const v2u uw = uwp[hb];
                y[0] += dv.x * bflo(uw.x); y[1] += dv.y * bfhi(uw.x); y[2] += dv.z * bflo(uw.y); y[3] += dv.w * bfhi(uw.y);
                v2u o; o.x = pk2(gelu_tanh(y[0]), gelu_tanh(y[1])); o.y = pk2(gelu_tanh(y[2]), gelu_tanh(y[3]));
                *(GAS v2u*)((bf16*)(F.ws + WS_YG) + row * DH + g * 16 + 4 * G) = o;
            }
            LDS_WAIT(); asm volatile("" ::: "memory");
        }
        af = afn;
    }
    if (FULL && xcarry) { xcarry[0] = x0r; xcarry[1] = x0i; xcarry[2] = x1r; xcarry[3] = x1i; }
    if (!FULL) { float* est = (float*)(F.ws + WS_EST) + ((((size_t)b * NG + g) * NCH + ch) * NP) * 2;
        *(GAS f32x2_t*)(est + s * 2) = (f32x2_t){x0r, x0i}; *(GAS f32x2_t*)(est + (32 + s) * 2) = (f32x2_t){x1r, x1i}; }
}

__device__ __forceinline__ void ph_normb(Frame& F, const Args& A, int l) {
    bf16* MIX = (bf16*)(F.ws + WS_MIX);
    const float* ssp = (const float*)(F.ws + WS_SSP);
    const int gw = F.vcu * NWAVES + F.wave, NGW = F.G * NWAVES;
    for (int mb = gw; mb < M; mb += 8 * NGW) {
        f32x4 p0[8], p1[8]; v4u w[8];
#pragma unroll
        for (int j = 0; j < 8; ++j) { const int m = mb + j * NGW; if (m < M) { p0[j] = *(const GAS f32x4*)(ssp + (size_t)m * 8); p1[j] = *(const GAS f32x4*)(ssp + (size_t)m * 8 + 4); w[j] = *(const GAS v4u*)(MIX + (size_t)m * D + DH + 8 * F.lane); } }
#pragma unroll
        for (int j = 0; j < 8; ++j) { const int m = mb + j * NGW; if (m < M) {
            const float s = 1.0f / sqrtf((((p0[j].x + p0[j].y) + (p0[j].z + p0[j].w)) + ((p1[j].x + p1[j].y) + (p1[j].z + p1[j].w))) * (1.f / DH) + EPS);
            v4u o; o.x = pk2(bflo(w[j].x) * s, bfhi(w[j].x) * s); o.y = pk2(bflo(w[j].y) * s, bfhi(w[j].y) * s); o.z = pk2(bflo(w[j].z) * s, bfhi(w[j].z) * s); o.w = pk2(bflo(w[j].w) * s, bfhi(w[j].w) * s);
            *(GAS v4u*)(MIX + (size_t)m * D + DH + 8 * F.lane) = o; } }
    }
}

__device__ __forceinline__ void ph_route_mfma(Frame& F, const Args& A, int l, int cbank) {
    const bf16* XA = (const bf16*)(F.ws + WS_XA); float* RSE = (float*)(F.ws + WS_H2);
    int* RE = (int*)(F.ws + WS_RE); int* RK = (int*)(F.ws + WS_RK); float* GW = (float*)(F.ws + WS_GW);
    gu32* cnt = F.ctl + CW_CNT + cbank * NE;
    constexpr int WP = 2064, PL_OFF = 64 * WP, SSQ_OFF = PL_OFF + 2 * 64 * 32 * 4;
    static_assert(SSQ_OFF + 512 + 2048 <= LDSCTL_OFF, "route LDS map");
    LAS unsigned char* wt = F.lds + RING_OFF;
    LAS float* PL = (LAS float*)(F.lds + PL_OFF); LAS float* SSQ = (LAS float*)(F.lds + SSQ_OFF);
    LAS int* lcnt = (LAS int*)(F.lds + LDSCTL_OFF); LAS int* lbase = lcnt + 32;
    LAS int* as_e = (LAS int*)(F.lds + LDSCTL_OFF + 1024); LAS int* as_lr = as_e + 256; LAS float* as_g = (LAS float*)(as_lr + 256);
    LAS float* as_rs = (LAS float*)(F.lds + LDSCTL_OFF + 4096);
    const float* rb = A.in[I_RB] + l * NE;
    { const bf16* src = (const bf16*)(F.ws + WS_RWT) + (size_t)l * 2 * NE * D;
      v4u wv[16];
#pragma unroll
      for (int q = 0; q < 16; ++q) { const int i = F.tid + q * (NWAVES * 64), row = i >> 7, ch = i & 127; wv[q] = *(const GAS v4u*)(src + (size_t)row * D + ch * 8); }
#pragma unroll
      for (int q = 0; q < 16; ++q) { const int i = F.tid + q * (NWAVES * 64), row = i >> 7, ch = i & 127; *(LAS v4u*)(wt + row * WP + ch * 16) = wv[q]; } }
    const int fr = F.lane & 15, G = F.lane >> 4, rg = F.wave & 3;
    for (int blk = F.vcu; blk < M / 64; blk += F.G) {
        if (F.tid < 32) lcnt[F.tid] = 0;
        __syncthreads();
        if (F.wave < 4) {
            v4u xall[2][16];
#pragma unroll
            for (int kh = 0; kh < 2; ++kh) { const bf16* xp = XA + (size_t)(blk * 64 + rg * 16 + fr) * D + kh * 512 + 8 * G;
#pragma unroll
                for (int ks = 0; ks < 16; ++ks) xall[kh][ks] = *(const GAS v4u*)(xp + ks * 32); }
#pragma unroll
            for (int kh = 0; kh < 2; ++kh) {
                pg8::f32x4 a0 = (pg8::f32x4){0.f, 0.f, 0.f, 0.f}, a1 = a0; float ssq = 0.f;
                const LAS unsigned char* wp = wt + fr * WP + (kh * 512 + 8 * G) * 2;
#pragma unroll
                for (int ks = 0; ks < 16; ++ks) {
                    const v4u xw = xall[kh][ks]; const bf16x8 xb = __builtin_bit_cast(bf16x8, xw);
                    { const float x0 = bflo(xw.x), x1 = bfhi(xw.x), x2 = bflo(xw.y), x3 = bfhi(xw.y), x4 = bflo(xw.z), x5 = bfhi(xw.z), x6 = bflo(xw.w), x7 = bfhi(xw.w);
                      ssq += ((x0 * x0 + x1 * x1) + (x2 * x2 + x3 * x3)) + ((x4 * x4 + x5 * x5) + (x6 * x6 + x7 * x7)); }
                    const bf16x8 w0h = *(const LAS bf16x8*)(wp + ks * 64), w1h = *(const LAS bf16x8*)(wp + 16 * WP + ks * 64);
                    const bf16x8 w0l = *(const LAS bf16x8*)(wp + 32 * WP + ks * 64), w1l = *(const LAS bf16x8*)(wp + 48 * WP + ks * 64);
                    a0 = __builtin_amdgcn_mfma_f32_16x16x32_bf16(w0h, xb, a0, 0, 0, 0); a1 = __builtin_amdgcn_mfma_f32_16x16x32_bf16(w1h, xb, a1, 0, 0, 0);
                    a0 = __builtin_amdgcn_mfma_f32_16x16x32_bf16(w0l, xb, a0, 0, 0, 0); a1 = __builtin_amdgcn_mfma_f32_16x16x32_bf16(w1l, xb, a1, 0, 0, 0);
                }
                ssq += __shfl_xor(ssq, 16); ssq += __shfl_xor(ssq, 32);
                LAS float* pl = PL + ((kh * 64 + rg * 16 + fr) * 32);
                *(LAS pg8::f32x4*)(pl + 4 * G) = a0; *(LAS pg8::f32x4*)(pl + 16 + 4 * G) = a1;
                if (G == 0) SSQ[kh * 64 + rg * 16 + fr] = ssq;
            }
        }
        __syncthreads();
#pragma unroll 1
        for (int rr = 0; rr < 8; rr += 2) {
            const int L = F.lane, e = L >> 1;
            int lr[2]; float rs[2], val[2], mx[2], ex[2], den[2]; int rank[2]; bool win[2];
#pragma unroll
            for (int u = 0; u < 2; ++u) lr[u] = F.wave * 8 + rr + u;
#pragma unroll
            for (int u = 0; u < 2; ++u) { rs[u] = 1.0f / sqrtf((SSQ[lr[u]] + SSQ[64 + lr[u]]) * (1.f / D) + EPS);
                val[u] = (PL[lr[u] * 32 + e] + PL[(64 + lr[u]) * 32 + e]) * rs[u] + rb[e];
                LAS float* lrow = (LAS float*)(F.lds + SSQ_OFF + 512) + (F.wave * 2 + u) * 32;
                if ((L & 1) == 0) lrow[e] = val[u]; }
            LDS_WAIT(); asm volatile("" ::: "memory");
#pragma unroll
            for (int u = 0; u < 2; ++u) { const LAS float* lrow = (const LAS float*)(F.lds + SSQ_OFF + 512) + (F.wave * 2 + u) * 32; const float v = val[u]; int rk = 0;
#pragma unroll
                for (int q = 0; q < 8; ++q) { const f32x4 o = *(const LAS f32x4*)(lrow + 4 * q);
                    rk += (o.x > v || (o.x == v && 4 * q + 0 < e)) ? 1 : 0; rk += (o.y > v || (o.y == v && 4 * q + 1 < e)) ? 1 : 0;
                    rk += (o.z > v || (o.z == v && 4 * q + 2 < e)) ? 1 : 0; rk += (o.w > v || (o.w == v && 4 * q + 3 < e)) ? 1 : 0; }
                rank[u] = rk; mx[u] = v; }
            asm volatile("" ::: "memory");
#pragma unroll
            for (int o = 2; o < 64; o <<= 1) { mx[0] = fmaxf(mx[0], __shfl_xor(mx[0], o)); mx[1] = fmaxf(mx[1], __shfl_xor(mx[1], o)); }
#pragma unroll
            for (int u = 0; u < 2; ++u) { win[u] = (rank[u] < 4) && ((L & 1) == 0); ex[u] = win[u] ? __expf(val[u] - mx[u]) : 0.f; den[u] = ex[u]; }
#pragma unroll
            for (int o = 1; o < 64; o <<= 1) { den[0] += __shfl_xor(den[0], o); den[1] += __shfl_xor(den[1], o); }
#pragma unroll
            for (int u = 0; u < 2; ++u) {
                if (L == 0) as_rs[lr[u]] = rs[u];
                if (win[u]) { const int slr = __hip_atomic_fetch_add(lcnt + e, 1, __ATOMIC_RELAXED, __HIP_MEMORY_SCOPE_WORKGROUP);
                    const int ix = lr[u] * 4 + rank[u]; as_e[ix] = e; as_lr[ix] = slr; as_g[ix] = ex[u] / den[u]; } }
            LDS_WAIT(); asm volatile("" ::: "memory");
        }
        __syncthreads();
        if (F.tid < 32) lbase[F.tid] = (int)__hip_atomic_fetch_add(cnt + F.tid, (unsigned)lcnt[F.tid], RLX_AGENT);
        __syncthreads();
        if (F.tid < 256) { const int a = blk * 256 + F.tid, e = as_e[F.tid], rk = lbase[e] + as_lr[F.tid]; RE[a] = e; RK[a] = rk; GW[a] = as_g[F.tid]; ((int*)(F.ws + WS_XS))[e * NAS + rk] = a >> 2; RSE[e * NAS + rk] = as_rs[F.tid >> 2]; }
        __syncthreads();
    }
}

__device__ __forceinline__ int moe_tables(Frame& F, int l, int NT, int GS, bool build, bool fresh = true) {
    gu32* cnt = F.ctl + CW_CNT + l * NE;
    LAS int* offL = (LAS int*)(F.lds + TAB_OFF); LAS int* cntL = offL + 64; LAS unsigned* tab = (LAS unsigned*)(F.lds + TAB_OFF + 1024);
    if (fresh) {
    if (F.tid < NE) cntL[F.tid] = (int)__hip_atomic_load(cnt + F.tid, RLX_AGENT);
    __syncthreads();
    if (F.tid == 0) { int o = 0; for (int e = 0; e < NE; ++e) { offL[e] = o; o += (cntL[e] + 255) & ~255; } offL[NE] = o; }
    __syncthreads();
    }
    if (build && F.tid < NE) { const int e = F.tid, t0 = offL[e] >> 8, mt = (offL[e + 1] - offL[e]) >> 8;
        int idx = t0 * NT;
        for (int pg = 0; pg * GS < mt; ++pg) { const int gs = (mt - pg * GS) < GS ? (mt - pg * GS) : GS;
            for (int pn = 0; pn < NT; ++pn) for (int pi = 0; pi < gs; ++pi) { tab[idx] = (unsigned)(t0 + pg * GS + pi) | ((unsigned)(e * NT + pn) << 12); ++idx; } } }
    __syncthreads();
    return (offL[NE] >> 8) * NT;
}

__device__ __forceinline__ void ph_combine(Frame& F, const Args& A, int l) {
    const bf16* XA = (const bf16*)(F.ws + WS_XA); bf16* XC = (bf16*)(F.ws + WS_XC); float* RSI = (float*)(F.ws + WS_RSI) + M;
    const bf16* YB = (const bf16*)(F.ws + WS_YB); const int* RE = (const int*)(F.ws + WS_RE); const int* RK = (const int*)(F.ws + WS_RK); const float* GW = (const float*)(F.ws + WS_GW);
    (void)moe_tables(F, l, 4, 8, false, false);
    const LAS int* offL = (const LAS int*)(F.lds + TAB_OFF);
    const int gw = F.vcu * NWAVES + F.wave, NGW = F.G * NWAVES;
    const bool last = (l == DEPTH - 1);
    for (int jb = 0; gw + jb * NGW < M; jb += 16) {
        int slot_l = 0; float g_l = 0.f;
        { const int ml = gw + (jb + (F.lane >> 2)) * NGW;
          if (ml < M) { const int a = ml * 4 + (F.lane & 3); slot_l = offL[__hip_atomic_load(RE + a, RLX_AGENT)] + __hip_atomic_load(RK + a, RLX_AGENT); g_l = __hip_atomic_load(GW + a, RLX_AGENT); } }
        v2u xa[4], ya[4][4], xb[4], yb[4][4];
#define COMB_LOAD(X, Y, J) do { const int m_ = gw + (jb + (J)) * NGW; const GAS v2u* xr_ = (const GAS v2u*)(XA + (size_t)m_ * D) + F.lane; \
            _Pragma("unroll") for (int q = 0; q < 4; ++q) (X)[q] = xr_[64 * q]; \
            _Pragma("unroll") for (int k = 0; k < 4; ++k) { const int slot_ = __builtin_amdgcn_readlane(slot_l, 4 * (J) + k); const GAS v2u* yp_ = (const GAS v2u*)(YB + (size_t)slot_ * D) + F.lane; \
                _Pragma("unroll") for (int q = 0; q < 4; ++q) (Y)[k][q] = yp_[64 * q]; } } while (0)
        COMB_LOAD(xa, ya, 0);
#pragma unroll 1
        for (int jj = 0; jj < 16; ++jj) {
            const int m = gw + (jb + jj) * NGW;
            if (m >= M) break;
            const bool more = (jj < 15) && (m + NGW < M);
            if (more) COMB_LOAD(xb, yb, jj + 1);
            f32x4 v[4];
#pragma unroll
            for (int q = 0; q < 4; ++q) v[q] = (f32x4){bflo(xa[q].x), bfhi(xa[q].x), bflo(xa[q].y), bfhi(xa[q].y)};
#pragma unroll
            for (int k = 0; k < 4; ++k) { const float g = __builtin_bit_cast(float, __builtin_amdgcn_readlane(__builtin_bit_cast(int, g_l), 4 * jj + k));
#pragma unroll
                for (int q = 0; q < 4; ++q) { const v2u w = ya[k][q]; v[q].x += g * bflo(w.x); v[q].y += g * bfhi(w.x); v[q].z += g * bflo(w.y); v[q].w += g * bfhi(w.y); } }
            float sq = 0.f;
#pragma unroll
            for (int q = 0; q < 4; ++q) sq += (v[q].x * v[q].x + v[q].y * v[q].y) + (v[q].z * v[q].z + v[q].w * v[q].w);
            const float rs = 1.0f / sqrtf(wave_sum(sq) * (1.f / D) + EPS);
            if (!last) {
                GAS unsigned long long* o8 = (GAS unsigned long long*)(XC + (size_t)m * D) + F.lane;
#pragma unroll
                for (int q = 0; q < 4; ++q) o8[64 * q] = (unsigned long long)pk2(v[q].x, v[q].y) | ((unsigned long long)pk2(v[q].z, v[q].w) << 32);
                if (F.lane == 0) RSI[m] = rs;
            } else {
                GAS f32x4* oo = (GAS f32x4*)(A.out + (size_t)m * D) + F.lane; const GAS f32x4* fw = (const GAS f32x4*)A.in[I_FINW] + F.lane;
#pragma unroll
                for (int q = 0; q < 4; ++q) { const f32x4 w = fw[64 * q]; oo[64 * q] = v[q] * rs * w; }
            }
            if (more) {
#pragma unroll
                for (int q = 0; q < 4; ++q) { xa[q] = xb[q];
#pragma unroll
                    for (int k = 0; k < 4; ++k) ya[k][q] = yb[k][q]; } }
        }
#undef COMB_LOAD
    }
}
template <class Epi, class Sched>
__device__ __forceinline__ void run_gemm(Frame& F, const pg8::Gemm& g, const Sched& S, const Epi& E) {
    pg8::gemm_phase<Epi, Sched, true>(F.lds + RING_OFF, g, S, E);
}
__global__ void __launch_bounds__(NWAVES * 64, 2) mk_fwd(Args args) {
    extern __shared__ __attribute__((aligned(16))) unsigned char lds[];
    Frame F;
    F.lds = (LAS unsigned char*)lds;
    F.MISC = (volatile LAS unsigned*)(F.lds + MISC_OFF);
    F.tid = threadIdx.x; F.lane = F.tid & 63; F.wave = __builtin_amdgcn_readfirstlane(F.tid >> 6);
    F.G = gridDim.x; { const int bx = blockIdx.x; F.vcu = (F.G % 8 == 0) ? (bx % 8) * (F.G / 8) + bx / 8 : bx; }
    F.ws = args.ws; F.ctl = (gu32*)(args.ws + WS_CTL);
    for (int u = F.tid; u < (LDS_BYTES - LDSCTL_OFF) / 4; u += NWAVES * 64) ((LAS unsigned*)(F.lds + LDSCTL_OFF))[u] = 0u;
    __syncthreads();
#if N_LAUNCH_MODE == 1
    XcdBarrier bar = xcd_barrier_post((unsigned*)(F.ctl + CW_BAR), F.MISC + 8);
#define GRID_BAR() xcd_barrier(bar)
#else
#define GRID_BAR() do { } while (0)
#endif
    const int lo = args.ph_lo, hi = args.ph_hi;
#define IN(k) (lo <= (k) && (k) < hi)
#define SEAM(k) do { if (IN(k) && IN((k) + 1)) GRID_BAR(); } while (0)

#ifndef PH_MASK
#define PH_MASK 0xfff
#endif
#define PHX(k) (((PH_MASK) >> (k)) & 1)
#ifndef DUP_MASK
#define DUP_MASK 0
#endif
#define REPS(k) (1 + (((DUP_MASK) >> (k)) & 1))
    if (PHX(11) && IN(0)) { for (int rep = 0; rep < REPS(11); ++rep) { if (rep) GRID_BAR(); ph_prep(F, args); __syncthreads(); conv_pull(F, args, 1 << 20, QN); }     SEAM(0); }

#define LAUNDER() do { asm volatile("" : "+v"(F.tid)); F.lane = F.tid & 63; F.wave = __builtin_amdgcn_readfirstlane(F.tid >> 6); } while (0)
    for (int l = 0; l < DEPTH; ++l) {
        const int pb = 1 + l * PH_PER_LAYER;
        unsigned char* wb = F.ws + WS_W + (size_t)l * W_STRIDE;
        const bf16* xin = (l == 0) ? (const bf16*)(F.ws + WS_XB) : (const bf16*)(F.ws + WS_XC);
        if (PHX(0) && IN(pb + 0)) { for (int rep = 0; rep < REPS(0); ++rep) { if (rep) GRID_BAR();
            pg8::Gemm g{xin, (const bf16*)(wb + W_IN), M, NPROJ, D}; pg8::StaticOrder S; S.init(M, NPROJ, F.G, (int)blockIdx.x);
            EpiInProj E{(bf16*)(F.ws + WS_P), (const float*)(F.ws + WS_RSI) + (size_t)l * M};
            run_gemm(F, g, S, E);
            } SEAM(pb + 0);
        }
        if (PHX(1) && IN(pb + 1)) { for (int rep = 0; rep < REPS(1); ++rep) { if (rep) GRID_BAR(); LAUNDER();
            for (int bi = (int)blockIdx.x; bi < 256; bi += F.G) { const int wi = bi * 8 + F.wave; ssm_item<false>(F, args, l, wi >> 6, (wi >> 5) & 1, wi & 31); }
            } SEAM(pb + 1);
        }
        if (PHX(2) && IN(pb + 2)) { for (int rep = 0; rep < REPS(2); ++rep) { if (rep) GRID_BAR(); LAUNDER();
            for (int bi = (int)blockIdx.x; bi < 256; bi += F.G) { if (F.wave < 4) { float xs[4]; const int wi = bi * 8 + 2 * F.wave;
                ssm_item<true>(F, args, l, wi >> 6, (wi >> 5) & 1, wi & 31, xs, false); ssm_item<true>(F, args, l, wi >> 6, (wi >> 5) & 1, (wi & 31) + 1, xs, true); } }
            } SEAM(pb + 2);
        }
        if (PHX(3) && IN(pb + 3)) { for (int rep = 0; rep < REPS(3); ++rep) { if (rep) GRID_BAR();
            pg8::Gemm g{(const bf16*)(F.ws + WS_YG), (const bf16*)(wb + W_GLU), M, DH, DH}; pg8::StaticOrder S; S.init(M, DH, F.G, (int)blockIdx.x);
            EpiGlu E{(const bf16*)(F.ws + WS_YG), (bf16*)(F.ws + WS_MIX), args.in[I_GLUB] + l * DH, (float*)(F.ws + WS_SSP)};
            run_gemm(F, g, S, E);
            LAUNDER();
            if (F.G >= 256) { for (int c = (int)blockIdx.x - 128; c >= 0 && c < 128; c += F.G) sgu_chunk_mfma(F, args, l, c); }
            else { for (int c = (int)blockIdx.x; c < 128; c += F.G) sgu_chunk_mfma(F, args, l, c); }
            } SEAM(pb + 3);
        }
        if (PHX(4) && IN(pb + 4)) { for (int rep = 0; rep < REPS(4); ++rep) { if (rep) GRID_BAR(); LAUNDER(); ph_normb(F, args, l); } SEAM(pb + 4); }
        if (PHX(5) && IN(pb + 5)) { for (int rep = 0; rep < REPS(5); ++rep) { if (rep) GRID_BAR();
            pg8::Gemm g{(const bf16*)(F.ws + WS_MIX), (const bf16*)(wb + W_OUT), M, D, D}; pg8::StaticOrder S; S.init(M, D, F.G, (int)blockIdx.x);
            EpiResid E{xin, (bf16*)(F.ws + WS_XA)};
            run_gemm(F, g, S, E);
            } SEAM(pb + 5);
        }
        if (PHX(6) && IN(pb + 6)) { for (int rep = 0; rep < REPS(6); ++rep) { if (rep) GRID_BAR(); LAUNDER(); ph_route_mfma(F, args, l, (REPS(6) == 2 && rep == 0) ? 2 + l : l); } SEAM(pb + 6); }
        if (PHX(7) && IN(pb + 7)) { for (int rep = 0; rep < REPS(7); ++rep) { if (rep) GRID_BAR();
            const int n = moe_tables(F, l, 8, 4, true);
            pg8::Gemm g{(const bf16*)(F.ws + WS_XA), (const bf16*)(wb + W_GU), M, NE * 2048, D};
            LdsOrder<true> S{(const LAS unsigned*)(F.lds + TAB_OFF + 1024), n, F.G, (int)blockIdx.x, (const LAS int*)(F.lds + TAB_OFF), (const LAS int*)(F.lds + TAB_OFF) + 64, (const int*)(F.ws + WS_XS), (const LAS unsigned*)(F.lds + TAB_OFF + 10240)};
            EpiSwiglu E{(bf16*)(F.ws + WS_ACT), args.in[I_BGU] + (size_t)l * NE * 2048, (const float*)(F.ws + WS_H2), (const LAS int*)(F.lds + TAB_OFF), (const LAS int*)(F.lds + TAB_OFF) + 64};
            S.fill_rows((LAS unsigned*)(F.lds + TAB_OFF + 10240), F.tid); __syncthreads();
            run_gemm(F, g, S, E);
            } SEAM(pb + 7);
        }
        if (PHX(8) && IN(pb + 8)) { for (int rep = 0; rep < REPS(8); ++rep) { if (rep) GRID_BAR();
            const int n = moe_tables(F, l, 4, 8, true, REPS(8) == 2 || REPS(9) == 2);
            pg8::Gemm g{(const bf16*)(F.ws + WS_ACT), (const bf16*)(wb + W_DN), SLOTS, NE * D, D};
            LdsOrder<false> S{(const LAS unsigned*)(F.lds + TAB_OFF + 1024), n, F.G, (int)blockIdx.x, (const LAS int*)(F.lds + TAB_OFF), (const LAS int*)(F.lds + TAB_OFF) + 64, (const int*)(F.ws + WS_XS), (const LAS unsigned*)(F.lds + TAB_OFF + 10240)};
            EpiDown E{(bf16*)(F.ws + WS_YB), args.in[I_BDN] + (size_t)l * NE * D};
            run_gemm(F, g, S, E);
            } SEAM(pb + 8);
        }
        if (PHX(9) && IN(pb + 9)) { for (int rep = 0; rep < REPS(9); ++rep) { if (rep) GRID_BAR(); LAUNDER(); ph_combine(F, args, l); } SEAM(pb + 9); }
    }
#undef IN
#undef SEAM
}

extern "C" void kernel_launch(void* const* d_in, const int* in_sizes, int n_in, void* d_out, int out_size, void* d_ws, size_t ws_size, hipStream_t stream) {
    static int grid = 0;
    if (grid == 0) {
        if (n_in != 28 || in_sizes[0] != M * D || out_size != M * D || ws_size < WS_END) { fprintf(stderr, "kernel_launch: unexpected shapes (n_in %d, in0 %d, out %d, ws %zu < %zu); nothing launched\n", n_in, n_in > 0 ? in_sizes[0] : -1, out_size, ws_size, (size_t)WS_END); grid = -1; return; }
        int dev = 0, cus = 0, per_cu = 0;
        if (hipGetDevice(&dev) != hipSuccess || hipDeviceGetAttribute(&cus, hipDeviceAttributeMultiprocessorCount, dev) != hipSuccess) { grid = -1; return; }
        if (hipFuncSetAttribute((const void*)mk_fwd, hipFuncAttributeMaxDynamicSharedMemorySize, LDS_BYTES) != hipSuccess) { fprintf(stderr, "kernel_launch: hipFuncSetAttribute failed\n"); grid = -1; return; }
        if (hipOccupancyMaxActiveBlocksPerMultiprocessor(&per_cu, (const void*)mk_fwd, NWAVES * 64, LDS_BYTES) != hipSuccess || per_cu < 1) { fprintf(stderr, "kernel_launch: occupancy query reports %d workgroups per CU\n", per_cu); }
        (void)hipGetLastError();
        grid = cus;
        if (grid % 8 != 0 || grid < 8) { fprintf(stderr, "kernel_launch: %d CUs: unsupported\n", grid); grid = -1; return; }
    }
    if (grid < 0) return;
    if (hipMemsetAsync((char*)d_ws + WS_CTL, 0, CTL_ZERO_BYTES, stream) != hipSuccess) return;
    Args a{};
    for (int i = 0; i < 28; ++i) a.in[i] = (const float*)d_in[i];
    a.out = (float*)d_out; a.ws = (unsigned char*)d_ws;
#if N_LAUNCH_MODE == 1
    a.ph_lo = 0; a.ph_hi = N_PHASES;
    hipLaunchKernelGGL(mk_fwd, dim3(grid), dim3(NWAVES * 64), LDS_BYTES, stream, a);
#else
    for (int p = 0; p < N_PHASES; ++p) { a.ph_lo = p; a.ph_hi = p + 1; hipLaunchKernelGGL(mk_fwd, dim3(grid), dim3(NWAVES * 64), LDS_BYTES, stream, a); }
#endif
}
```

```cpp
#include <hip/hip_runtime.h>
#include <cstdio>
#include <cstdint>
#ifndef N_LAUNCH_MODE
#define N_LAUNCH_MODE 1
#endif
namespace pg8 {
#define PG8_LAS __attribute__((address_space(3)))
typedef unsigned short bf16_t;
typedef short bf16x8 __attribute__((ext_vector_type(8)));
typedef float f32x4 __attribute__((ext_vector_type(4)));
typedef unsigned u32x4 __attribute__((ext_vector_type(4)));
constexpr int BM = 256, BK = 64, HALF = 128, HTB = HALF * BK * 2  , STAGE_BYTES = 8 * HTB, NXCD = 8, WGM = 8;

__host__ __device__ __forceinline__ int lds_byte(int r, int c) { const int st = (r >> 4) * 2 + (c >> 5), rr = r & 15, cc = c & 31, ob = rr * 64 + cc * 2; return st * 1024 + (ob ^ (((ob >> 9) & 1) << 5)); }
__host__ __device__ __forceinline__ void stage_rc(int b, int& R, int& C) { const int st = b / 1024, sb = b % 1024, swz = sb ^ (((sb >> 9) & 1) << 5); R = (st >> 1) * 16 + swz / 64; C = (st & 1) * 32 + (swz % 64) / 2; }
__host__ __device__ __forceinline__ int perm32(int rho) { const int n = rho >> 4, i = rho & 15; return 8 * (i >> 2) + 4 * n + (i & 3); }

struct Unit { int pm, pn, li; };
struct Gemm { const bf16_t* A; const bf16_t* Bt; int M, N, K; };

struct StaticOrder {
    static constexpr bool GATHER = false;
    int nM, nN, nwg, G, c;
    __host__ __device__ void init(int M, int N, int G_, int c_) { nM = M / BM; nN = N / BM; nwg = nM * nN; G = G_; c = c_; }
    __host__ __device__ bool next(int i, Unit& u) const {
        const long L = (long)i * G + c; if (L >= nwg) return false;
        int wgid = (int)L; { const int q = nwg / NXCD, r = nwg % NXCD, xcd = wgid % NXCD, off = wgid / NXCD; wgid = (xcd < r ? xcd * (q + 1) : r * (q + 1) + (xcd - r) * q) + off; }
        const int nig = WGM * nN, gid = wgid / nig, fm = gid * WGM, gsz = (nM - fm) < WGM ? (nM - fm) : WGM;
        u.pm = fm + ((wgid % nig) % gsz); u.pn = (wgid % nig) / gsz; u.li = i; return true;
    }
    __device__ __forceinline__ void a_ready(const Unit&) const {}
    __device__ __forceinline__ void done(const Unit&) const {}
};

typedef __bf16 bf16x2_t __attribute__((ext_vector_type(2)));
typedef float f32x2c_t __attribute__((ext_vector_type(2)));
__device__ __forceinline__ unsigned cvt_pk_bf16(float lo, float hi) { const bf16x2_t r = __builtin_convertvector((f32x2c_t){lo, hi}, bf16x2_t); unsigned u = __builtin_bit_cast(unsigned, r); asm volatile("s_nop 1" : "+v"(u)); return u; }
__device__ __forceinline__ unsigned cvt_pk_bf16_raw(float lo, float hi) { const bf16x2_t r = __builtin_convertvector((f32x2c_t){lo, hi}, bf16x2_t); return __builtin_bit_cast(unsigned, r); }
template <class Epi, class Sched, bool ALIGN_EPI = true>
__device__ __forceinline__ void gemm_phase(PG8_LAS unsigned char* lds, const Gemm g, const Sched& S, const Epi& E) {
    int tid_ = threadIdx.x; asm volatile("" : "+v"(tid_));
    const int tid = tid_, wid = __builtin_amdgcn_readfirstlane(tid >> 6), lane = tid & 63, wr = wid >> 2, wc = wid & 3, fr = lane & 15, fq = lane >> 4;
    const int K = g.K, nt = K / BK;
    int RA[2]; unsigned cofA[2], voffB[2];
#pragma unroll
    for (int i = 0; i < 2; ++i) { int R, C; stage_rc(tid * 16 + i * 8192, R, C); const int Rb = Epi::PERM ? ((R & ~31) + perm32(R & 31)) : R;
        RA[i] = R; cofA[i] = (unsigned)C * 2u; voffB[i] = (unsigned)(Rb * K + C) * 2u; }
    const size_t kstep = (size_t)(BK * 2);
    const size_t hstep = (size_t)HALF * K * 2;
    const size_t tstep = 2 * hstep;
    const unsigned ldsw = (unsigned)wid * 1024u;
    const int aoff = lds_byte(wr * 64 + fr, fq * 8), boff = lds_byte(wc * 32 + fr, fq * 8);
    const char* gA = (const char*)g.A;
#define PG8_AOFF(dst, u) do { _Pragma("unroll") for (int _h = 0; _h < 2; ++_h) _Pragma("unroll") for (int _i = 0; _i < 2; ++_i) { \
        if constexpr (Sched::GATHER) dst[_h][_i] = S.arow((u), _h * HALF + RA[_i]) + cofA[_i]; \
        else dst[_h][_i] = (unsigned)(((u).pm * BM + _h * HALF + RA[_i]) * K) * 2u + cofA[_i]; } } while (0)
#define PG8_SA(b, h) (((b) * 2 + (h)) * HTB)
#define PG8_SB(b, h) ((4 + (b) * 2 + (h)) * HTB)
#define PG8_STAGE(bufoff, gbase, voff) do { _Pragma("unroll") for (int _i = 0; _i < 2; ++_i) \
        __builtin_amdgcn_global_load_lds((const unsigned*)((const char*)(gbase) + (voff)[_i]), (PG8_LAS unsigned*)(lds + (bufoff) + ldsw + _i * 8192), 16, 0, 0); } while (0)
#define PG8_LDA(dst, b, h) do { _Pragma("unroll") for (int m = 0; m < 4; ++m) _Pragma("unroll") for (int k = 0; k < 2; ++k) dst[m][k] = *(const PG8_LAS bf16x8*)(lds + PG8_SA(b, h) + aoff + m * 2048 + k * 1024); } while (0)
#define PG8_LDB(dst, b, h) do { _Pragma("unroll") for (int n = 0; n < 2; ++n) _Pragma("unroll") for (int k = 0; k < 2; ++k) dst[n][k] = *(const PG8_LAS bf16x8*)(lds + PG8_SB(b, h) + boff + n * 2048 + k * 1024); } while (0)
#define PG8_MMA(ai, bj, At, Bt) do { __builtin_amdgcn_s_setprio(1); _Pragma("unroll") for (int m = 0; m < 4; ++m) _Pragma("unroll") for (int n = 0; n < 2; ++n) _Pragma("unroll") for (int k = 0; k < 2; ++k) \
        acc[ai][bj][m][n] = __builtin_amdgcn_mfma_f32_16x16x32_bf16(Bt[n][k], At[m][k], acc[ai][bj][m][n], 0, 0, 0); __builtin_amdgcn_s_setprio(0); } while (0)
#define PG8_WAIT_V(n) asm volatile("s_waitcnt vmcnt(" #n ")" ::: "memory")
#define PG8_WAIT_L(n) asm volatile("s_waitcnt lgkmcnt(" #n ")" ::: "memory")
#define PG8_BAR __builtin_amdgcn_s_barrier()
#define PG8_SCHED __builtin_amdgcn_sched_barrier(0)
    Unit cur, nxt; int ui = 0;
    if (!S.next(0, cur)) return;
    f32x4 acc[2][2][4][2];
#pragma unroll
    for (int a = 0; a < 2; ++a)
#pragma unroll
        for (int b = 0; b < 2; ++b)
#pragma unroll
            for (int m = 0; m < 4; ++m)
#pragma unroll
                for (int n = 0; n < 2; ++n) acc[a][b][m][n] = (f32x4){0.f, 0.f, 0.f, 0.f};
    bf16x8 At[4][2], B0[2][2], B1[2][2];
    unsigned oC[2][2], oN[2][2];
    PG8_AOFF(oC, cur);
    const char* cB = (const char*)g.Bt + (size_t)cur.pn * tstep;
    S.a_ready(cur);
    PG8_STAGE(PG8_SB(0, 0), cB, voffB); PG8_STAGE(PG8_SB(0, 1), cB + hstep, voffB); PG8_STAGE(PG8_SA(0, 0), gA, oC[0]); PG8_STAGE(PG8_SA(0, 1), gA, oC[1]);
    if (wr == 1) PG8_BAR;
    PG8_WAIT_V(2); PG8_BAR;
    PG8_STAGE(PG8_SB(1, 0), cB + kstep, voffB); PG8_STAGE(PG8_SA(1, 0), gA + kstep, oC[0]); PG8_STAGE(PG8_SB(1, 1), cB + hstep + kstep, voffB);
    PG8_WAIT_V(6); PG8_BAR;
    for (;;) {
        const bool has_next = S.next(ui + 1, nxt);
        if (has_next) PG8_AOFF(oN, nxt);
        else {
#pragma unroll
            for (int _h = 0; _h < 2; ++_h)
#pragma unroll
                for (int _i = 0; _i < 2; ++_i) oN[_h][_i] = oC[_h][_i]; }
        const char* nB = has_next ? (const char*)g.Bt + (size_t)nxt.pn * tstep : cB;
        for (int t = 0; t < nt; t += 2) {
            const bool last = (t == nt - 2);
            if constexpr (Epi::MIDK) { if (t == (nt >> 1)) E.midk(acc, cur, wr, wc, fr, fq); }
            const char* a1 = gA + (size_t)(t + 1) * kstep;
            const char* a2 = last ? gA : gA + (size_t)(t + 2) * kstep; const char* b2 = last ? nB : cB + (size_t)(t + 2) * kstep;
            const char* a3 = a2 + kstep; const char* b3 = b2 + kstep;
            unsigned o2[2][2];
#pragma unroll
            for (int _h = 0; _h < 2; ++_h)
#pragma unroll
                for (int _i = 0; _i < 2; ++_i) o2[_h][_i] = last ? oN[_h][_i] : oC[_h][_i];
            if (last && has_next) S.a_ready(nxt);
            PG8_LDB(B0, 0, 0); PG8_LDB(B1, 0, 1); PG8_SCHED; PG8_LDA(At, 0, 0); PG8_STAGE(PG8_SA(1, 1), a1, oC[1]);
            PG8_WAIT_V(8); PG8_WAIT_L(0); PG8_BAR; PG8_MMA(0, 0, At, B0); PG8_MMA(0, 1, At, B1); PG8_BAR; PG8_SCHED;
            PG8_LDA(At, 0, 1); PG8_STAGE(PG8_SB(0, 0), b2, voffB); PG8_STAGE(PG8_SB(0, 1), b2 + hstep, voffB); PG8_STAGE(PG8_SA(0, 0), a2, o2[0]);
            PG8_WAIT_V(8); PG8_WAIT_L(0); PG8_BAR; PG8_MMA(1, 0, At, B0); PG8_MMA(1, 1, At, B1); PG8_BAR; PG8_SCHED;
            PG8_LDB(B0, 1, 0); PG8_LDB(B1, 1, 1); PG8_SCHED; PG8_LDA(At, 1, 0); PG8_STAGE(PG8_SA(0, 1), a2, o2[1]);
            PG8_WAIT_V(8); PG8_WAIT_L(0); PG8_BAR; PG8_MMA(0, 0, At, B0); PG8_MMA(0, 1, At, B1); PG8_BAR; PG8_SCHED;
            PG8_LDA(At, 1, 1); PG8_STAGE(PG8_SB(1, 0), b3, voffB); PG8_STAGE(PG8_SB(1, 1), b3 + hstep, voffB); PG8_STAGE(PG8_SA(1, 0), a3, o2[0]);
            PG8_WAIT_V(8); PG8_WAIT_L(0); PG8_BAR; PG8_MMA(1, 0, At, B0); PG8_MMA(1, 1, At, B1); PG8_BAR; PG8_SCHED;
        }
        if constexpr (ALIGN_EPI) { if (wr == 0) PG8_BAR; }
        E(acc, cur, wr, wc, fr, fq); S.done(cur);
        if (!has_next) break;
#pragma unroll
        for (int a = 0; a < 2; ++a)
#pragma unroll
            for (int b = 0; b < 2; ++b)
#pragma unroll
                for (int m = 0; m < 4; ++m)
#pragma unroll
                    for (int n = 0; n < 2; ++n) acc[a][b][m][n] = (f32x4){0.f, 0.f, 0.f, 0.f};
        cur = nxt; cB = nB; ++ui;
#pragma unroll
        for (int _h = 0; _h < 2; ++_h)
#pragma unroll
            for (int _i = 0; _i < 2; ++_i) oC[_h][_i] = oN[_h][_i];
        if constexpr (ALIGN_EPI) { if (wr == 1) PG8_BAR; }
    }
    PG8_WAIT_V(0);
    if constexpr (!ALIGN_EPI) { if (wr == 0) PG8_BAR; }
    PG8_BAR;
#undef PG8_AOFF
#undef PG8_SA
#undef PG8_SB
#undef PG8_STAGE
#undef PG8_LDA
#undef PG8_LDB
#undef PG8_MMA
#undef PG8_WAIT_V
#undef PG8_WAIT_L
#undef PG8_BAR
#undef PG8_SCHED
}
}
#define GAS __attribute__((address_space(1)))
#define LAS __attribute__((address_space(3)))
typedef unsigned short bf16;
typedef unsigned v4u __attribute__((ext_vector_type(4)));
typedef float f32x4 __attribute__((ext_vector_type(4)));
typedef short bf16x8 __attribute__((ext_vector_type(8)));
typedef GAS unsigned gu32;
typedef GAS unsigned long long gu64;
#define RLX_AGENT __ATOMIC_RELAXED, __HIP_MEMORY_SCOPE_AGENT
#define LDS_WAIT() asm volatile("s_waitcnt lgkmcnt(0)" ::: "memory")
#define VM_WAIT() asm volatile("s_waitcnt vmcnt(0)" ::: "memory")
__device__ __forceinline__ unsigned long long rt() { return __builtin_amdgcn_s_memrealtime(); }
__device__ __forceinline__ unsigned f2bf(float f) { unsigned u = __builtin_bit_cast(unsigned, f); return (u + 0x7fffu + ((u >> 16) & 1u)) >> 16; }
__device__ __forceinline__ unsigned pk2(float lo, float hi) { return f2bf(lo) | (f2bf(hi) << 16); }

#define XB_TMO      128
#define XB_XCNT(j)  (256  + 64 * (j))
#define XB_XSUB(j)  (1280 + 64 * (j))
#define XB_XGEN(j)  (2304 + 64 * (j))
#define XB_TOP      3328
#define XB_TOPGEN   3392
#define XCD_BAR_WORDS 3456
#define XB_SPIN_CAP (1u << 18)

__device__ __forceinline__ unsigned xb_ld(unsigned* p)              { return __hip_atomic_load(p, __ATOMIC_RELAXED, __HIP_MEMORY_SCOPE_AGENT); }
__device__ __forceinline__ unsigned xb_add(unsigned* p, unsigned v) { return __hip_atomic_fetch_add(p, v, __ATOMIC_RELAXED, __HIP_MEMORY_SCOPE_AGENT); }
__device__ __forceinline__ unsigned xb_xcc_id() { return (unsigned)__builtin_amdgcn_s_getreg((3 << 11) | 20) & 0xFu; }
#define XB_SPIN(cond, bar) do { unsigned _sp = 0; while (cond) { __builtin_amdgcn_s_sleep(1); \
    if ((++_sp & 255u) == 0u) { if (xb_ld(&(bar)[XB_TMO])) break; if (_sp > XB_SPIN_CAP) { atomicAdd(&(bar)[XB_TMO], 1u); break; } } } } while (0)

struct XcdBarrier {
    unsigned* bar; unsigned x;
    volatile LAS unsigned* st;
};

__device__ __forceinline__ XcdBarrier xcd_barrier_post(unsigned* bar, volatile LAS unsigned* st) {
    XcdBarrier b; b.bar = bar; b.x = xb_xcc_id(); b.st = st;
    if (threadIdx.x == 0) (void)xb_add(&bar[XB_XCNT(b.x)], 1u);
    return b;
}
__device__ __forceinline__ void xcd_barrier_complete(unsigned* bar, unsigned x, unsigned& nloc, unsigned& nx) {
    const unsigned G = gridDim.x * gridDim.y * gridDim.z;
    unsigned sum, cnt, mine, sp = 0u;
    for (;;) {
        sum = 0u; cnt = 0u; mine = 0u;
#pragma unroll
        for (unsigned j = 0; j < 16; ++j) { const unsigned c = xb_ld(&bar[XB_XCNT(j)]); sum += c; cnt += (c > 0u) ? 1u : 0u; mine = (j == x) ? c : mine; }
        if (sum == G) break;
        __builtin_amdgcn_s_sleep(1);
        if ((++sp & 255u) == 0u) { if (xb_ld(&bar[XB_TMO])) break; if (sp > XB_SPIN_CAP) { atomicAdd(&bar[XB_TMO], 1u); break; } }
    }
    nloc = mine > 0u ? mine : 1u; nx = cnt > 0u ? cnt : 1u;
}

__device__ __forceinline__ void xcd_barrier(const XcdBarrier& b) {
    asm volatile("s_waitcnt vmcnt(0)" ::: "memory");
    __syncthreads();
    if (threadIdx.x == 0) {
        unsigned* bar = b.bar;
        __builtin_amdgcn_s_waitcnt(0);
        unsigned nloc = b.st[0], nx = b.st[1];
        if (nloc == 0u) { xcd_barrier_complete(bar, b.x, nloc, nx); b.st[0] = nloc; b.st[1] = nx; }
        const unsigned old = xb_add(&bar[XB_XSUB(b.x)], 1u);
        const unsigned gen = old / nloc;
        if (old + 1u == (gen + 1u) * nloc) {
            __builtin_amdgcn_fence(__ATOMIC_RELEASE, "agent");
            asm volatile("s_waitcnt vmcnt(0)" ::: "memory");
            const unsigned og = xb_add(&bar[XB_TOP], 1u);
            const unsigned tg = og / nx;
            if (og + 1u == (tg + 1u) * nx) xb_add(&bar[XB_TOPGEN], 1u);
            else XB_SPIN(xb_ld(&bar[XB_TOPGEN]) == tg, bar);
            __builtin_amdgcn_fence(__ATOMIC_ACQUIRE, "agent");
            xb_add(&bar[XB_XGEN(b.x)], 1u);
            asm volatile("s_waitcnt vmcnt(0)" ::: "memory");
        } else {
            XB_SPIN(xb_ld(&bar[XB_XGEN(b.x)]) == gen, bar);
            __builtin_amdgcn_fence(__ATOMIC_ACQUIRE, "agent");
            asm volatile("s_waitcnt vmcnt(0)" ::: "memory");
        }
    }
    __syncthreads();
}
constexpr int M = 16384, D = 1024, DH = 512, NPROJ = 1536, NE = 32, TOPK = 4, NAS = M * TOPK, SLOTS = NAS + NE * 256, SEQ = 4096, NBATCH = 4, NCH = 32, NG = 32, NP = 64, DEPTH = 2;
constexpr float EPS = 1e-5f;
constexpr int NWAVES = 8;
constexpr size_t MiB = 1u << 20;
constexpr size_t WS_CTL = 0, CTL_ZERO_BYTES = 512 * 1024;
constexpr int CW_BAR = 1024;
constexpr int CW_Q = 6144;
constexpr int CW_CNT = 8192;
constexpr int CW_SS = 16384;
static_assert((CW_SS + DEPTH * 2 * M) * 4 <= (int)CTL_ZERO_BYTES, "CTL words inside the memset region");
constexpr size_t WS_RE = 1 * MiB;
constexpr size_t WS_RK = WS_RE + (size_t)NAS * 4;
constexpr size_t WS_GW = WS_RK + (size_t)NAS * 4;
constexpr size_t WS_SO = WS_GW + (size_t)NAS * 4;
constexpr size_t WS_TGU = WS_SO + (size_t)NAS * 4;
constexpr size_t WS_TDN = WS_TGU + 288 * 8 * 8;
constexpr size_t WS_META = WS_TDN + 288 * 4 * 8;
constexpr size_t WS_SSMP = 3 * MiB;
constexpr size_t SSMP_ABAR = 0, SSMP_A128 = 16384, SSMP_BBAR = 32768, SSMP_CTAB = SSMP_BBAR + 262144, SSMP_STRIDE = SSMP_CTAB + 262144;
constexpr size_t WS_BB16 = 5 * MiB;
constexpr size_t WS_CT16 = WS_BB16 + 512 * 1024;
constexpr size_t WS_RWT = 6 * MiB + 512 * 1024;
constexpr size_t WS_RSI = 7 * MiB;
constexpr size_t WS_WM = 6 * MiB;
static_assert(WS_META + 256 <= WS_SSMP && WS_SSMP + DEPTH * SSMP_STRIDE <= WS_BB16 && WS_WM + DEPTH * 4 * 128 * 128 * 2 <= 8 * MiB, "small tables");
constexpr size_t WS_W = 8 * MiB, W_IN = 0, W_OUT = 3 * MiB, W_GLU = 5 * MiB, W_GU = 6 * MiB, W_DN = 134 * MiB, W_STRIDE = 198 * MiB;
constexpr size_t WS_XB = WS_W + DEPTH * W_STRIDE;
constexpr size_t WS_P = WS_XB + 32 * MiB;
constexpr size_t WS_YG = WS_P + 48 * MiB;
constexpr size_t WS_MIX = WS_YG + 16 * MiB;
constexpr size_t WS_XA = WS_MIX + 32 * MiB;
constexpr size_t WS_XC = WS_XA + 64 * MiB;
constexpr size_t WS_H2 = WS_XC + 64 * MiB;
constexpr size_t WS_XS = WS_H2 + 32 * MiB;
constexpr size_t WS_ACT = WS_XS + 144 * MiB;
constexpr size_t WS_YB = WS_ACT + 144 * MiB;
constexpr size_t WS_EST = WS_YB + 144 * MiB;
constexpr size_t WS_SSP = WS_EST + 2 * MiB;
constexpr size_t WS_END = WS_SSP + 1 * MiB;
static_assert((size_t)SLOTS * D * 2 == 144 * MiB, "slot buffers");
constexpr int RING_OFF = 0, RING_BYTES = 131072;
constexpr int TAB_OFF = 131072;
constexpr int LDSCTL_OFF = 151552, MISC_OFF = LDSCTL_OFF + 6144;
constexpr int LDS_BYTES = 159744;
static_assert(MISC_OFF + 128 <= LDS_BYTES, "LDS map");
constexpr int PH_PER_LAYER = 10, N_PHASES = 1 + DEPTH * PH_PER_LAYER;
__device__ __forceinline__ float wave_sum(float v) {
#pragma unroll
    for (int o = 1; o < 64; o <<= 1) v += __shfl_xor(v, o);
    return v;
}
__device__ __forceinline__ float fast_sigmoid(float x) { return __builtin_amdgcn_rcpf(1.0f + __builtin_amdgcn_exp2f(-1.4426950409f * x)); }
__device__ __forceinline__ float gelu_tanh(float x) { const float u = x * (1.5957691216f + 0.0713548163f * x * x); return x * fast_sigmoid(u); }
__device__ __forceinline__ float bf2f(unsigned short b) { return __builtin_bit_cast(float, (unsigned)b << 16); }
__device__ __forceinline__ float bflo(unsigned w) { return __builtin_bit_cast(float, w << 16); }
__device__ __forceinline__ float bfhi(unsigned w) { return __builtin_bit_cast(float, w & 0xffff0000u); }
typedef unsigned v2u __attribute__((ext_vector_type(2)));
typedef float f32x2_t __attribute__((ext_vector_type(2)));

struct EpiInProj {
    static constexpr bool PERM = true, MIDK = false;
    bf16* P; const float* rs;
    __device__ __forceinline__ void operator()(const pg8::f32x4 (&acc)[2][2][4][2], const pg8::Unit& u, int wr, int wc, int fr, int fq) const {
        const int t = u.pn >> 1; const bool act = t < 2;
        bf16* base = P + (size_t)t * M * DH;
        const int row0 = u.pm * 256 + wr * 64 + fr, col0 = (u.pn & 1) * 256 + wc * 32 + 8 * fq;
#pragma unroll
        for (int ai = 0; ai < 2; ++ai)
#pragma unroll
            for (int m = 0; m < 4; ++m) { bf16* rowp = base + (size_t)(row0 + ai * 128 + m * 16) * DH + col0; const float rsv = rs[row0 + ai * 128 + m * 16];
#pragma unroll
                for (int bj = 0; bj < 2; ++bj) { pg8::f32x4 v0 = acc[ai][bj][m][0] * rsv, v1 = acc[ai][bj][m][1] * rsv;
                    if (act) {
#pragma unroll
                        for (int j = 0; j < 4; ++j) { v0[j] = gelu_tanh(v0[j]); v1[j] = gelu_tanh(v1[j]); } }
                    v4u w; w.x = pg8::cvt_pk_bf16(v0[0], v0[1]); w.y = pg8::cvt_pk_bf16(v0[2], v0[3]); w.z = pg8::cvt_pk_bf16(v1[0], v1[1]); w.w = pg8::cvt_pk_bf16(v1[2], v1[3]);
                    *(v4u*)(rowp + bj * 128) = w; } }
    }
};
struct EpiGlu {
    static constexpr bool PERM = true, MIDK = false;
    const bf16* YG; bf16* MIX; const float* bias; float* ss;
    __device__ __forceinline__ void operator()(const pg8::f32x4 (&acc)[2][2][4][2], const pg8::Unit& u, int wr, int wc, int fr, int fq) const {
        const int row0 = u.pm * 256 + wr * 64 + fr, col0 = u.pn * 256 + wc * 32 + 8 * fq;
        pg8::f32x4 bv[2][2];
#pragma unroll
        for (int bj = 0; bj < 2; ++bj)
#pragma unroll
            for (int n = 0; n < 2; ++n) bv[bj][n] = *(const pg8::f32x4*)(bias + col0 + bj * 128 + 4 * n);
#pragma unroll
        for (int ai = 0; ai < 2; ++ai)
#pragma unroll
            for (int m = 0; m < 4; ++m) { const int row = row0 + ai * 128 + m * 16; float sq = 0.f;
#pragma unroll
                for (int bj = 0; bj < 2; ++bj) { const int col = col0 + bj * 128;
                    const v4u yw = *(const v4u*)(YG + (size_t)row * DH + col);
                    const pg8::f32x4 g0 = acc[ai][bj][m][0] + bv[bj][0], g1 = acc[ai][bj][m][1] + bv[bj][1];
                    float o[8];
                    o[0] = bflo(yw.x) * fast_sigmoid(g0[0]); o[1] = bfhi(yw.x) * fast_sigmoid(g0[1]); o[2] = bflo(yw.y) * fast_sigmoid(g0[2]); o[3] = bfhi(yw.y) * fast_sigmoid(g0[3]);
                    o[4] = bflo(yw.z) * fast_sigmoid(g1[0]); o[5] = bfhi(yw.z) * fast_sigmoid(g1[1]); o[6] = bflo(yw.w) * fast_sigmoid(g1[2]); o[7] = bfhi(yw.w) * fast_sigmoid(g1[3]);
#pragma unroll
                    for (int j = 0; j < 8; ++j) sq += o[j] * o[j];
                    v4u w; w.x = pg8::cvt_pk_bf16(o[0], o[1]); w.y = pg8::cvt_pk_bf16(o[2], o[3]); w.z = pg8::cvt_pk_bf16(o[4], o[5]); w.w = pg8::cvt_pk_bf16(o[6], o[7]);
                    *(v4u*)(MIX + (size_t)row * D + DH + col) = w; }
                sq += __shfl_xor(sq, 16); sq += __shfl_xor(sq, 32);
                if (fq == 0) ss[(size_t)row * 8 + u.pn * 4 + wc] = sq; }
    }
};
struct EpiResid {
    static constexpr bool PERM = true, MIDK = false;
    const bf16* resid; bf16* out;
    __device__ __forceinline__ void operator()(const pg8::f32x4 (&acc)[2][2][4][2], const pg8::Unit& u, int wr, int wc, int fr, int fq) const {
        const int row0 = u.pm * 256 + wr * 64 + fr, col0 = u.pn * 256 + wc * 32 + 8 * fq;
#pragma unroll
        for (int ai = 0; ai < 2; ++ai)
#pragma unroll
            for (int m = 0; m < 4; ++m) { const size_t off = (size_t)(row0 + ai * 128 + m * 16) * D + col0;
#pragma unroll
                for (int bj = 0; bj < 2; ++bj) { const v4u r = *(const v4u*)(resid + off + bj * 128); const pg8::f32x4 a0 = acc[ai][bj][m][0], a1 = acc[ai][bj][m][1];
                    v4u w; w.x = pg8::cvt_pk_bf16(bflo(r.x) + a0[0], bfhi(r.x) + a0[1]); w.y = pg8::cvt_pk_bf16(bflo(r.y) + a0[2], bfhi(r.y) + a0[3]);
                    w.z = pg8::cvt_pk_bf16(bflo(r.z) + a1[0], bfhi(r.z) + a1[1]); w.w = pg8::cvt_pk_bf16(bflo(r.w) + a1[2], bfhi(r.w) + a1[3]);
                    *(v4u*)(out + off + bj * 128) = w; } }
    }
};
struct EpiSwiglu {
    static constexpr bool PERM = true, MIDK = false;
    bf16* ACT; const float* bgu;
    const float* rse; const LAS int* offL; const LAS int* cntL;
    __device__ __forceinline__ void operator()(const pg8::f32x4 (&acc)[2][2][4][2], const pg8::Unit& u, int wr, int wc, int fr, int fq) const {
        const int e = u.pn >> 3, pn = u.pn & 7;
        const int row0 = u.pm * 256 + wr * 64 + fr, col0 = pn * 128 + wc * 32 + 8 * fq;
        const float* bg = bgu + (size_t)e * 2048 + col0;
        pg8::f32x4 bgl[2], bli[2];
#pragma unroll
        for (int n = 0; n < 2; ++n) { bgl[n] = *(const pg8::f32x4*)(bg + 4 * n); bli[n] = *(const pg8::f32x4*)(bg + 1024 + 4 * n); }
        float rsa[2][4];
        { const int o0 = offL[e], cn = cntL[e];
#pragma unroll
          for (int ai = 0; ai < 2; ++ai)
#pragma unroll
            for (int m = 0; m < 4; ++m) { const int rank = row0 + ai * 128 + m * 16 - o0; rsa[ai][m] = rse[(size_t)e * NAS + (rank < cn ? rank : cn - 1)]; } }
#pragma unroll
        for (int ai = 0; ai < 2; ++ai)
#pragma unroll
            for (int m = 0; m < 4; ++m) { float o[8]; const float rsv = rsa[ai][m];
#pragma unroll
                for (int n = 0; n < 2; ++n)
#pragma unroll
                    for (int j = 0; j < 4; ++j) { float gl = acc[ai][0][m][n][j] * rsv + bgl[n][j], li = acc[ai][1][m][n][j] * rsv + bli[n][j];
                        gl = fminf(gl, 7.0f); li = fminf(fmaxf(li, -7.0f), 7.0f);
                        o[4 * n + j] = gl * fast_sigmoid(1.702f * gl) * (li + 1.0f); }
                v4u w; w.x = pg8::cvt_pk_bf16(o[0], o[1]); w.y = pg8::cvt_pk_bf16(o[2], o[3]); w.z = pg8::cvt_pk_bf16(o[4], o[5]); w.w = pg8::cvt_pk_bf16(o[6], o[7]);
                *(v4u*)(ACT + (size_t)(row0 + ai * 128 + m * 16) * D + col0) = w; }
    }
};
struct EpiDown {
    static constexpr bool PERM = true, MIDK = false;
    bf16* YB; const float* bdn;
    __device__ __forceinline__ void operator()(const pg8::f32x4 (&acc)[2][2][4][2], const pg8::Unit& u, int wr, int wc, int fr, int fq) const {
        const int e = u.pn >> 2, pn = u.pn & 3;
        const int row0 = u.pm * 256 + wr * 64 + fr, col0 = pn * 256 + wc * 32 + 8 * fq;
        const float* bb = bdn + (size_t)e * D + col0;
        pg8::f32x4 bv[2][2];
#pragma unroll
        for (int bj = 0; bj < 2; ++bj)
#pragma unroll
            for (int n = 0; n < 2; ++n) bv[bj][n] = *(const pg8::f32x4*)(bb + bj * 128 + 4 * n);
#pragma unroll
        for (int ai = 0; ai < 2; ++ai)
#pragma unroll
            for (int m = 0; m < 4; ++m) { bf16* rowp = YB + (size_t)(row0 + ai * 128 + m * 16) * D + col0;
#pragma unroll
                for (int bj = 0; bj < 2; ++bj) { const pg8::f32x4 v0 = acc[ai][bj][m][0] + bv[bj][0], v1 = acc[ai][bj][m][1] + bv[bj][1];
                    v4u w; w.x = pg8::cvt_pk_bf16(v0[0], v0[1]); w.y = pg8::cvt_pk_bf16(v0[2], v0[3]); w.z = pg8::cvt_pk_bf16(v1[0], v1[1]); w.w = pg8::cvt_pk_bf16(v1[2], v1[3]);
                    *(v4u*)(rowp + bj * 128) = w; } }
    }
};
template <bool GATHER_>
struct LdsOrder {
    static constexpr bool GATHER = GATHER_;
    const LAS unsigned* tab; int n, G, c;
    const LAS int* offL; const LAS int* cntL; const int* tok; const LAS unsigned* rows;
    __device__ __forceinline__ bool next(int i, pg8::Unit& u) const {
        const int per = G >> 3, L = (i * 8 + (c & 7)) * per + (c >> 3);
        if (L >= n) return false;
        const unsigned e = (unsigned)__builtin_amdgcn_readfirstlane((int)tab[L]);
        u.pm = (int)(e & 0xfffu); u.pn = (int)(e >> 12); u.li = i;
        return true;
    }
    __device__ __forceinline__ unsigned arow(const pg8::Unit& u, int r) const { return rows[u.li * 256 + r]; }
    __device__ __forceinline__ void fill_rows(LAS unsigned* rw, int tid) const {
        pg8::Unit u;
        for (int i = 0; i < 10 && next(i, u); ++i)
            for (int r = tid; r < 256; r += NWAVES * 64) { const int e = u.pn >> 3, rank = u.pm * 256 + r - offL[e], cn = cntL[e], idx = rank < cn ? rank : cn - 1;
                rw[i * 256 + r] = (unsigned)tok[e * NAS + idx] * (unsigned)(D * 2); }
    }
    __device__ __forceinline__ void a_ready(const pg8::Unit&) const {}
    __device__ __forceinline__ void done(const pg8::Unit&) const {}
};
struct Frame {
    LAS unsigned char* lds;
    volatile LAS unsigned* MISC;
    gu32* ctl;
    unsigned char* ws;
    int tid, lane, wave, vcu, G;
};
struct Args { const float* in[28]; float* out; unsigned char* ws; int ph_lo, ph_hi; };
enum { I_X = 0, I_ANW, I_WIN, I_LNW, I_LNB, I_SGUW, I_SGUB, I_ARE, I_AIM, I_BRE, I_BIM, I_CRE, I_CIM, I_SD, I_LOGDT, I_GLUW, I_GLUB, I_ONA, I_ONB, I_WOUT, I_FNW, I_RW, I_RB, I_WGU, I_BGU, I_WDN, I_BDN, I_FINW };

__device__ __forceinline__ void tr_item(const float* W, int K, int N, bf16* WT, int k0, int n0, int drow0, const float* sc, LAS float* scr, int lane) {
    const int c4 = lane & 15, kr = lane >> 4;
    f32x4 v[16];
#pragma unroll
    for (int i = 0; i < 16; ++i) v[i] = __builtin_nontemporal_load((const GAS f32x4*)(W + (size_t)(k0 + 4 * i + kr) * N + n0 + 4 * c4));
#pragma unroll
    for (int i = 0; i < 16; ++i) { const int k = 4 * i + kr; const float s = sc ? sc[k0 + k] : 1.0f; LAS float* d = scr + k * 65 + 4 * c4;
        d[0] = v[i].x * s; d[1] = v[i].y * s; d[2] = v[i].z * s; d[3] = v[i].w * s; }
    LDS_WAIT(); asm volatile("" ::: "memory");
    const int nl = lane & 7, kc = lane >> 3;
#pragma unroll
    for (int j = 0; j < 8; ++j) { const int n = nl + 8 * j; const LAS float* s = scr + (8 * kc) * 65 + n;
        v4u o; o.x = pk2(s[0 * 65], s[1 * 65]); o.y = pk2(s[2 * 65], s[3 * 65]); o.z = pk2(s[4 * 65], s[5 * 65]); o.w = pk2(s[6 * 65], s[7 * 65]);
        __builtin_nontemporal_store(o, (GAS v4u*)(WT + (size_t)(drow0 + n) * K + k0 + 8 * kc)); }
    LDS_WAIT(); asm volatile("" ::: "memory");
}
__device__ __forceinline__ void rms_row_to_bf16(const float* xrow, bf16* orow, float* rsp, int lane) {
    const GAS f32x4* xr = (const GAS f32x4*)xrow + lane;
    f32x4 v[4]; float s = 0.f;
#pragma unroll
    for (int j = 0; j < 4; ++j) { v[j] = xr[64 * j]; s += (v[j].x * v[j].x + v[j].y * v[j].y) + (v[j].z * v[j].z + v[j].w * v[j].w); }
    const float rs = 1.0f / sqrtf(wave_sum(s) * (1.f / D) + EPS);
    GAS unsigned long long* o8 = (GAS unsigned long long*)orow + lane;
#pragma unroll
    for (int j = 0; j < 4; ++j) o8[64 * j] = (unsigned long long)pk2(v[j].x, v[j].y) | ((unsigned long long)pk2(v[j].z, v[j].w) << 32);
    if (lane == 0) *rsp = rs;
}
constexpr int I_IN = 16 * 24, I_OUT = 16 * 16, I_GLU = 8 * 8, I_GU = NE * 16 * 32, I_DN = NE * 16 * 16;
constexpr int Q_L0GU = I_GU, Q_L0DN = Q_L0GU + I_DN, Q_L1GU = Q_L0DN + I_GU, QN = Q_L1GU + I_DN;
__device__ __forceinline__ void conv_gu_item(Frame& F, const Args& A, int l, int r, LAS float* scr) {
    unsigned char* wb = F.ws + WS_W + (size_t)l * W_STRIDE;
    const int e = r / 512, rr = r % 512, kb = rr / 32, nb = rr % 32, n0 = 64 * nb, j = n0 & 1023, half = n0 >> 10, drow0 = (j >> 7) * 256 + half * 128 + (j & 127);
    tr_item(A.in[I_WGU] + ((size_t)l * NE + e) * D * 2048, D, 2048, (bf16*)(wb + W_GU) + (size_t)e * 2048 * D, 64 * kb, n0, drow0, A.in[I_FNW] + l * D, scr, F.lane);
}
__device__ __forceinline__ void conv_dn_item(Frame& F, const Args& A, int l, int r, LAS float* scr) {
    unsigned char* wb = F.ws + WS_W + (size_t)l * W_STRIDE;
    const int e = r / 256, rr = r % 256, kb = rr / 16, nb = rr % 16;
    tr_item(A.in[I_WDN] + ((size_t)l * NE + e) * D * D, D, D, (bf16*)(wb + W_DN) + (size_t)e * D * D, 64 * kb, 64 * nb, 64 * nb, nullptr, scr, F.lane);
}
__device__ __forceinline__ void conv_pull(Frame& F, const Args& A, int nb, int until) {
    LAS float* scr = (LAS float*)(F.lds + RING_OFF + F.wave * 16640);
    LAS int* qb = (LAS int*)(F.lds + LDSCTL_OFF + 768);
    (void)nb; (void)until;
    if (F.tid == 0) qb[0] = (int)__hip_atomic_fetch_add(F.ctl + CW_Q, 8u, RLX_AGENT);
    __syncthreads();
    int base = qb[0];
    __syncthreads();
    while (base < QN) {
        unsigned nx = 0u;
        if (F.tid == 0) nx = __hip_atomic_fetch_add(F.ctl + CW_Q, 8u, RLX_AGENT);
        const int q = base + F.wave;
        if (q < Q_L0GU) conv_gu_item(F, A, 0, q, scr);
        else if (q < Q_L0DN) conv_dn_item(F, A, 0, q - Q_L0GU, scr);
        else if (q < Q_L1GU) conv_gu_item(F, A, 1, q - Q_L0DN, scr);
        else if (q < QN) conv_dn_item(F, A, 1, q - Q_L1GU, scr);
        if (F.tid == 0) qb[0] = (int)nx;
        __syncthreads();
        base = qb[0];
        __syncthreads();
    }
}
__device__ __forceinline__ void ph_prep(Frame& F, const Args& A) {
    LAS float* scr = (LAS float*)(F.lds + RING_OFF + F.wave * 16640);
    const int gw = F.vcu * NWAVES + F.wave, NGW = F.G * NWAVES;
    constexpr int PER_S = I_IN + I_OUT + I_GLU;
    for (int it = gw; it < DEPTH * PER_S; it += NGW) {
        const int l = it / PER_S; int r = it - l * PER_S;
        unsigned char* wb = F.ws + WS_W + (size_t)l * W_STRIDE;
        if (r < I_IN) { const int kb = r / 24, nb = r % 24; tr_item(A.in[I_WIN] + (size_t)l * D * NPROJ, D, NPROJ, (bf16*)(wb + W_IN), 64 * kb, 64 * nb, 64 * nb, A.in[I_ANW] + l * D, scr, F.lane); continue; } r -= I_IN;
        if (r < I_OUT) { const int kb = r / 16, nb = r % 16; const float* sc = (kb < 8) ? A.in[I_ONA] + l * DH : A.in[I_ONB] + l * DH - DH;
            tr_item(A.in[I_WOUT] + (size_t)l * D * D, D, D, (bf16*)(wb + W_OUT), 64 * kb, 64 * nb, 64 * nb, sc, scr, F.lane); continue; } r -= I_OUT;
        { const int kb = r / 8, nb = r % 8; tr_item(A.in[I_GLUW] + (size_t)l * DH * DH, DH, DH, (bf16*)(wb + W_GLU), 64 * kb, 64 * nb, 64 * nb, nullptr, scr, F.lane); }
    }
    for (int m = gw; m < M; m += NGW) rms_row_to_bf16(A.in[I_X] + (size_t)m * D, (bf16*)(F.ws + WS_XB) + (size_t)m * D, (float*)(F.ws + WS_RSI) + m, F.lane);
    for (int i = (F.vcu * NWAVES + F.wave) * 64 + F.lane; i < DEPTH * NG * NP; i += F.G * NWAVES * 64) {
        const int l = i / (NG * NP), gp = i % (NG * NP), g = gp / NP, p = gp % NP;
        unsigned char* sp = F.ws + WS_SSMP + (size_t)l * SSMP_STRIDE;
        const float dt = expf(A.in[I_LOGDT][l * NG + g]), ar = A.in[I_ARE][i], ai = A.in[I_AIM][i];
        const float ex = expf(dt * ar); float sn, cs; sincosf(dt * ai, &sn, &cs);
        const float abr = ex * cs, abi = ex * sn;
        const float nr = abr - 1.0f, ni = abi, den = ar * ar + ai * ai, cr = (nr * ar + ni * ai) / den, ci = (ni * ar - nr * ai) / den;
        ((float*)(sp + SSMP_ABAR))[gp * 2] = abr; ((float*)(sp + SSMP_ABAR))[gp * 2 + 1] = abi;
        float pr = abr, pi = abi;
#pragma unroll
        for (int k = 0; k < 7; ++k) { const float t = pr * pr - pi * pi; pi = 2.0f * pr * pi; pr = t; }
        ((float*)(sp + SSMP_A128))[gp * 2] = pr; ((float*)(sp + SSMP_A128))[gp * 2 + 1] = pi;
        float* bb = (float*)(sp + SSMP_BBAR) + (size_t)gp * 32;
        const float* bre = A.in[I_BRE] + (size_t)i * 16; const float* bim = A.in[I_BIM] + (size_t)i * 16;
#pragma unroll
        for (int h = 0; h < 16; ++h) { const float br = bre[h], bi = bim[h]; bb[h] = cr * br - ci * bi; bb[16 + h] = cr * bi + ci * br; }
        float* ct = (float*)(sp + SSMP_CTAB) + (size_t)g * 128 * 16;
        const float* cre = A.in[I_CRE] + (size_t)(l * NG + g) * 16 * NP; const float* cim = A.in[I_CIM] + (size_t)(l * NG + g) * 16 * NP;
#pragma unroll
        for (int h = 0; h < 16; ++h) { ct[p * 16 + h] = cre[h * NP + p]; ct[(64 + p) * 16 + h] = -cim[h * NP + p]; }
        bf16* bb16 = (bf16*)(F.ws + WS_BB16) + (size_t)(l * NG + g) * 2048; bf16* ct16 = (bf16*)(F.ws + WS_CT16) + (size_t)(l * NG + g) * 2048;
#pragma unroll
        for (int h = 0; h < 16; ++h) { bb16[((p >> 5) * 32 + (p & 31)) * 16 + h] = (bf16)f2bf(bb[h]); bb16[((2 + (p >> 5)) * 32 + (p & 31)) * 16 + h] = (bf16)f2bf(bb[16 + h]);
            ct16[h * 128 + p] = (bf16)f2bf(cre[h * NP + p]); ct16[h * 128 + 64 + p] = (bf16)f2bf(-cim[h * NP + p]); }
    }
    for (int i = (F.vcu * NWAVES + F.wave) * 64 + F.lane; i < DEPTH * D * NE; i += F.G * NWAVES * 64) { const int l = i / (D * NE), k = (i / NE) % D, e = i % NE;
        const float w = A.in[I_RW][i] * A.in[I_FNW][l * D + k]; const unsigned hi = f2bf(w); const float lo = w - __builtin_bit_cast(float, hi << 16);
        bf16* t = (bf16*)(F.ws + WS_RWT) + (size_t)l * 2 * NE * D; t[e * D + k] = (bf16)hi; t[(NE + e) * D + k] = (bf16)f2bf(lo); }
    for (int i = (F.vcu * NWAVES + F.wave) * 64 + F.lane; i < DEPTH * 4 * 128 * 128; i += F.G * NWAVES * 64) { const int t = (i >> 7) & 127, sx = i & 127;
        ((bf16*)(F.ws + WS_WM))[i] = (sx <= t) ? (bf16)f2bf(A.in[I_SGUW][i]) : (bf16)0; }
}

typedef short v4i16_t __attribute__((ext_vector_type(4)));
__device__ __forceinline__ void sgu_chunk_mfma(Frame& F, const Args& A, int l, int c) {
    const bf16* UG = (const bf16*)(F.ws + WS_P); const bf16* VG = UG + (size_t)M * DH;
    bf16* MIX = (bf16*)(F.ws + WS_MIX);
    const bf16* Wm = (const bf16*)(F.ws + WS_WM) + (size_t)l * 4 * 128 * 128;
    constexpr int PITCH = 1056;
    LAS unsigned char* vn = F.lds + RING_OFF;
    const float* lnw = A.in[I_LNW] + l * DH; const float* lnb = A.in[I_LNB] + l * DH;
    {
        const f32x4 w0 = *(const GAS f32x4*)(lnw + 8 * F.lane), w1 = *(const GAS f32x4*)(lnw + 8 * F.lane + 4), b0 = *(const GAS f32x4*)(lnb + 8 * F.lane), b1 = *(const GAS f32x4*)(lnb + 8 * F.lane + 4);
        const float ww[8] = {w0.x, w0.y, w0.z, w0.w, w1.x, w1.y, w1.z, w1.w}, bb[8] = {b0.x, b0.y, b0.z, b0.w, b1.x, b1.y, b1.z, b1.w};
#pragma unroll 4
        for (int r = F.wave * 16; r < F.wave * 16 + 16; ++r) {
            const v4u w = *(const GAS v4u*)(VG + (size_t)(c * 128 + r) * DH + 8 * F.lane);
            float v[8] = {bflo(w.x), bfhi(w.x), bflo(w.y), bfhi(w.y), bflo(w.z), bfhi(w.z), bflo(w.w), bfhi(w.w)};
            float s = 0.f, s2 = 0.f;
#pragma unroll
            for (int j = 0; j < 8; ++j) { s += v[j]; s2 += v[j] * v[j]; }
            s = wave_sum(s); s2 = wave_sum(s2);
            const float mean = s * (1.f / DH), var = fmaxf(s2 * (1.f / DH) - mean * mean, 0.f), rstd = 1.0f / sqrtf(var + EPS);
            float o[8];
#pragma unroll
            for (int j = 0; j < 8; ++j) o[j] = (v[j] - mean) * rstd * ww[j] + bb[j];
            v4u ow; ow.x = pk2(o[0], o[1]); ow.y = pk2(o[2], o[3]); ow.z = pk2(o[4], o[5]); ow.w = pk2(o[6], o[7]);
            *(LAS v4u*)(vn + r * PITCH + 16 * F.lane) = ow;
        }
    }
    __syncthreads();
    const int w = F.wave, fr = F.lane & 15, G = F.lane >> 4, rr = (F.lane >> 2) & 3, cc = F.lane & 3;
    const int nks = (w >> 1) + 1;
    const int trow = c * 128 + w * 16 + fr;
    LAS unsigned char* trb = vn + (4 * G + rr) * PITCH + 8 * cc;
    pg8::f32x4 acc[4][8];
#pragma unroll
    for (int h = 0; h < 4; ++h)
#pragma unroll
        for (int dt = 0; dt < 8; ++dt) acc[h][dt] = (pg8::f32x4){0.f, 0.f, 0.f, 0.f};
    for (int ks = 0; ks < nks; ++ks) {
#pragma unroll
        for (int h = 0; h < 4; ++h) {
            const bf16* wp = Wm + ((size_t)h * 128 + w * 16 + fr) * 128 + ks * 32 + 4 * G;
            const v2u wlo = *(const GAS v2u*)wp, whi = *(const GAS v2u*)(wp + 16);
            const v4u wf4 = (v4u){wlo.x, wlo.y, whi.x, whi.y};
            const bf16x8 wf = __builtin_bit_cast(bf16x8, wf4);
#pragma unroll
            for (int dt = 0; dt < 8; ++dt) {
                const LAS unsigned char* pa = trb + ks * 32 * PITCH + (h * 128 + dt * 16) * 2;
                const v4i16_t a0 = __builtin_amdgcn_ds_read_tr16_b64_v4i16((LAS v4i16_t*)pa), a1 = __builtin_amdgcn_ds_read_tr16_b64_v4i16((LAS v4i16_t*)(pa + 16 * PITCH));
                const bf16x8 af = (bf16x8){a0[0], a0[1], a0[2], a0[3], a1[0], a1[1], a1[2], a1[3]};
                acc[h][dt] = __builtin_amdgcn_mfma_f32_16x16x32_bf16(af, wf, acc[h][dt], 0, 0, 0);
            }
        }
    }
    float ss = 0.f;
#pragma unroll
    for (int h = 0; h < 4; ++h) { const float bt = A.in[I_SGUB][(size_t)(l * 4 + h) * 128 + w * 16 + fr];
#pragma unroll
        for (int dt = 0; dt < 8; ++dt) { const v2u uw = *(const GAS v2u*)(UG + (size_t)trow * DH + h * 128 + dt * 16 + 4 * G);
            pg8::f32x4 y = acc[h][dt] + bt; y[0] *= bflo(uw.x); y[1] *= bfhi(uw.x); y[2] *= bflo(uw.y); y[3] *= bfhi(uw.y);
            acc[h][dt] = y; ss += (y[0] * y[0] + y[1] * y[1]) + (y[2] * y[2] + y[3] * y[3]); } }
    ss += __shfl_xor(ss, 16); ss += __shfl_xor(ss, 32);
    const float rs = 1.0f / sqrtf(ss * (1.f / DH) + EPS);
#pragma unroll
    for (int h = 0; h < 4; ++h)
#pragma unroll
        for (int dt = 0; dt < 8; ++dt) { const pg8::f32x4 y = acc[h][dt] * rs; v2u o; o.x = pk2(y[0], y[1]); o.y = pk2(y[2], y[3]);
            *(GAS v2u*)(MIX + (size_t)trow * D + h * 128 + dt * 16 + 4 * G) = o; }
    __syncthreads();
}

typedef float f32x16 __attribute__((ext_vector_type(16)));
template <bool FULL>
__device__ __forceinline__ void ssm_item(Frame& F, const Args& A, int l, int g, int bp, int ch, float* xcarry = nullptr, bool cont = false) {
    const unsigned char* sp = F.ws + WS_SSMP + (size_t)l * SSMP_STRIDE;
    const bf16* US = (const bf16*)(F.ws + WS_P) + (size_t)2 * M * DH;
    const int lane = F.lane, H = lane >> 5, s = lane & 31;
    const float* abp = (const float*)(sp + SSMP_ABAR) + (size_t)g * NP * 2;
    const float a0r = abp[s * 2], a0i = abp[s * 2 + 1], a1r = abp[(32 + s) * 2], a1i = abp[(32 + s) * 2 + 1];
    bf16x8 bq[4];
    { const bf16* bb16 = (const bf16*)(F.ws + WS_BB16) + (size_t)(l * NG + g) * 2048;
#pragma unroll
      for (int q = 0; q < 4; ++q) bq[q] = *(const GAS bf16x8*)(bb16 + (q * 32 + s) * 16 + 8 * H); }
    float x0r = 0.f, x0i = 0.f, x1r = 0.f, x1i = 0.f;
    const int b = 2 * bp + H;
    if (FULL && cont) { x0r = xcarry[0]; x0i = xcarry[1]; x1r = xcarry[2]; x1i = xcarry[3]; }
    if (FULL && !cont) {
        const float* a8p = (const float*)(sp + SSMP_A128) + (size_t)g * NP * 2;
        const float c0r = a8p[s * 2], c0i = a8p[s * 2 + 1], c1r = a8p[(32 + s) * 2], c1i = a8p[(32 + s) * 2 + 1];
        const float* est = (const float*)(F.ws + WS_EST) + (((size_t)b * NG + g) * NCH * NP) * 2;
        for (int cb = 0; cb < ch; cb += 8) {
            f32x2_t ea[8], eb[8];
#pragma unroll
            for (int k = 0; k < 8; ++k) { const int cc = (cb + k < ch) ? cb + k : ch - 1; ea[k] = *(const GAS f32x2_t*)(est + ((size_t)cc * NP + s) * 2); eb[k] = *(const GAS f32x2_t*)(est + ((size_t)cc * NP + 32 + s) * 2); }
#pragma unroll
            for (int k = 0; k < 8; ++k) if (cb + k < ch) {
                float nr = c0r * x0r - c0i * x0i + ea[k].x, ni = c0r * x0i + c0i * x0r + ea[k].y; x0r = nr; x0i = ni;
                nr = c1r * x1r - c1i * x1i + eb[k].x; ni = c1r * x1i + c1i * x1r + eb[k].y; x1r = nr; x1i = ni; } }
    }
    const int ai = lane & 31;
    const bf16* ap = US + ((size_t)(2 * bp + ((ai >> 2) & 1)) * SEQ + ch * 128 + (ai & 3) + 4 * (ai >> 3)) * DH + g * 16 + 8 * H;
    constexpr int XP = 272;
    LAS unsigned char* xt = F.lds + RING_OFF + F.wave * (32 * XP);
    bf16x8 cq[4]; f32x4 dv = (f32x4){0.f, 0.f, 0.f, 0.f};
    const int fr = lane & 15, G = lane >> 4;
    if (FULL) { const bf16* ct16 = (const bf16*)(F.ws + WS_CT16) + (size_t)(l * NG + g) * 2048;
#pragma unroll
        for (int q = 0; q < 4; ++q) cq[q] = *(const GAS bf16x8*)(ct16 + fr * 128 + q * 32 + 8 * G);
        dv = *(const GAS f32x4*)(A.in[I_SD] + l * DH + g * 16 + 4 * G); }
    bf16x8 af = *(const GAS bf16x8*)ap;
    for (int tb = 0; tb < 8; ++tb) {
        const bf16x8 afn = *(const GAS bf16x8*)(ap + (size_t)((tb < 7 ? tb + 1 : tb) * 16) * DH);
        v2u uwp[2] = {(v2u){0u, 0u}, (v2u){0u, 0u}};
        if (FULL) {
#pragma unroll
            for (int hb = 0; hb < 2; ++hb) uwp[hb] = *(const GAS v2u*)(US + ((size_t)(2 * bp + hb) * SEQ + ch * 128 + tb * 16 + fr) * DH + g * 16 + 4 * G); }
        f32x16 z;
#pragma unroll
        for (int i = 0; i < 16; ++i) z[i] = 0.f;
        f32x16 r0 = __builtin_amdgcn_mfma_f32_32x32x16_bf16(af, bq[0], z, 0, 0, 0);
        f32x16 r1 = __builtin_amdgcn_mfma_f32_32x32x16_bf16(af, bq[1], z, 0, 0, 0);
        f32x16 i0 = __builtin_amdgcn_mfma_f32_32x32x16_bf16(af, bq[2], z, 0, 0, 0);
        f32x16 i1 = __builtin_amdgcn_mfma_f32_32x32x16_bf16(af, bq[3], z, 0, 0, 0);
#pragma unroll
        for (int t = 0; t < 16; ++t) {
            float nr = a0r * x0r - a0i * x0i + r0[t], ni = a0r * x0i + a0i * x0r + i0[t]; x0r = nr; x0i = ni;
            nr = a1r * x1r - a1i * x1i + r1[t]; ni = a1r * x1i + a1i * x1r + i1[t]; x1r = nr; x1i = ni;
            if (FULL) { LAS bf16* xr = (LAS bf16*)(xt + (H * 16 + t) * XP) + s;
                unsigned p0 = pg8::cvt_pk_bf16_raw(x0r, x0r), p1 = pg8::cvt_pk_bf16_raw(x1r, x1r), p2 = pg8::cvt_pk_bf16_raw(x0i, x0i), p3 = pg8::cvt_pk_bf16_raw(x1i, x1i);
                asm volatile("s_nop 1" : "+v"(p0), "+v"(p1), "+v"(p2), "+v"(p3));
                xr[0] = (bf16)p0; xr[32] = (bf16)p1; xr[64] = (bf16)p2; xr[96] = (bf16)p3;
                asm volatile("s_nop 1" :: "v"(p0), "v"(p1), "v"(p2), "v"(p3) : "memory"); }
        }
        if (FULL) {
            LDS_WAIT(); asm volatile("" ::: "memory");
#pragma unroll
            for (int hb = 0; hb < 2; ++hb) {
                pg8::f32x4 y = (pg8::f32x4){0.f, 0.f, 0.f, 0.f};
#pragma unroll
                for (int q = 0; q < 4; ++q) { const bf16x8 xf = *(const LAS bf16x8*)(xt + (hb * 16 + fr) * XP + q * 64 + 16 * G); y = __builtin_amdgcn_mfma_f32_16x16x32_bf16(cq[q], xf, y, 0, 0, 0); }
                const size_t row = (size_t)(2 * bp + hb) * SEQ + ch * 128 + tb * 16 + fr;
                const v2u uw = uwp[hb];
                y[0] += dv.x * bflo(uw.x); y[1] += dv.y * bfhi(uw.x); y[2] += dv.z * bflo(uw.y); y[3] += dv.w * bfhi(uw.y);
                v2u o; o.x = pk2(gelu_tanh(y[0]), gelu_tanh(y[1])); o.y = pk2(gelu_tanh(y[2]), gelu_tanh(y[3]));
                *(GAS v2u*)((bf16*)(F.ws + WS_YG) + row * DH + g * 16 + 4 * G) = o;
            }
            LDS_WAIT(); asm volatile("" ::: "memory");
        }
        af = afn;
    }
    if (FULL && xcarry) { xcarry[0] = x0r; xcarry[1] = x0i; xcarry[2] = x1r; xcarry[3] = x1i; }
    if (!FULL) { float* est = (float*)(F.ws + WS_EST) + ((((size_t)b * NG + g) * NCH + ch) * NP) * 2;
        *(GAS f32x2_t*)(est + s * 2) = (f32x2_t){x0r, x0i}; *(GAS f32x2_t*)(est + (32 + s) * 2) = (f32x2_t){x1r, x1i}; }
}

__device__ __forceinline__ void ph_normb(Frame& F, const Args& A, int l) {
    bf16* MIX = (bf16*)(F.ws + WS_MIX);
    const float* ssp = (const float*)(F.ws + WS_SSP);
    const int gw = F.vcu * NWAVES + F.wave, NGW = F.G * NWAVES;
    for (int mb = gw; mb < M; mb += 8 * NGW) {
        f32x4 p0[8], p1[8]; v4u w[8];
#pragma unroll
        for (int j = 0; j < 8; ++j) { const int m = mb + j * NGW; if (m < M) { p0[j] = *(const GAS f32x4*)(ssp + (size_t)m * 8); p1[j] = *(const GAS f32x4*)(ssp + (size_t)m * 8 + 4); w[j] = *(const GAS v4u*)(MIX + (size_t)m * D + DH + 8 * F.lane); } }
#pragma unroll
        for (int j = 0; j < 8; ++j) { const int m = mb + j * NGW; if (m < M) {
            const float s = 1.0f / sqrtf((((p0[j].x + p0[j].y) + (p0[j].z + p0[j].w)) + ((p1[j].x + p1[j].y) + (p1[j].z + p1[j].w))) * (1.f / DH) + EPS);
            v4u o; o.x = pk2(bflo(w[j].x) * s, bfhi(w[j].x) * s); o.y = pk2(bflo(w[j].y) * s, bfhi(w[j].y) * s); o.z = pk2(bflo(w[j].z) * s, bfhi(w[j].z) * s); o.w = pk2(bflo(w[j].w) * s, bfhi(w[j].w) * s);
            *(GAS v4u*)(MIX + (size_t)m * D + DH + 8 * F.lane) = o; } }
    }
}

__device__ __forceinline__ void ph_route_mfma(Frame& F, const Args& A, int l, int cbank) {
    const bf16* XA = (const bf16*)(F.ws + WS_XA); float* RSE = (float*)(F.ws + WS_H2);
    int* RE = (int*)(F.ws + WS_RE); int* RK = (int*)(F.ws + WS_RK); float* GW = (float*)(F.ws + WS_GW);
    gu32* cnt = F.ctl + CW_CNT + cbank * NE;
    constexpr int WP = 2064, PL_OFF = 64 * WP, SSQ_OFF = PL_OFF + 2 * 64 * 32 * 4;
    static_assert(SSQ_OFF + 512 + 2048 <= LDSCTL_OFF, "route LDS map");
    LAS unsigned char* wt = F.lds + RING_OFF;
    LAS float* PL = (LAS float*)(F.lds + PL_OFF); LAS float* SSQ = (LAS float*)(F.lds + SSQ_OFF);
    LAS int* lcnt = (LAS int*)(F.lds + LDSCTL_OFF); LAS int* lbase = lcnt + 32;
    LAS int* as_e = (LAS int*)(F.lds + LDSCTL_OFF + 1024); LAS int* as_lr = as_e + 256; LAS float* as_g = (LAS float*)(as_lr + 256);
    LAS float* as_rs = (LAS float*)(F.lds + LDSCTL_OFF + 4096);
    const float* rb = A.in[I_RB] + l * NE;
    { const bf16* src = (const bf16*)(F.ws + WS_RWT) + (size_t)l * 2 * NE * D;
      v4u wv[16];
#pragma unroll
      for (int q = 0; q < 16; ++q) { const int i = F.tid + q * (NWAVES * 64), row = i >> 7, ch = i & 127; wv[q] = *(const GAS v4u*)(src + (size_t)row * D + ch * 8); }
#pragma unroll
      for (int q = 0; q < 16; ++q) { const int i = F.tid + q * (NWAVES * 64), row = i >> 7, ch = i & 127; *(LAS v4u*)(wt + row * WP + ch * 16) = wv[q]; } }
    const int fr = F.lane & 15, G = F.lane >> 4, rg = F.wave & 3;
    for (int blk = F.vcu; blk < M / 64; blk += F.G) {
        if (F.tid < 32) lcnt[F.tid] = 0;
        __syncthreads();
        if (F.wave < 4) {
            v4u xall[2][16];
#pragma unroll
            for (int kh = 0; kh < 2; ++kh) { const bf16* xp = XA + (size_t)(blk * 64 + rg * 16 + fr) * D + kh * 512 + 8 * G;
#pragma unroll
                for (int ks = 0; ks < 16; ++ks) xall[kh][ks] = *(const GAS v4u*)(xp + ks * 32); }
#pragma unroll
            for (int kh = 0; kh < 2; ++kh) {
                pg8::f32x4 a0 = (pg8::f32x4){0.f, 0.f, 0.f, 0.f}, a1 = a0; float ssq = 0.f;
                const LAS unsigned char* wp = wt + fr * WP + (kh * 512 + 8 * G) * 2;
#pragma unroll
                for (int ks = 0; ks < 16; ++ks) {
                    const v4u xw = xall[kh][ks]; const bf16x8 xb = __builtin_bit_cast(bf16x8, xw);
                    { const float x0 = bflo(xw.x), x1 = bfhi(xw.x), x2 = bflo(xw.y), x3 = bfhi(xw.y), x4 = bflo(xw.z), x5 = bfhi(xw.z), x6 = bflo(xw.w), x7 = bfhi(xw.w);
                      ssq += ((x0 * x0 + x1 * x1) + (x2 * x2 + x3 * x3)) + ((x4 * x4 + x5 * x5) + (x6 * x6 + x7 * x7)); }
                    const bf16x8 w0h = *(const LAS bf16x8*)(wp + ks * 64), w1h = *(const LAS bf16x8*)(wp + 16 * WP + ks * 64);
                    const bf16x8 w0l = *(const LAS bf16x8*)(wp + 32 * WP + ks * 64), w1l = *(const LAS bf16x8*)(wp + 48 * WP + ks * 64);
                    a0 = __builtin_amdgcn_mfma_f32_16x16x32_bf16(w0h, xb, a0, 0, 0, 0); a1 = __builtin_amdgcn_mfma_f32_16x16x32_bf16(w1h, xb, a1, 0, 0, 0);
                    a0 = __builtin_amdgcn_mfma_f32_16x16x32_bf16(w0l, xb, a0, 0, 0, 0); a1 = __builtin_amdgcn_mfma_f32_16x16x32_bf16(w1l, xb, a1, 0, 0, 0);
                }
                ssq += __shfl_xor(ssq, 16); ssq += __shfl_xor(ssq, 32);
                LAS float* pl = PL + ((kh * 64 + rg * 16 + fr) * 32);
                *(LAS pg8::f32x4*)(pl + 4 * G) = a0; *(LAS pg8::f32x4*)(pl + 16 + 4 * G) = a1;
                if (G == 0) SSQ[kh * 64 + rg * 16 + fr] = ssq;
            }
        }
        __syncthreads();
#pragma unroll 1
        for (int rr = 0; rr < 8; rr += 2) {
            const int L = F.lane, e = L >> 1;
            int lr[2]; float rs[2], val[2], mx[2], ex[2], den[2]; int rank[2]; bool win[2];
#pragma unroll
            for (int u = 0; u < 2; ++u) lr[u] = F.wave * 8 + rr + u;
#pragma unroll
            for (int u = 0; u < 2; ++u) { rs[u] = 1.0f / sqrtf((SSQ[lr[u]] + SSQ[64 + lr[u]]) * (1.f / D) + EPS);
                val[u] = (PL[lr[u] * 32 + e] + PL[(64 + lr[u]) * 32 + e]) * rs[u] + rb[e];
                LAS float* lrow = (LAS float*)(F.lds + SSQ_OFF + 512) + (F.wave * 2 + u) * 32;
                if ((L & 1) == 0) lrow[e] = val[u]; }
            LDS_WAIT(); asm volatile("" ::: "memory");
#pragma unroll
            for (int u = 0; u < 2; ++u) { const LAS float* lrow = (const LAS float*)(F.lds + SSQ_OFF + 512) + (F.wave * 2 + u) * 32; const float v = val[u]; int rk = 0;
#pragma unroll
                for (int q = 0; q < 8; ++q) { const f32x4 o = *(const LAS f32x4*)(lrow + 4 * q);
                    rk += (o.x > v || (o.x == v && 4 * q + 0 < e)) ? 1 : 0; rk += (o.y > v || (o.y == v && 4 * q + 1 < e)) ? 1 : 0;
                    rk += (o.z > v || (o.z == v && 4 * q + 2 < e)) ? 1 : 0; rk += (o.w > v || (o.w == v && 4 * q + 3 < e)) ? 1 : 0; }
                rank[u] = rk; mx[u] = v; }
            asm volatile("" ::: "memory");
#pragma unroll
            for (int o = 2; o < 64; o <<= 1) { mx[0] = fmaxf(mx[0], __shfl_xor(mx[0], o)); mx[1] = fmaxf(mx[1], __shfl_xor(mx[1], o)); }
#pragma unroll
            for (int u = 0; u < 2; ++u) { win[u] = (rank[u] < 4) && ((L & 1) == 0); ex[u] = win[u] ? __expf(val[u] - mx[u]) : 0.f; den[u] = ex[u]; }
#pragma unroll
            for (int o = 1; o < 64; o <<= 1) { den[0] += __shfl_xor(den[0], o); den[1] += __shfl_xor(den[1], o); }
#pragma unroll
            for (int u = 0; u < 2; ++u) {
                if (L == 0) as_rs[lr[u]] = rs[u];
                if (win[u]) { const int slr = __hip_atomic_fetch_add(lcnt + e, 1, __ATOMIC_RELAXED, __HIP_MEMORY_SCOPE_WORKGROUP);
                    const int ix = lr[u] * 4 + rank[u]; as_e[ix] = e; as_lr[ix] = slr; as_g[ix] = ex[u] / den[u]; } }
            LDS_WAIT(); asm volatile("" ::: "memory");
        }
        __syncthreads();
        if (F.tid < 32) lbase[F.tid] = (int)__hip_atomic_fetch_add(cnt + F.tid, (unsigned)lcnt[F.tid], RLX_AGENT);
        __syncthreads();
        if (F.tid < 256) { const int a = blk * 256 + F.tid, e = as_e[F.tid], rk = lbase[e] + as_lr[F.tid]; RE[a] = e; RK[a] = rk; GW[a] = as_g[F.tid]; ((int*)(F.ws + WS_XS))[e * NAS + rk] = a >> 2; RSE[e * NAS + rk] = as_rs[F.tid >> 2]; }
        __syncthreads();
    }
}

__device__ __forceinline__ int moe_tables(Frame& F, int l, int NT, int GS, bool build, bool fresh = true) {
    gu32* cnt = F.ctl + CW_CNT + l * NE;
    LAS int* offL = (LAS int*)(F.lds + TAB_OFF); LAS int* cntL = offL + 64; LAS unsigned* tab = (LAS unsigned*)(F.lds + TAB_OFF + 1024);
    if (fresh) {
    if (F.tid < NE) cntL[F.tid] = (int)__hip_atomic_load(cnt + F.tid, RLX_AGENT);
    __syncthreads();
    if (F.tid == 0) { int o = 0; for (int e = 0; e < NE; ++e) { offL[e] = o; o += (cntL[e] + 255) & ~255; } offL[NE] = o; }
    __syncthreads();
    }
    if (build && F.tid < NE) { const int e = F.tid, t0 = offL[e] >> 8, mt = (offL[e + 1] - offL[e]) >> 8;
        int idx = t0 * NT;
        for (int pg = 0; pg * GS < mt; ++pg) { const int gs = (mt - pg * GS) < GS ? (mt - pg * GS) : GS;
            for (int pn = 0; pn < NT; ++pn) for (int pi = 0; pi < gs; ++pi) { tab[idx] = (unsigned)(t0 + pg * GS + pi) | ((unsigned)(e * NT + pn) << 12); ++idx; } } }
    __syncthreads();
    return (offL[NE] >> 8) * NT;
}

__device__ __forceinline__ void ph_combine(Frame& F, const Args& A, int l) {
    const bf16* XA = (const bf16*)(F.ws + WS_XA); bf16* XC = (bf16*)(F.ws + WS_XC); float* RSI = (float*)(F.ws + WS_RSI) + M;
    const bf16* YB = (const bf16*)(F.ws + WS_YB); const int* RE = (const int*)(F.ws + WS_RE); const int* RK = (const int*)(F.ws + WS_RK); const float* GW = (const float*)(F.ws + WS_GW);
    (void)moe_tables(F, l, 4, 8, false, false);
    const LAS int* offL = (const LAS int*)(F.lds + TAB_OFF);
    const int gw = F.vcu * NWAVES + F.wave, NGW = F.G * NWAVES;
    const bool last = (l == DEPTH - 1);
    for (int jb = 0; gw + jb * NGW < M; jb += 16) {
        int slot_l = 0; float g_l = 0.f;
        { const int ml = gw + (jb + (F.lane >> 2)) * NGW;
          if (ml < M) { const int a = ml * 4 + (F.lane & 3); slot_l = offL[__hip_atomic_load(RE + a, RLX_AGENT)] + __hip_atomic_load(RK + a, RLX_AGENT); g_l = __hip_atomic_load(GW + a, RLX_AGENT); } }
        v2u xa[4], ya[4][4], xb[4], yb[4][4];
#define COMB_LOAD(X, Y, J) do { const int m_ = gw + (jb + (J)) * NGW; const GAS v2u* xr_ = (const GAS v2u*)(XA + (size_t)m_ * D) + F.lane; \
            _Pragma("unroll") for (int q = 0; q < 4; ++q) (X)[q] = xr_[64 * q]; \
            _Pragma("unroll") for (int k = 0; k < 4; ++k) { const int slot_ = __builtin_amdgcn_readlane(slot_l, 4 * (J) + k); const GAS v2u* yp_ = (const GAS v2u*)(YB + (size_t)slot_ * D) + F.lane; \
                _Pragma("unroll") for (int q = 0; q < 4; ++q) (Y)[k][q] = yp_[64 * q]; } } while (0)
        COMB_LOAD(xa, ya, 0);
#pragma unroll 1
        for (int jj = 0; jj < 16; ++jj) {
            const int m = gw + (jb + jj) * NGW;
            if (m >= M) break;
            const bool more = (jj < 15) && (m + NGW < M);
            if (more) COMB_LOAD(xb, yb, jj + 1);
            f32x4 v[4];
#pragma unroll
            for (int q = 0; q < 4; ++q) v[q] = (f32x4){bflo(xa[q].x), bfhi(xa[q].x), bflo(xa[q].y), bfhi(xa[q].y)};
#pragma unroll
            for (int k = 0; k < 4; ++k) { const float g = __builtin_bit_cast(float, __builtin_amdgcn_readlane(__builtin_bit_cast(int, g_l), 4 * jj + k));
#pragma unroll
                for (int q = 0; q < 4; ++q) { const v2u w = ya[k][q]; v[q].x += g * bflo(w.x); v[q].y += g * bfhi(w.x); v[q].z += g * bflo(w.y); v[q].w += g * bfhi(w.y); } }
            float sq = 0.f;
#pragma unroll
            for (int q = 0; q < 4; ++q) sq += (v[q].x * v[q].x + v[q].y * v[q].y) + (v[q].z * v[q].z + v[q].w * v[q].w);
            const float rs = 1.0f / sqrtf(wave_sum(sq) * (1.f / D) + EPS);
            if (!last) {
                GAS unsigned long long* o8 = (GAS unsigned long long*)(XC + (size_t)m * D) + F.lane;
#pragma unroll
                for (int q = 0; q < 4; ++q) o8[64 * q] = (unsigned long long)pk2(v[q].x, v[q].y) | ((unsigned long long)pk2(v[q].z, v[q].w) << 32);
                if (F.lane == 0) RSI[m] = rs;
            } else {
                GAS f32x4* oo = (GAS f32x4*)(A.out + (size_t)m * D) + F.lane; const GAS f32x4* fw = (const GAS f32x4*)A.in[I_FINW] + F.lane;
#pragma unroll
                for (int q = 0; q < 4; ++q) { const f32x4 w = fw[64 * q]; oo[64 * q] = v[q] * rs * w; }
            }
            if (more) {
#pragma unroll
                for (int q = 0; q < 4; ++q) { xa[q] = xb[q];
#pragma unroll
                    for (int k = 0; k < 4; ++k) ya[k][q] = yb[k][q]; } }
        }
#undef COMB_LOAD
    }
}
template <class Epi, class Sched>
__device__ __forceinline__ void run_gemm(Frame& F, const pg8::Gemm& g, const Sched& S, const Epi& E) {
    pg8::gemm_phase<Epi, Sched, true>(F.lds + RING_OFF, g, S, E);
}
__global__ void __launch_bounds__(NWAVES * 64, 2) mk_fwd(Args args) {
    extern __shared__ __attribute__((aligned(16))) unsigned char lds[];
    Frame F;
    F.lds = (LAS unsigned char*)lds;
    F.MISC = (volatile LAS unsigned*)(F.lds + MISC_OFF);
    F.tid = threadIdx.x; F.lane = F.tid & 63; F.wave = __builtin_amdgcn_readfirstlane(F.tid >> 6);
    F.G = gridDim.x; { const int bx = blockIdx.x; F.vcu = (F.G % 8 == 0) ? (bx % 8) * (F.G / 8) + bx / 8 : bx; }
    F.ws = args.ws; F.ctl = (gu32*)(args.ws + WS_CTL);
    for (int u = F.tid; u < (LDS_BYTES - LDSCTL_OFF) / 4; u += NWAVES * 64) ((LAS unsigned*)(F.lds + LDSCTL_OFF))[u] = 0u;
    __syncthreads();
#if N_LAUNCH_MODE == 1
    XcdBarrier bar = xcd_barrier_post((unsigned*)(F.ctl + CW_BAR), F.MISC + 8);
#define GRID_BAR() xcd_barrier(bar)
#else
#define GRID_BAR() do { } while (0)
#endif
    const int lo = args.ph_lo, hi = args.ph_hi;
#define IN(k) (lo <= (k) && (k) < hi)
#define SEAM(k) do { if (IN(k) && IN((k) + 1)) GRID_BAR(); } while (0)

#ifndef PH_MASK
#define PH_MASK 0xfff
#endif
#define PHX(k) (((PH_MASK) >> (k)) & 1)
#ifndef DUP_MASK
#define DUP_MASK 0
#endif
#define REPS(k) (1 + (((DUP_MASK) >> (k)) & 1))
    if (PHX(11) && IN(0)) { for (int rep = 0; rep < REPS(11); ++rep) { if (rep) GRID_BAR(); ph_prep(F, args); __syncthreads(); conv_pull(F, args, 1 << 20, QN); }     SEAM(0); }

#define LAUNDER() do { asm volatile("" : "+v"(F.tid)); F.lane = F.tid & 63; F.wave = __builtin_amdgcn_readfirstlane(F.tid >> 6); } while (0)
    for (int l = 0; l < DEPTH; ++l) {
        const int pb = 1 + l * PH_PER_LAYER;
        unsigned char* wb = F.ws + WS_W + (size_t)l * W_STRIDE;
        const bf16* xin = (l == 0) ? (const bf16*)(F.ws + WS_XB) : (const bf16*)(F.ws + WS_XC);
        if (PHX(0) && IN(pb + 0)) { for (int rep = 0; rep < REPS(0); ++rep) { if (rep) GRID_BAR();
            pg8::Gemm g{xin, (const bf16*)(wb + W_IN), M, NPROJ, D}; pg8::StaticOrder S; S.init(M, NPROJ, F.G, (int)blockIdx.x);
            EpiInProj E{(bf16*)(F.ws + WS_P), (const float*)(F.ws + WS_RSI) + (size_t)l * M};
            run_gemm(F, g, S, E);
            } SEAM(pb + 0);
        }
        if (PHX(1) && IN(pb + 1)) { for (int rep = 0; rep < REPS(1); ++rep) { if (rep) GRID_BAR(); LAUNDER();
            for (int bi = (int)blockIdx.x; bi < 256; bi += F.G) { const int wi = bi * 8 + F.wave; ssm_item<false>(F, args, l, wi >> 6, (wi >> 5) & 1, wi & 31); }
            } SEAM(pb + 1);
        }
        if (PHX(2) && IN(pb + 2)) { for (int rep = 0; rep < REPS(2); ++rep) { if (rep) GRID_BAR(); LAUNDER();
            for (int bi = (int)blockIdx.x; bi < 256; bi += F.G) { if (F.wave < 4) { float xs[4]; const int wi = bi * 8 + 2 * F.wave;
                ssm_item<true>(F, args, l, wi >> 6, (wi >> 5) & 1, wi & 31, xs, false); ssm_item<true>(F, args, l, wi >> 6, (wi >> 5) & 1, (wi & 31) + 1, xs, true); } }
            } SEAM(pb + 2);
        }
        if (PHX(3) && IN(pb + 3)) { for (int rep = 0; rep < REPS(3); ++rep) { if (rep) GRID_BAR();
            pg8::Gemm g{(const bf16*)(F.ws + WS_YG), (const bf16*)(wb + W_GLU), M, DH, DH}; pg8::StaticOrder S; S.init(M, DH, F.G, (int)blockIdx.x);
            EpiGlu E{(const bf16*)(F.ws + WS_YG), (bf16*)(F.ws + WS_MIX), args.in[I_GLUB] + l * DH, (float*)(F.ws + WS_SSP)};
            run_gemm(F, g, S, E);
            LAUNDER();
            if (F.G >= 256) { for (int c = (int)blockIdx.x - 128; c >= 0 && c < 128; c += F.G) sgu_chunk_mfma(F, args, l, c); }
            else { for (int c = (int)blockIdx.x; c < 128; c += F.G) sgu_chunk_mfma(F, args, l, c); }
            } SEAM(pb + 3);
        }
        if (PHX(4) && IN(pb + 4)) { for (int rep = 0; rep < REPS(4); ++rep) { if (rep) GRID_BAR(); LAUNDER(); ph_normb(F, args, l); } SEAM(pb + 4); }
        if (PHX(5) && IN(pb + 5)) { for (int rep = 0; rep < REPS(5); ++rep) { if (rep) GRID_BAR();
            pg8::Gemm g{(const bf16*)(F.ws + WS_MIX), (const bf16*)(wb + W_OUT), M, D, D}; pg8::StaticOrder S; S.init(M, D, F.G, (int)blockIdx.x);
            EpiResid E{xin, (bf16*)(F.ws + WS_XA)};
            run_gemm(F, g, S, E);
            } SEAM(pb + 5);
        }
        if (PHX(6) && IN(pb + 6)) { for (int rep = 0; rep < REPS(6); ++rep) { if (rep) GRID_BAR(); LAUNDER(); ph_route_mfma(F, args, l, (REPS(6) == 2 && rep == 0) ? 2 + l : l); } SEAM(pb + 6); }
        if (PHX(7) && IN(pb + 7)) { for (int rep = 0; rep < REPS(7); ++rep) { if (rep) GRID_BAR();
            const int n = moe_tables(F, l, 8, 4, true);
            pg8::Gemm g{(const bf16*)(F.ws + WS_XA), (const bf16*)(wb + W_GU), M, NE * 2048, D};
            LdsOrder<true> S{(const LAS unsigned*)(F.lds + TAB_OFF + 1024), n, F.G, (int)blockIdx.x, (const LAS int*)(F.lds + TAB_OFF), (const LAS int*)(F.lds + TAB_OFF) + 64, (const int*)(F.ws + WS_XS), (const LAS unsigned*)(F.lds + TAB_OFF + 10240)};
            EpiSwiglu E{(bf16*)(F.ws + WS_ACT), args.in[I_BGU] + (size_t)l * NE * 2048, (const float*)(F.ws + WS_H2), (const LAS int*)(F.lds + TAB_OFF), (const LAS int*)(F.lds + TAB_OFF) + 64};
            S.fill_rows((LAS unsigned*)(F.lds + TAB_OFF + 10240), F.tid); __syncthreads();
            run_gemm(F, g, S, E);
            } SEAM(pb + 7);
        }
        if (PHX(8) && IN(pb + 8)) { for (int rep = 0; rep < REPS(8); ++rep) { if (rep) GRID_BAR();
            const int n = moe_tables(F, l, 4, 8, true, REPS(8) == 2 || REPS(9) == 2);
            pg8::Gemm g{(const bf16*)(F.ws + WS_ACT), (const bf16*)(wb + W_DN), SLOTS, NE * D, D};
            LdsOrder<false> S{(const LAS unsigned*)(F.lds + TAB_OFF + 1024), n, F.G, (int)blockIdx.x, (const LAS int*)(F.lds + TAB_OFF), (const LAS int*)(F.lds + TAB_OFF) + 64, (const int*)(F.ws + WS_XS), (const LAS unsigned*)(F.lds + TAB_OFF + 10240)};
            EpiDown E{(bf16*)(F.ws + WS_YB), args.in[I_BDN] + (size_t)l * NE * D};
            run_gemm(F, g, S, E);
            } SEAM(pb + 8);
        }
        if (PHX(9) && IN(pb + 9)) { for (int rep = 0; rep < REPS(9); ++rep) { if (rep) GRID_BAR(); LAUNDER(); ph_combine(F, args, l); } SEAM(pb + 9); }
    }
#undef IN
#undef SEAM
}

extern "C" void kernel_launch(void* const* d_in, const int* in_sizes, int n_in, void* d_out, int out_size, void* d_ws, size_t ws_size, hipStream_t stream) {
    static int grid = 0;
    if (grid == 0) {
        if (n_in != 28 || in_sizes[0] != M * D || out_size != M * D || ws_size < WS_END) { fprintf(stderr, "kernel_launch: unexpected shapes (n_in %d, in0 %d, out %d, ws %zu < %zu); nothing launched\n", n_in, n_in > 0 ? in_sizes[0] : -1, out_size, ws_size, (size_t)WS_END); grid = -1; return; }
        int dev = 0, cus = 0, per_cu = 0;
        if (hipGetDevice(&dev) != hipSuccess || hipDeviceGetAttribute(&cus, hipDeviceAttributeMultiprocessorCount, dev) != hipSuccess) { grid = -1; return; }
        if (hipFuncSetAttribute((const void*)mk_fwd, hipFuncAttributeMaxDynamicSharedMemorySize, LDS_BYTES) != hipSuccess) { fprintf(stderr, "kernel_launch: hipFuncSetAttribute failed\n"); grid = -1; return; }
        if (hipOccupancyMaxActiveBlocksPerMultiprocessor(&per_cu, (const void*)mk_fwd, NWAVES * 64, LDS_BYTES) != hipSuccess || per_cu < 1) { fprintf(stderr, "kernel_launch: occupancy query reports %d workgroups per CU\n", per_cu); }
        (void)hipGetLastError();
        grid = cus;
        if (grid % 8 != 0 || grid < 8) { fprintf(stderr, "kernel_launch: %d CUs: unsupported\n", grid); grid = -1; return; }
    }
    if (grid < 0) return;
    if (hipMemsetAsync((char*)d_ws + WS_CTL, 0, CTL_ZERO_BYTES, stream) != hipSuccess) return;
    Args a{};
    for (int i = 0; i < 28; ++i) a.in[i] = (const float*)d_in[i];
    a.out = (float*)d_out; a.ws = (unsigned char*)d_ws;
#if N_LAUNCH_MODE == 1
    a.ph_lo = 0; a.ph_hi = N_PHASES;
    hipLaunchKernelGGL(mk_fwd, dim3(grid), dim3(NWAVES * 64), LDS_BYTES, stream, a);
#else
    for (int p = 0; p < N_PHASES; ++p) { a.ph_lo = p; a.ph_hi = p + 1; hipLaunchKernelGGL(mk_fwd, dim3(grid), dim3(NWAVES * 64), LDS_BYTES, stream, a); }
#endif
}
```

```cpp
#include <hip/hip_runtime.h>
#include <cstdio>
#include <cstdint>
#ifndef N_LAUNCH_MODE
#define N_LAUNCH_MODE 1
#endif
namespace pg8 {
#define PG8_LAS __attribute__((address_space(3)))
typedef unsigned short bf16_t;
typedef short bf16x8 __attribute__((ext_vector_type(8)));
typedef float f32x4 __attribute__((ext_vector_type(4)));
typedef unsigned u32x4 __attribute__((ext_vector_type(4)));
constexpr int BM = 256, BK = 64, HALF = 128, HTB = HALF * BK * 2  , STAGE_BYTES = 8 * HTB, NXCD = 8, WGM = 8;

__host__ __device__ __forceinline__ int lds_byte(int r, int c) { const int st = (r >> 4) * 2 + (c >> 5), rr = r & 15, cc = c & 31, ob = rr * 64 + cc * 2; return st * 1024 + (ob ^ (((ob >> 9) & 1) << 5)); }
__host__ __device__ __forceinline__ void stage_rc(int b, int& R, int& C) { const int st = b / 1024, sb = b % 1024, swz = sb ^ (((sb >> 9) & 1) << 5); R = (st >> 1) * 16 + swz / 64; C = (st & 1) * 32 + (swz % 64) / 2; }
__host__ __device__ __forceinline__ int perm32(int rho) { const int n = rho >> 4, i = rho & 15; return 8 * (i >> 2) + 4 * n + (i & 3); }

struct Unit { int pm, pn, li; };
struct Gemm { const bf16_t* A; const bf16_t* Bt; int M, N, K; };

struct StaticOrder {
    static constexpr bool GATHER = false;
    int nM, nN, nwg, G, c;
    __host__ __device__ void init(int M, int N, int G_, int c_) { nM = M / BM; nN = N / BM; nwg = nM * nN; G = G_; c = c_; }
    __host__ __device__ bool next(int i, Unit& u) const {
        const long L = (long)i * G + c; if (L >= nwg) return false;
        int wgid = (int)L; { const int q = nwg / NXCD, r = nwg % NXCD, xcd = wgid % NXCD, off = wgid / NXCD; wgid = (xcd < r ? xcd * (q + 1) : r * (q + 1) + (xcd - r) * q) + off; }
        const int nig = WGM * nN, gid = wgid / nig, fm = gid * WGM, gsz = (nM - fm) < WGM ? (nM - fm) : WGM;
        u.pm = fm + ((wgid % nig) % gsz); u.pn = (wgid % nig) / gsz; u.li = i; return true;
    }
    __device__ __forceinline__ void a_ready(const Unit&) const {}
    __device__ __forceinline__ void done(const Unit&) const {}
};

typedef __bf16 bf16x2_t __attribute__((ext_vector_type(2)));
typedef float f32x2c_t __attribute__((ext_vector_type(2)));
__device__ __forceinline__ unsigned cvt_pk_bf16(float lo, float hi) { const bf16x2_t r = __builtin_convertvector((f32x2c_t){lo, hi}, bf16x2_t); unsigned u = __builtin_bit_cast(unsigned, r); asm volatile("s_nop 1" : "+v"(u)); return u; }
__device__ __forceinline__ unsigned cvt_pk_bf16_raw(float lo, float hi) { const bf16x2_t r = __builtin_convertvector((f32x2c_t){lo, hi}, bf16x2_t); return __builtin_bit_cast(unsigned, r); }
template <class Epi, class Sched, bool ALIGN_EPI = true>
__device__ __forceinline__ void gemm_phase(PG8_LAS unsigned char* lds, const Gemm g, const Sched& S, const Epi& E) {
    int tid_ = threadIdx.x; asm volatile("" : "+v"(tid_));
    const int tid = tid_, wid = __builtin_amdgcn_readfirstlane(tid >> 6), lane = tid & 63, wr = wid >> 2, wc = wid & 3, fr = lane & 15, fq = lane >> 4;
    const int K = g.K, nt = K / BK;
    int RA[2]; unsigned cofA[2], voffB[2];
#pragma unroll
    for (int i = 0; i < 2; ++i) { int R, C; stage_rc(tid * 16 + i * 8192, R, C); const int Rb = Epi::PERM ? ((R & ~31) + perm32(R & 31)) : R;
        RA[i] = R; cofA[i] = (unsigned)C * 2u; voffB[i] = (unsigned)(Rb * K + C) * 2u; }
    const size_t kstep = (size_t)(BK * 2);
    const size_t hstep = (size_t)HALF * K * 2;
    const size_t tstep = 2 * hstep;
    const unsigned ldsw = (unsigned)wid * 1024u;
    const int aoff = lds_byte(wr * 64 + fr, fq * 8), boff = lds_byte(wc * 32 + fr, fq * 8);
    const char* gA = (const char*)g.A;
#define PG8_AOFF(dst, u) do { _Pragma("unroll") for (int _h = 0; _h < 2; ++_h) _Pragma("unroll") for (int _i = 0; _i < 2; ++_i) { \
        if constexpr (Sched::GATHER) dst[_h][_i] = S.arow((u), _h * HALF + RA[_i]) + cofA[_i]; \
        else dst[_h][_i] = (unsigned)(((u).pm * BM + _h * HALF + RA[_i]) * K) * 2u + cofA[_i]; } } while (0)
#define PG8_SA(b, h) (((b) * 2 + (h)) * HTB)
#define PG8_SB(b, h) ((4 + (b) * 2 + (h)) * HTB)
#define PG8_STAGE(bufoff, gbase, voff) do { _Pragma("unroll") for (int _i = 0; _i < 2; ++_i) \
        __builtin_amdgcn_global_load_lds((const unsigned*)((const char*)(gbase) + (voff)[_i]), (PG8_LAS unsigned*)(lds + (bufoff) + ldsw + _i * 8192), 16, 0, 0); } while (0)
#define PG8_LDA(dst, b, h) do { _Pragma("unroll") for (int m = 0; m < 4; ++m) _Pragma("unroll") for (int k = 0; k < 2; ++k) dst[m][k] = *(const PG8_LAS bf16x8*)(lds + PG8_SA(b, h) + aoff + m * 2048 + k * 1024); } while (0)
#define PG8_LDB(dst, b, h) do { _Pragma("unroll") for (int n = 0; n < 2; ++n) _Pragma("unroll") for (int k = 0; k < 2; ++k) dst[n][k] = *(const PG8_LAS bf16x8*)(lds + PG8_SB(b, h) + boff + n * 2048 + k * 1024); } while (0)
#define PG8_MMA(ai, bj, At, Bt) do { __builtin_amdgcn_s_setprio(1); _Pragma("unroll") for (int m = 0; m < 4; ++m) _Pragma("unroll") for (int n = 0; n < 2; ++n) _Pragma("unroll") for (int k = 0; k < 2; ++k) \
        acc[ai][bj][m][n] = __builtin_amdgcn_mfma_f32_16x16x32_bf16(Bt[n][k], At[m][k], acc[ai][bj][m][n], 0, 0, 0); __builtin_amdgcn_s_setprio(0); } while (0)
#define PG8_WAIT_V(n) asm volatile("s_waitcnt vmcnt(" #n ")" ::: "memory")
#define PG8_WAIT_L(n) asm volatile("s_waitcnt lgkmcnt(" #n ")" ::: "memory")
#define PG8_BAR __builtin_amdgcn_s_barrier()
#define PG8_SCHED __builtin_amdgcn_sched_barrier(0)
    Unit cur, nxt; int ui = 0;
    if (!S.next(0, cur)) return;
    f32x4 acc[2][2][4][2];
#pragma unroll
    for (int a = 0; a < 2; ++a)
#pragma unroll
        for (int b = 0; b < 2; ++b)
#pragma unroll
            for (int m = 0; m < 4; ++m)
#pragma unroll
                for (int n = 0; n < 2; ++n) acc[a][b][m][n] = (f32x4){0.f, 0.f, 0.f, 0.f};
    bf16x8 At[4][2], B0[2][2], B1[2][2];
    unsigned oC[2][2], oN[2][2];
    PG8_AOFF(oC, cur);
    const char* cB = (const char*)g.Bt + (size_t)cur.pn * tstep;
    S.a_ready(cur);
    PG8_STAGE(PG8_SB(0, 0), cB, voffB); PG8_STAGE(PG8_SB(0, 1), cB + hstep, voffB); PG8_STAGE(PG8_SA(0, 0), gA, oC[0]); PG8_STAGE(PG8_SA(0, 1), gA, oC[1]);
    if (wr == 1) PG8_BAR;
    PG8_WAIT_V(2); PG8_BAR;
    PG8_STAGE(PG8_SB(1, 0), cB + kstep, voffB); PG8_STAGE(PG8_SA(1, 0), gA + kstep, oC[0]); PG8_STAGE(PG8_SB(1, 1), cB + hstep + kstep, voffB);
    PG8_WAIT_V(6); PG8_BAR;
    for (;;) {
        const bool has_next = S.next(ui + 1, nxt);
        if (has_next) PG8_AOFF(oN, nxt);
        else {
#pragma unroll
            for (int _h = 0; _h < 2; ++_h)
#pragma unroll
                for (int _i = 0; _i < 2; ++_i) oN[_h][_i] = oC[_h][_i]; }
        const char* nB = has_next ? (const char*)g.Bt + (size_t)nxt.pn * tstep : cB;
        for (int t = 0; t < nt; t += 2) {
            const bool last = (t == nt - 2);
            if constexpr (Epi::MIDK) { if (t == (nt >> 1)) E.midk(acc, cur, wr, wc, fr, fq); }
            const char* a1 = gA + (size_t)(t + 1) * kstep;
            const char* a2 = last ? gA : gA + (size_t)(t + 2) * kstep; const char* b2 = last ? nB : cB + (size_t)(t + 2) * kstep;
            const char* a3 = a2 + kstep; const char* b3 = b2 + kstep;
            unsigned o2[2][2];
#pragma unroll
            for (int _h = 0; _h < 2; ++_h)
#pragma unroll
                for (int _i = 0; _i < 2; ++_i) o2[_h][_i] = last ? oN[_h][_i] : oC[_h][_i];
            if (last && has_next) S.a_ready(nxt);
            PG8_LDB(B0, 0, 0); PG8_LDB(B1, 0, 1); PG8_SCHED; PG8_LDA(At, 0, 0); PG8_STAGE(PG8_SA(1, 1), a1, oC[1]);
            PG8_WAIT_V(8); PG8_WAIT_L(0); PG8_BAR; PG8_MMA(0, 0, At, B0); PG8_MMA(0, 1, At, B1); PG8_BAR; PG8_SCHED;
            PG8_LDA(At, 0, 1); PG8_STAGE(PG8_SB(0, 0), b2, voffB); PG8_STAGE(PG8_SB(0, 1), b2 + hstep, voffB); PG8_STAGE(PG8_SA(0, 0), a2, o2[0]);
            PG8_WAIT_V(8); PG8_WAIT_L(0); PG8_BAR; PG8_MMA(1, 0, At, B0); PG8_MMA(1, 1, At, B1); PG8_BAR; PG8_SCHED;
            PG8_LDB(B0, 1, 0); PG8_LDB(B1, 1, 1); PG8_SCHED; PG8_LDA(At, 1, 0); PG8_STAGE(PG8_SA(0, 1), a2, o2[1]);
            PG8_WAIT_V(8); PG8_WAIT_L(0); PG8_BAR; PG8_MMA(0, 0, At, B0); PG8_MMA(0, 1, At, B1); PG8_BAR; PG8_SCHED;
            PG8_LDA(At, 1, 1); PG8_STAGE(PG8_SB(1, 0), b3, voffB); PG8_STAGE(PG8_SB(1, 1), b3 + hstep, voffB); PG8_STAGE(PG8_SA(1, 0), a3, o2[0]);
            PG8_WAIT_V(8); PG8_WAIT_L(0); PG8_BAR; PG8_MMA(1, 0, At, B0); PG8_MMA(1, 1, At, B1); PG8_BAR; PG8_SCHED;
        }
        if constexpr (ALIGN_EPI) { if (wr == 0) PG8_BAR; }
        E(acc, cur, wr, wc, fr, fq); S.done(cur);
        if (!has_next) break;
#pragma unroll
        for (int a = 0; a < 2; ++a)
#pragma unroll
            for (int b = 0; b < 2; ++b)
#pragma unroll
                for (int m = 0; m < 4; ++m)
#pragma unroll
                    for (int n = 0; n < 2; ++n) acc[a][b][m][n] = (f32x4){0.f, 0.f, 0.f, 0.f};
        cur = nxt; cB = nB; ++ui;
#pragma unroll
        for (int _h = 0; _h < 2; ++_h)
#pragma unroll
            for (int _i = 0; _i < 2; ++_i) oC[_h][_i] = oN[_h][_i];
        if constexpr (ALIGN_EPI) { if (wr == 1) PG8_BAR; }
    }
    PG8_WAIT_V(0);
    if constexpr (!ALIGN_EPI) { if (wr == 0) PG8_BAR; }
    PG8_BAR;
#undef PG8_AOFF
#undef PG8_SA
#undef PG8_SB
#undef PG8_STAGE
#undef PG8_LDA
#undef PG8_LDB
#undef PG8_MMA
#undef PG8_WAIT_V
#undef PG8_WAIT_L
#undef PG8_BAR
#undef PG8_SCHED
}
}
#define GAS __attribute__((address_space(1)))
#define LAS __attribute__((address_space(3)))
typedef unsigned short bf16;
typedef unsigned v4u __attribute__((ext_vector_type(4)));
typedef float f32x4 __attribute__((ext_vector_type(4)));
typedef short bf16x8 __attribute__((ext_vector_type(8)));
typedef GAS unsigned gu32;
typedef GAS unsigned long long gu64;
#define RLX_AGENT __ATOMIC_RELAXED, __HIP_MEMORY_SCOPE_AGENT
#define LDS_WAIT() asm volatile("s_waitcnt lgkmcnt(0)" ::: "memory")
#define VM_WAIT() asm volatile("s_waitcnt vmcnt(0)" ::: "memory")
__device__ __forceinline__ unsigned long long rt() { return __builtin_amdgcn_s_memrealtime(); }
__device__ __forceinline__ unsigned f2bf(float f) { unsigned u = __builtin_bit_cast(unsigned, f); return (u + 0x7fffu + ((u >> 16) & 1u)) >> 16; }
__device__ __forceinline__ unsigned pk2(float lo, float hi) { return f2bf(lo) | (f2bf(hi) << 16); }

#define XB_TMO      128
#define XB_XCNT(j)  (256  + 64 * (j))
#define XB_XSUB(j)  (1280 + 64 * (j))
#define XB_XGEN(j)  (2304 + 64 * (j))
#define XB_TOP      3328
#define XB_TOPGEN   3392
#define XCD_BAR_WORDS 3456
#define XB_SPIN_CAP (1u << 18)

__device__ __forceinline__ unsigned xb_ld(unsigned* p)              { return __hip_atomic_load(p, __ATOMIC_RELAXED, __HIP_MEMORY_SCOPE_AGENT); }
__device__ __forceinline__ unsigned xb_add(unsigned* p, unsigned v) { return __hip_atomic_fetch_add(p, v, __ATOMIC_RELAXED, __HIP_MEMORY_SCOPE_AGENT); }
__device__ __forceinline__ unsigned xb_xcc_id() { return (unsigned)__builtin_amdgcn_s_getreg((3 << 11) | 20) & 0xFu; }
#define XB_SPIN(cond, bar) do { unsigned _sp = 0; while (cond) { __builtin_amdgcn_s_sleep(1); \
    if ((++_sp & 255u) == 0u) { if (xb_ld(&(bar)[XB_TMO])) break; if (_sp > XB_SPIN_CAP) { atomicAdd(&(bar)[XB_TMO], 1u); break; } } } } while (0)

struct XcdBarrier {
    unsigned* bar; unsigned x;
    volatile LAS unsigned* st;
};

__device__ __forceinline__ XcdBarrier xcd_barrier_post(unsigned* bar, volatile LAS unsigned* st) {
    XcdBarrier b; b.bar = bar; b.x = xb_xcc_id(); b.st = st;
    if (threadIdx.x == 0) (void)xb_add(&bar[XB_XCNT(b.x)], 1u);
    return b;
}
__device__ __forceinline__ void xcd_barrier_complete(unsigned* bar, unsigned x, unsigned& nloc, unsigned& nx) {
    const unsigned G = gridDim.x * gridDim.y * gridDim.z;
    unsigned sum, cnt, mine, sp = 0u;
    for (;;) {
        sum = 0u; cnt = 0u; mine = 0u;
#pragma unroll
        for (unsigned j = 0; j < 16; ++j) { const unsigned c = xb_ld(&bar[XB_XCNT(j)]); sum += c; cnt += (c > 0u) ? 1u : 0u; mine = (j == x) ? c : mine; }
        if (sum == G) break;
        __builtin_amdgcn_s_sleep(1);
        if ((++sp & 255u) == 0u) { if (xb_ld(&bar[XB_TMO])) break; if (sp > XB_SPIN_CAP) { atomicAdd(&bar[XB_TMO], 1u); break; } }
    }
    nloc = mine > 0u ? mine : 1u; nx = cnt > 0u ? cnt : 1u;
}

__device__ __forceinline__ void xcd_barrier(const XcdBarrier& b) {
    asm volatile("s_waitcnt vmcnt(0)" ::: "memory");
    __syncthreads();
    if (threadIdx.x == 0) {
        unsigned* bar = b.bar;
        __builtin_amdgcn_s_waitcnt(0);
        unsigned nloc = b.st[0], nx = b.st[1];
        if (nloc == 0u) { xcd_barrier_complete(bar, b.x, nloc, nx); b.st[0] = nloc; b.st[1] = nx; }
        const unsigned old = xb_add(&bar[XB_XSUB(b.x)], 1u);
        const unsigned gen = old / nloc;
        if (old + 1u == (gen + 1u) * nloc) {
            __builtin_amdgcn_fence(__ATOMIC_RELEASE, "agent");
            asm volatile("s_waitcnt vmcnt(0)" ::: "memory");
            const unsigned og = xb_add(&bar[XB_TOP], 1u);
            const unsigned tg = og / nx;
            if (og + 1u == (tg + 1u) * nx) xb_add(&bar[XB_TOPGEN], 1u);
            else XB_SPIN(xb_ld(&bar[XB_TOPGEN]) == tg, bar);
            __builtin_amdgcn_fence(__ATOMIC_ACQUIRE, "agent");
            xb_add(&bar[XB_XGEN(b.x)], 1u);
            asm volatile("s_waitcnt vmcnt(0)" ::: "memory");
        } else {
            XB_SPIN(xb_ld(&bar[XB_XGEN(b.x)]) == gen, bar);
            __builtin_amdgcn_fence(__ATOMIC_ACQUIRE, "agent");
            asm volatile("s_waitcnt vmcnt(0)" ::: "memory");
        }
    }
    __syncthreads();
}
constexpr int M = 16384, D = 1024, DH = 512, NPROJ = 1536, NE = 32, TOPK = 4, NAS = M * TOPK, SLOTS = NAS + NE * 256, SEQ = 4096, NBATCH = 4, NCH = 32, NG = 32, NP = 64, DEPTH = 2;
constexpr float EPS = 1e-5f;
constexpr int NWAVES = 8;
constexpr size_t MiB = 1u << 20;
constexpr size_t WS_CTL = 0, CTL_ZERO_BYTES = 512 * 1024;
constexpr int CW_BAR = 1024;
constexpr int CW_Q = 6144;
constexpr int CW_CNT = 8192;
constexpr int CW_SS = 16384;
static_assert((CW_SS + DEPTH * 2 * M) * 4 <= (int)CTL_ZERO_BYTES, "CTL words inside the memset region");
constexpr size_t WS_RE = 1 * MiB;
constexpr size_t WS_RK = WS_RE + (size_t)NAS * 4;
constexpr size_t WS_GW = WS_RK + (size_t)NAS * 4;
constexpr size_t WS_SO = WS_GW + (size_t)NAS * 4;
constexpr size_t WS_TGU = WS_SO + (size_t)NAS * 4;
constexpr size_t WS_TDN = WS_TGU + 288 * 8 * 8;
constexpr size_t WS_META = WS_TDN + 288 * 4 * 8;
constexpr size_t WS_SSMP = 3 * MiB;
constexpr size_t SSMP_ABAR = 0, SSMP_A128 = 16384, SSMP_BBAR = 32768, SSMP_CTAB = SSMP_BBAR + 262144, SSMP_STRIDE = SSMP_CTAB + 262144;
constexpr size_t WS_BB16 = 5 * MiB;
constexpr size_t WS_CT16 = WS_BB16 + 512 * 1024;
constexpr size_t WS_RWT = 6 * MiB + 512 * 1024;
constexpr size_t WS_RSI = 7 * MiB;
constexpr size_t WS_WM = 6 * MiB;
static_assert(WS_META + 256 <= WS_SSMP && WS_SSMP + DEPTH * SSMP_STRIDE <= WS_BB16 && WS_WM + DEPTH * 4 * 128 * 128 * 2 <= 8 * MiB, "small tables");
constexpr size_t WS_W = 8 * MiB, W_IN = 0, W_OUT = 3 * MiB, W_GLU = 5 * MiB, W_GU = 6 * MiB, W_DN = 134 * MiB, W_STRIDE = 198 * MiB;
constexpr size_t WS_XB = WS_W + DEPTH * W_STRIDE;
constexpr size_t WS_P = WS_XB + 32 * MiB;
constexpr size_t WS_YG = WS_P + 48 * MiB;
constexpr size_t WS_MIX = WS_YG + 16 * MiB;
constexpr size_t WS_XA = WS_MIX + 32 * MiB;
constexpr size_t WS_XC = WS_XA + 64 * MiB;
constexpr size_t WS_H2 = WS_XC + 64 * MiB;
constexpr size_t WS_XS = WS_H2 + 32 * MiB;
constexpr size_t WS_ACT = WS_XS + 144 * MiB;
constexpr size_t WS_YB = WS_ACT + 144 * MiB;
constexpr size_t WS_EST = WS_YB + 144 * MiB;
constexpr size_t WS_SSP = WS_EST + 2 * MiB;
constexpr size_t WS_END = WS_SSP + 1 * MiB;
static_assert((size_t)SLOTS * D * 2 == 144 * MiB, "slot buffers");
constexpr int RING_OFF = 0, RING_BYTES = 131072;
constexpr int TAB_OFF = 131072;
constexpr int LDSCTL_OFF = 151552, MISC_OFF = LDSCTL_OFF + 6144;
constexpr int LDS_BYTES = 159744;
static_assert(MISC_OFF + 128 <= LDS_BYTES, "LDS map");
constexpr int PH_PER_LAYER = 10, N_PHASES = 1 + DEPTH * PH_PER_LAYER;
__device__ __forceinline__ float wave_sum(float v) {
#pragma unroll
    for (int o = 1; o < 64; o <<= 1) v += __shfl_xor(v, o);
    return v;
}
__device__ __forceinline__ float fast_sigmoid(float x) { return __builtin_amdgcn_rcpf(1.0f + __builtin_amdgcn_exp2f(-1.4426950409f * x)); }
__device__ __forceinline__ float gelu_tanh(float x) { const float u = x * (1.5957691216f + 0.0713548163f * x * x); return x * fast_sigmoid(u); }
__device__ __forceinline__ float bf2f(unsigned short b) { return __builtin_bit_cast(float, (unsigned)b << 16); }
__device__ __forceinline__ float bflo(unsigned w) { return __builtin_bit_cast(float, w << 16); }
__device__ __forceinline__ float bfhi(unsigned w) { return __builtin_bit_cast(float, w & 0xffff0000u); }
typedef unsigned v2u __attribute__((ext_vector_type(2)));
typedef float f32x2_t __attribute__((ext_vector_type(2)));

struct EpiInProj {
    static constexpr bool PERM = true, MIDK = false;
    bf16* P; const float* rs;
    __device__ __forceinline__ void operator()(const pg8::f32x4 (&acc)[2][2][4][2], const pg8::Unit& u, int wr, int wc, int fr, int fq) const {
        const int t = u.pn >> 1; const bool act = t < 2;
        bf16* base = P + (size_t)t * M * DH;
        const int row0 = u.pm * 256 + wr * 64 + fr, col0 = (u.pn & 1) * 256 + wc * 32 + 8 * fq;
#pragma unroll
        for (int ai = 0; ai < 2; ++ai)
#pragma unroll
            for (int m = 0; m < 4; ++m) { bf16* rowp = base + (size_t)(row0 + ai * 128 + m * 16) * DH + col0; const float rsv = rs[row0 + ai * 128 + m * 16];
#pragma unroll
                for (int bj = 0; bj < 2; ++bj) { pg8::f32x4 v0 = acc[ai][bj][m][0] * rsv, v1 = acc[ai][bj][m][1] * rsv;
                    if (act) {
#pragma unroll
                        for (int j = 0; j < 4; ++j) { v0[j] = gelu_tanh(v0[j]); v1[j] = gelu_tanh(v1[j]); } }
                    v4u w; w.x = pg8::cvt_pk_bf16(v0[0], v0[1]); w.y = pg8::cvt_pk_bf16(v0[2], v0[3]); w.z = pg8::cvt_pk_bf16(v1[0], v1[1]); w.w = pg8::cvt_pk_bf16(v1[2], v1[3]);
                    *(v4u*)(rowp + bj * 128) = w; } }
    }
};
struct EpiGlu {
    static constexpr bool PERM = true, MIDK = false;
    const bf16* YG; bf16* MIX; const float* bias; float* ss;
    __device__ __forceinline__ void operator()(const pg8::f32x4 (&acc)[2][2][4][2], const pg8::Unit& u, int wr, int wc, int fr, int fq) const {
        const int row0 = u.pm * 256 + wr * 64 + fr, col0 = u.pn * 256 + wc * 32 + 8 * fq;
        pg8::f32x4 bv[2][2];
#pragma unroll
        for (int bj = 0; bj < 2; ++bj)
#pragma unroll
            for (int n = 0; n < 2; ++n) bv[bj][n] = *(const pg8::f32x4*)(bias + col0 + bj * 128 + 4 * n);
#pragma unroll
        for (int ai = 0; ai < 2; ++ai)
#pragma unroll
            for (int m = 0; m < 4; ++m) { const int row = row0 + ai * 128 + m * 16; float sq = 0.f;
#pragma unroll
                for (int bj = 0; bj < 2; ++bj) { const int col = col0 + bj * 128;
                    const v4u yw = *(const v4u*)(YG + (size_t)row * DH + col);
                    const pg8::f32x4 g0 = acc[ai][bj][m][0] + bv[bj][0], g1 = acc[ai][bj][m][1] + bv[bj][1];
                    float o[8];
                    o[0] = bflo(yw.x) * fast_sigmoid(g0[0]); o[1] = bfhi(yw.x) * fast_sigmoid(g0[1]); o[2] = bflo(yw.y) * fast_sigmoid(g0[2]); o[3] = bfhi(yw.y) * fast_sigmoid(g0[3]);
                    o[4] = bflo(yw.z) * fast_sigmoid(g1[0]); o[5] = bfhi(yw.z) * fast_sigmoid(g1[1]); o[6] = bflo(yw.w) * fast_sigmoid(g1[2]); o[7] = bfhi(yw.w) * fast_sigmoid(g1[3]);
#pragma unroll
                    for (int j = 0; j < 8; ++j) sq += o[j] * o[j];
                    v4u w; w.x = pg8::cvt_pk_bf16(o[0], o[1]); w.y = pg8::cvt_pk_bf16(o[2], o[3]); w.z = pg8::cvt_pk_bf16(o[4], o[5]); w.w = pg8::cvt_pk_bf16(o[6], o[7]);
                    *(v4u*)(MIX + (size_t)row * D + DH + col) = w; }
                sq += __shfl_xor(sq, 16); sq += __shfl_xor(sq, 32);
                if (fq == 0) ss[(size_t)row * 8 + u.pn * 4 + wc] = sq; }
    }
};
struct EpiResid {
    static constexpr bool PERM = true, MIDK = false;
    const bf16* resid; bf16* out;
    __device__ __forceinline__ void operator()(const pg8::f32x4 (&acc)[2][2][4][2], const pg8::Unit& u, int wr, int wc, int fr, int fq) const {
        const int row0 = u.pm * 256 + wr * 64 + fr, col0 = u.pn * 256 + wc * 32 + 8 * fq;
#pragma unroll
        for (int ai = 0; ai < 2; ++ai)
#pragma unroll
            for (int m = 0; m < 4; ++m) { const size_t off = (size_t)(row0 + ai * 128 + m * 16) * D + col0;
#pragma unroll
                for (int bj = 0; bj < 2; ++bj) { const v4u r = *(const v4u*)(resid + off + bj * 128); const pg8::f32x4 a0 = acc[ai][bj][m][0], a1 = acc[ai][bj][m][1];
                    v4u w; w.x = pg8::cvt_pk_bf16(bflo(r.x) + a0[0], bfhi(r.x) + a0[1]); w.y = pg8::cvt_pk_bf16(bflo(r.y) + a0[2], bfhi(r.y) + a0[3]);
                    w.z = pg8::cvt_pk_bf16(bflo(r.z) + a1[0], bfhi(r.z) + a1[1]); w.w = pg8::cvt_pk_bf16(bflo(r.w) + a1[2], bfhi(r.w) + a1[3]);
                    *(v4u*)(out + off + bj * 128) = w; } }
    }
};
struct EpiSwiglu {
    static constexpr bool PERM = true, MIDK = false;
    bf16* ACT; const float* bgu;
    const float* rse; const LAS int* offL; const LAS int* cntL;
    __device__ __forceinline__ void operator()(const pg8::f32x4 (&acc)[2][2][4][2], const pg8::Unit& u, int wr, int wc, int fr, int fq) const {
        const int e = u.pn >> 3, pn = u.pn & 7;
        const int row0 = u.pm * 256 + wr * 64 + fr, col0 = pn * 128 + wc * 32 + 8 * fq;
        const float* bg = bgu + (size_t)e * 2048 + col0;
        pg8::f32x4 bgl[2], bli[2];
#pragma unroll
        for (int n = 0; n < 2; ++n) { bgl[n] = *(const pg8::f32x4*)(bg + 4 * n); bli[n] = *(const pg8::f32x4*)(bg + 1024 + 4 * n); }
        float rsa[2][4];
        { const int o0 = offL[e], cn = cntL[e];
#pragma unroll
          for (int ai = 0; ai < 2; ++ai)
#pragma unroll
            for (int m = 0; m < 4; ++m) { const int rank = row0 + ai * 128 + m * 16 - o0; rsa[ai][m] = rse[(size_t)e * NAS + (rank < cn ? rank : cn - 1)]; } }
#pragma unroll
        for (int ai = 0; ai < 2; ++ai)
#pragma unroll
            for (int m = 0; m < 4; ++m) { float o[8]; const float rsv = rsa[ai][m];
#pragma unroll
                for (int n = 0; n < 2; ++n)
#pragma unroll
                    for (int j = 0; j < 4; ++j) { float gl = acc[ai][0][m][n][j] * rsv + bgl[n][j], li = acc[ai][1][m][n][j] * rsv + bli[n][j];
                        gl = fminf(gl, 7.0f); li = fminf(fmaxf(li, -7.0f), 7.0f);
                        o[4 * n + j] = gl * fast_sigmoid(1.702f * gl) * (li + 1.0f); }
                v4u w; w.x = pg8::cvt_pk_bf16(o[0], o[1]); w.y = pg8::cvt_pk_bf16(o[2], o[3]); w.z = pg8::cvt_pk_bf16(o[4], o[5]); w.w = pg8::cvt_pk_bf16(o[6], o[7]);
                *(v4u*)(ACT + (size_t)(row0 + ai * 128 + m * 16) * D + col0) = w; }
    }
};
struct EpiDown {
    static constexpr bool PERM = true, MIDK = false;
    bf16* YB; const float* bdn;
    __device__ __forceinline__ void operator()(const pg8::f32x4 (&acc)[2][2][4][2], const pg8::Unit& u, int wr, int wc, int fr, int fq) const {
        const int e = u.pn >> 2, pn = u.pn & 3;
        const int row0 = u.pm * 256 + wr * 64 + fr, col0 = pn * 256 + wc * 32 + 8 * fq;
        const float* bb = bdn + (size_t)e * D + col0;
        pg8::f32x4 bv[2][2];
#pragma unroll
        for (int bj = 0; bj < 2; ++bj)
#pragma unroll
            for (int n = 0; n < 2; ++n) bv[bj][n] = *(const pg8::f32x4*)(bb + bj * 128 + 4 * n);
#pragma unroll
        for (int ai = 0; ai < 2; ++ai)
#pragma unroll
            for (int m = 0; m < 4; ++m) { bf16* rowp = YB + (size_t)(row0 + ai * 128 + m * 16) * D + col0;
#pragma unroll
                for (int bj = 0; bj < 2; ++bj) { const pg8::f32x4 v0 = acc[ai][bj][m][0] + bv[bj][0], v1 = acc[ai][bj][m][1] + bv[bj][1];
                    v4u w; w.x = pg8::cvt_pk_bf16(v0[0], v0[1]); w.y = pg8::cvt_pk_bf16(v0[2], v0[3]); w.z = pg8::cvt_pk_bf16(v1[0], v1[1]); w.w = pg8::cvt_pk_bf16(v1[2], v1[3]);
                    *(v4u*)(rowp + bj * 128) = w; } }
    }
};
template <bool GATHER_>
struct LdsOrder {
    static constexpr bool GATHER = GATHER_;
    const LAS unsigned* tab; int n, G, c;
    const LAS int* offL; const LAS int* cntL; const int* tok; const LAS unsigned* rows;
    __device__ __forceinline__ bool next(int i, pg8::Unit& u) const {
        const int per = G >> 3, L = (i * 8 + (c & 7)) * per + (c >> 3);
        if (L >= n) return false;
        const unsigned e = (unsigned)__builtin_amdgcn_readfirstlane((int)tab[L]);
        u.pm = (int)(e & 0xfffu); u.pn = (int)(e >> 12); u.li = i;
        return true;
    }
    __device__ __forceinline__ unsigned arow(const pg8::Unit& u, int r) const { return rows[u.li * 256 + r]; }
    __device__ __forceinline__ void fill_rows(LAS unsigned* rw, int tid) const {
        pg8::Unit u;
        for (int i = 0; i < 10 && next(i, u); ++i)
            for (int r = tid; r < 256; r += NWAVES * 64) { const int e = u.pn >> 3, rank = u.pm * 256 + r - offL[e], cn = cntL[e], idx = rank < cn ? rank : cn - 1;
                rw[i * 256 + r] = (unsigned)tok[e * NAS + idx] * (unsigned)(D * 2); }
    }
    __device__ __forceinline__ void a_ready(const pg8::Unit&) const {}
    __device__ __forceinline__ void done(const pg8::Unit&) const {}
};
struct Frame {
    LAS unsigned char* lds;
    volatile LAS unsigned* MISC;
    gu32* ctl;
    unsigned char* ws;
    int tid, lane, wave, vcu, G;
};
struct Args { const float* in[28]; float* out; unsigned char* ws; int ph_lo, ph_hi; };
enum { I_X = 0, I_ANW, I_WIN, I_LNW, I_LNB, I_SGUW, I_SGUB, I_ARE, I_AIM, I_BRE, I_BIM, I_CRE, I_CIM, I_SD, I_LOGDT, I_GLUW, I_GLUB, I_ONA, I_ONB, I_WOUT, I_FNW, I_RW, I_RB, I_WGU, I_BGU, I_WDN, I_BDN, I_FINW };

__device__ __forceinline__ void tr_item(const float* W, int K, int N, bf16* WT, int k0, int n0, int drow0, const float* sc, LAS float* scr, int lane) {
    const int c4 = lane & 15, kr = lane >> 4;
    f32x4 v[16];
#pragma unroll
    for (int i = 0; i < 16; ++i) v[i] = __builtin_nontemporal_load((const GAS f32x4*)(W + (size_t)(k0 + 4 * i + kr) * N + n0 + 4 * c4));
#pragma unroll
    for (int i = 0; i < 16; ++i) { const int k = 4 * i + kr; const float s = sc ? sc[k0 + k] : 1.0f; LAS float* d = scr + k * 65 + 4 * c4;
        d[0] = v[i].x * s; d[1] = v[i].y * s; d[2] = v[i].z * s; d[3] = v[i].w * s; }
    LDS_WAIT(); asm volatile("" ::: "memory");
    const int nl = lane & 7, kc = lane >> 3;
#pragma unroll
    for (int j = 0; j < 8; ++j) { const int n = nl + 8 * j; const LAS float* s = scr + (8 * kc) * 65 + n;
        v4u o; o.x = pk2(s[0 * 65], s[1 * 65]); o.y = pk2(s[2 * 65], s[3 * 65]); o.z = pk2(s[4 * 65], s[5 * 65]); o.w = pk2(s[6 * 65], s[7 * 65]);
        __builtin_nontemporal_store(o, (GAS v4u*)(WT + (size_t)(drow0 + n) * K + k0 + 8 * kc)); }
    LDS_WAIT(); asm volatile("" ::: "memory");
}
__device__ __forceinline__ void rms_row_to_bf16(const float* xrow, bf16* orow, float* rsp, int lane) {
    const GAS f32x4* xr = (const GAS f32x4*)xrow + lane;
    f32x4 v[4]; float s = 0.f;
#pragma unroll
    for (int j = 0; j < 4; ++j) { v[j] = xr[64 * j]; s += (v[j].x * v[j].x + v[j].y * v[j].y) + (v[j].z * v[j].z + v[j].w * v[j].w); }
    const float rs = 1.0f / sqrtf(wave_sum(s) * (1.f / D) + EPS);
    GAS unsigned long long* o8 = (GAS unsigned long long*)orow + lane;
#pragma unroll
    for (int j = 0; j < 4; ++j) o8[64 * j] = (unsigned long long)pk2(v[j].x, v[j].y) | ((unsigned long long)pk2(v[j].z, v[j].w) << 32);
    if (lane == 0) *rsp = rs;
}
constexpr int I_IN = 16 * 24, I_OUT = 16 * 16, I_GLU = 8 * 8, I_GU = NE * 16 * 32, I_DN = NE * 16 * 16;
constexpr int Q_L0GU = I_GU, Q_L0DN = Q_L0GU + I_DN, Q_L1GU = Q_L0DN + I_GU, QN = Q_L1GU + I_DN;
__device__ __forceinline__ void conv_gu_item(Frame& F, const Args& A, int l, int r, LAS float* scr) {
    unsigned char* wb = F.ws + WS_W + (size_t)l * W_STRIDE;
    const int e = r / 512, rr = r % 512, kb = rr / 32, nb = rr % 32, n0 = 64 * nb, j = n0 & 1023, half = n0 >> 10, drow0 = (j >> 7) * 256 + half * 128 + (j & 127);
    tr_item(A.in[I_WGU] + ((size_t)l * NE + e) * D * 2048, D, 2048, (bf16*)(wb + W_GU) + (size_t)e * 2048 * D, 64 * kb, n0, drow0, A.in[I_FNW] + l * D, scr, F.lane);
}
__device__ __forceinline__ void conv_dn_item(Frame& F, const Args& A, int l, int r, LAS float* scr) {
    unsigned char* wb = F.ws + WS_W + (size_t)l * W_STRIDE;
    const int e = r / 256, rr = r % 256, kb = rr / 16, nb = rr % 16;
    tr_item(A.in[I_WDN] + ((size_t)l * NE + e) * D * D, D, D, (bf16*)(wb + W_DN) + (size_t)e * D * D, 64 * kb, 64 * nb, 64 * nb, nullptr, scr, F.lane);
}
__device__ __forceinline__ void conv_pull(Frame& F, const Args& A, int nb, int until) {
    LAS float* scr = (LAS float*)(F.lds + RING_OFF + F.wave * 16640);
    LAS int* qb = (LAS int*)(F.lds + LDSCTL_OFF + 768);
    (void)nb; (void)until;
    if (F.tid == 0) qb[0] = (int)__hip_atomic_fetch_add(F.ctl + CW_Q, 8u, RLX_AGENT);
    __syncthreads();
    int base = qb[0];
    __syncthreads();
    while (base < QN) {
        unsigned nx = 0u;
        if (F.tid == 0) nx = __hip_atomic_fetch_add(F.ctl + CW_Q, 8u, RLX_AGENT);
        const int q = base + F.wave;
        if (q < Q_L0GU) conv_gu_item(F, A, 0, q, scr);
        else if (q < Q_L0DN) conv_dn_item(F, A, 0, q - Q_L0GU, scr);
        else if (q < Q_L1GU) conv_gu_item(F, A, 1, q - Q_L0DN, scr);
        else if (q < QN) conv_dn_item(F, A, 1, q - Q_L1GU, scr);
        if (F.tid == 0) qb[0] = (int)nx;
        __syncthreads();
        base = qb[0];
        __syncthreads();
    }
}
__device__ __forceinline__ void ph_prep(Frame& F, const Args& A) {
    LAS float* scr = (LAS float*)(F.lds + RING_OFF + F.wave * 16640);
    const int gw = F.vcu * NWAVES + F.wave, NGW = F.G * NWAVES;
    constexpr int PER_S = I_IN + I_OUT + I_GLU;
    for (int it = gw; it < DEPTH * PER_S; it += NGW) {
        const int l = it / PER_S; int r = it - l * PER_S;
        unsigned char* wb = F.ws + WS_W + (size_t)l * W_STRIDE;
        if (r < I_IN) { const int kb = r / 24, nb = r % 24; tr_item(A.in[I_WIN] + (size_t)l * D * NPROJ, D, NPROJ, (bf16*)(wb + W_IN), 64 * kb, 64 * nb, 64 * nb, A.in[I_ANW] + l * D, scr, F.lane); continue; } r -= I_IN;
        if (r < I_OUT) { const int kb = r / 16, nb = r % 16; const float* sc = (kb < 8) ? A.in[I_ONA] + l * DH : A.in[I_ONB] + l * DH - DH;
            tr_item(A.in[I_WOUT] + (size_t)l * D * D, D, D, (bf16*)(wb + W_OUT), 64 * kb, 64 * nb, 64 * nb, sc, scr, F.lane); continue; } r -= I_OUT;
        { const int kb = r / 8, nb = r % 8; tr_item(A.in[I_GLUW] + (size_t)l * DH * DH, DH, DH, (bf16*)(wb + W_GLU), 64 * kb, 64 * nb, 64 * nb, nullptr, scr, F.lane); }
    }
    for (int m = gw; m < M; m += NGW) rms_row_to_bf16(A.in[I_X] + (size_t)m * D, (bf16*)(F.ws + WS_XB) + (size_t)m * D, (float*)(F.ws + WS_RSI) + m, F.lane);
    for (int i = (F.vcu * NWAVES + F.wave) * 64 + F.lane; i < DEPTH * NG * NP; i += F.G * NWAVES * 64) {
        const int l = i / (NG * NP), gp = i % (NG * NP), g = gp / NP, p = gp % NP;
        unsigned char* sp = F.ws + WS_SSMP + (size_t)l * SSMP_STRIDE;
        const float dt = expf(A.in[I_LOGDT][l * NG + g]), ar = A.in[I_ARE][i], ai = A.in[I_AIM][i];
        const float ex = expf(dt * ar); float sn, cs; sincosf(dt * ai, &sn, &cs);
        const float abr = ex * cs, abi = ex * sn;
        const float nr = abr - 1.0f, ni = abi, den = ar * ar + ai * ai, cr = (nr * ar + ni * ai) / den, ci = (ni * ar - nr * ai) / den;
        ((float*)(sp + SSMP_ABAR))[gp * 2] = abr; ((float*)(sp + SSMP_ABAR))[gp * 2 + 1] = abi;
        float pr = abr, pi = abi;
#pragma unroll
        for (int k = 0; k < 7; ++k) { const float t = pr * pr - pi * pi; pi = 2.0f * pr * pi; pr = t; }
        ((float*)(sp + SSMP_A128))[gp * 2] = pr; ((float*)(sp + SSMP_A128))[gp * 2 + 1] = pi;
        float* bb = (float*)(sp + SSMP_BBAR) + (size_t)gp * 32;
        const float* bre = A.in[I_BRE] + (size_t)i * 16; const float* bim = A.in[I_BIM] + (size_t)i * 16;
#pragma unroll
        for (int h = 0; h < 16; ++h) { const float br = bre[h], bi = bim[h]; bb[h] = cr * br - ci * bi; bb[16 + h] = cr * bi + ci * br; }
        float* ct = (float*)(sp + SSMP_CTAB) + (size_t)g * 128 * 16;
        const float* cre = A.in[I_CRE] + (size_t)(l * NG + g) * 16 * NP; const float* cim = A.in[I_CIM] + (size_t)(l * NG + g) * 16 * NP;
#pragma unroll
        for (int h = 0; h < 16; ++h) { ct[p * 16 + h] = cre[h * NP + p]; ct[(64 + p) * 16 + h] = -cim[h * NP + p]; }
        bf16* bb16 = (bf16*)(F.ws + WS_BB16) + (size_t)(l * NG + g) * 2048; bf16* ct16 = (bf16*)(F.ws + WS_CT16) + (size_t)(l * NG + g) * 2048;
        const int kp = (p < 32) ? 2 * p : 2 * (p - 32) + 1;
#pragma unroll
        for (int h = 0; h < 16; ++h) { bb16[((p >> 5) * 32 + (p & 31)) * 16 + h] = (bf16)f2bf(bb[h]); bb16[((2 + (p >> 5)) * 32 + (p & 31)) * 16 + h] = (bf16)f2bf(bb[16 + h]);
            ct16[h * 128 + kp] = (bf16)f2bf(cre[h * NP + p]); ct16[h * 128 + 64 + kp] = (bf16)f2bf(-cim[h * NP + p]); }
    }
    for (int i = (F.vcu * NWAVES + F.wave) * 64 + F.lane; i < DEPTH * D * NE; i += F.G * NWAVES * 64) { const int l = i / (D * NE), k = (i / NE) % D, e = i % NE;
        const float w = A.in[I_RW][i] * A.in[I_FNW][l * D + k]; const unsigned hi = f2bf(w); const float lo = w - __builtin_bit_cast(float, hi << 16);
        bf16* t = (bf16*)(F.ws + WS_RWT) + (size_t)l * 2 * NE * D; t[e * D + k] = (bf16)hi; t[(NE + e) * D + k] = (bf16)f2bf(lo); }
    for (int i = (F.vcu * NWAVES + F.wave) * 64 + F.lane; i < DEPTH * 4 * 128 * 128; i += F.G * NWAVES * 64) { const int t = (i >> 7) & 127, sx = i & 127;
        ((bf16*)(F.ws + WS_WM))[i] = (sx <= t) ? (bf16)f2bf(A.in[I_SGUW][i]) : (bf16)0; }
}

typedef short v4i16_t __attribute__((ext_vector_type(4)));
__device__ __forceinline__ void sgu_chunk_mfma(Frame& F, const Args& A, int l, int c) {
    const bf16* UG = (const bf16*)(F.ws + WS_P); const bf16* VG = UG + (size_t)M * DH;
    bf16* MIX = (bf16*)(F.ws + WS_MIX);
    const bf16* Wm = (const bf16*)(F.ws + WS_WM) + (size_t)l * 4 * 128 * 128;
    constexpr int PITCH = 1056;
    LAS unsigned char* vn = F.lds + RING_OFF;
    const float* lnw = A.in[I_LNW] + l * DH; const float* lnb = A.in[I_LNB] + l * DH;
    {
        const f32x4 w0 = *(const GAS f32x4*)(lnw + 8 * F.lane), w1 = *(const GAS f32x4*)(lnw + 8 * F.lane + 4), b0 = *(const GAS f32x4*)(lnb + 8 * F.lane), b1 = *(const GAS f32x4*)(lnb + 8 * F.lane + 4);
        const float ww[8] = {w0.x, w0.y, w0.z, w0.w, w1.x, w1.y, w1.z, w1.w}, bb[8] = {b0.x, b0.y, b0.z, b0.w, b1.x, b1.y, b1.z, b1.w};
#pragma unroll 4
        for (int r = F.wave * 16; r < F.wave * 16 + 16; ++r) {
            const v4u w = *(const GAS v4u*)(VG + (size_t)(c * 128 + r) * DH + 8 * F.lane);
            float v[8] = {bflo(w.x), bfhi(w.x), bflo(w.y), bfhi(w.y), bflo(w.z), bfhi(w.z), bflo(w.w), bfhi(w.w)};
            float s = 0.f, s2 = 0.f;
#pragma unroll
            for (int j = 0; j < 8; ++j) { s += v[j]; s2 += v[j] * v[j]; }
            s = wave_sum(s); s2 = wave_sum(s2);
            const float mean = s * (1.f / DH), var = fmaxf(s2 * (1.f / DH) - mean * mean, 0.f), rstd = 1.0f / sqrtf(var + EPS);
            float o[8];
#pragma unroll
            for (int j = 0; j < 8; ++j) o[j] = (v[j] - mean) * rstd * ww[j] + bb[j];
            v4u ow; ow.x = pk2(o[0], o[1]); ow.y = pk2(o[2], o[3]); ow.z = pk2(o[4], o[5]); ow.w = pk2(o[6], o[7]);
            *(LAS v4u*)(vn + r * PITCH + 16 * F.lane) = ow;
        }
    }
    __syncthreads();
    const int w = F.wave, fr = F.lane & 15, G = F.lane >> 4, rr = (F.lane >> 2) & 3, cc = F.lane & 3;
    const int nks = (w >> 1) + 1;
    const int trow = c * 128 + w * 16 + fr;
    LAS unsigned char* trb = vn + (4 * G + rr) * PITCH + 8 * cc;
    pg8::f32x4 acc[4][8];
#pragma unroll
    for (int h = 0; h < 4; ++h)
#pragma unroll
        for (int dt = 0; dt < 8; ++dt) acc[h][dt] = (pg8::f32x4){0.f, 0.f, 0.f, 0.f};
    for (int ks = 0; ks < nks; ++ks) {
#pragma unroll
        for (int h = 0; h < 4; ++h) {
            const bf16* wp = Wm + ((size_t)h * 128 + w * 16 + fr) * 128 + ks * 32 + 4 * G;
            const v2u wlo = *(const GAS v2u*)wp, whi = *(const GAS v2u*)(wp + 16);
            const v4u wf4 = (v4u){wlo.x, wlo.y, whi.x, whi.y};
            const bf16x8 wf = __builtin_bit_cast(bf16x8, wf4);
#pragma unroll
            for (int dt = 0; dt < 8; ++dt) {
                const LAS unsigned char* pa = trb + ks * 32 * PITCH + (h * 128 + dt * 16) * 2;
                const v4i16_t a0 = __builtin_amdgcn_ds_read_tr16_b64_v4i16((LAS v4i16_t*)pa), a1 = __builtin_amdgcn_ds_read_tr16_b64_v4i16((LAS v4i16_t*)(pa + 16 * PITCH));
                const bf16x8 af = (bf16x8){a0[0], a0[1], a0[2], a0[3], a1[0], a1[1], a1[2], a1[3]};
                acc[h][dt] = __builtin_amdgcn_mfma_f32_16x16x32_bf16(af, wf, acc[h][dt], 0, 0, 0);
            }
        }
    }
    float ss = 0.f;
#pragma unroll
    for (int h = 0; h < 4; ++h) { const float bt = A.in[I_SGUB][(size_t)(l * 4 + h) * 128 + w * 16 + fr];
#pragma unroll
        for (int dt = 0; dt < 8; ++dt) { const v2u uw = *(const GAS v2u*)(UG + (size_t)trow * DH + h * 128 + dt * 16 + 4 * G);
            pg8::f32x4 y = acc[h][dt] + bt; y[0] *= bflo(uw.x); y[1] *= bfhi(uw.x); y[2] *= bflo(uw.y); y[3] *= bfhi(uw.y);
            acc[h][dt] = y; ss += (y[0] * y[0] + y[1] * y[1]) + (y[2] * y[2] + y[3] * y[3]); } }
    ss += __shfl_xor(ss, 16); ss += __shfl_xor(ss, 32);
    const float rs = 1.0f / sqrtf(ss * (1.f / DH) + EPS);
#pragma unroll
    for (int h = 0; h < 4; ++h)
#pragma unroll
        for (int dt = 0; dt < 8; ++dt) { const pg8::f32x4 y = acc[h][dt] * rs; v2u o; o.x = pk2(y[0], y[1]); o.y = pk2(y[2], y[3]);
            *(GAS v2u*)(MIX + (size_t)trow * D + h * 128 + dt * 16 + 4 * G) = o; }
    __syncthreads();
}

typedef float f32x16 __attribute__((ext_vector_type(16)));
template <bool FULL>
__device__ __forceinline__ void ssm_item(Frame& F, const Args& A, int l, int g, int bp, int ch, float* xcarry = nullptr, bool cont = false) {
    const unsigned char* sp = F.ws + WS_SSMP + (size_t)l * SSMP_STRIDE;
    const bf16* US = (const bf16*)(F.ws + WS_P) + (size_t)2 * M * DH;
    const int lane = F.lane, H = lane >> 5, s = lane & 31;
    const float* abp = (const float*)(sp + SSMP_ABAR) + (size_t)g * NP * 2;
    const float a0r = abp[s * 2], a0i = abp[s * 2 + 1], a1r = abp[(32 + s) * 2], a1i = abp[(32 + s) * 2 + 1];
    bf16x8 bq[4];
    { const bf16* bb16 = (const bf16*)(F.ws + WS_BB16) + (size_t)(l * NG + g) * 2048;
#pragma unroll
      for (int q = 0; q < 4; ++q) bq[q] = *(const GAS bf16x8*)(bb16 + (q * 32 + s) * 16 + 8 * H); }
    float x0r = 0.f, x0i = 0.f, x1r = 0.f, x1i = 0.f;
    const int b = 2 * bp + H;
    if (FULL && cont) { x0r = xcarry[0]; x0i = xcarry[1]; x1r = xcarry[2]; x1i = xcarry[3]; }
    if (FULL && !cont) {
        const float* a8p = (const float*)(sp + SSMP_A128) + (size_t)g * NP * 2;
        const float c0r = a8p[s * 2], c0i = a8p[s * 2 + 1], c1r = a8p[(32 + s) * 2], c1i = a8p[(32 + s) * 2 + 1];
        const float* est = (const float*)(F.ws + WS_EST) + (((size_t)b * NG + g) * NCH * NP) * 2;
        for (int cb = 0; cb < ch; cb += 8) {
            f32x2_t ea[8], eb[8];
#pragma unroll
            for (int k = 0; k < 8; ++k) { const int cc = (cb + k < ch) ? cb + k : ch - 1; ea[k] = *(const GAS f32x2_t*)(est + ((size_t)cc * NP + s) * 2); eb[k] = *(const GAS f32x2_t*)(est + ((size_t)cc * NP + 32 + s) * 2); }
#pragma unroll
            for (int k = 0; k < 8; ++k) if (cb + k < ch) {
                float nr = c0r * x0r - c0i * x0i + ea[k].x, ni = c0r * x0i + c0i * x0r + ea[k].y; x0r = nr; x0i = ni;
                nr = c1r * x1r - c1i * x1i + eb[k].x; ni = c1r * x1i + c1i * x1r + eb[k].y; x1r = nr; x1i = ni; } }
    }
    const int ai = lane & 31;
    const bf16* ap = US + ((size_t)(2 * bp + ((ai >> 2) & 1)) * SEQ + ch * 128 + (ai & 3) + 4 * (ai >> 3)) * DH + g * 16 + 8 * H;
    constexpr int XP = 272;
    LAS unsigned char* xt = F.lds + RING_OFF + F.wave * (32 * XP);
    bf16x8 cq[4]; f32x4 dv = (f32x4){0.f, 0.f, 0.f, 0.f};
    const int fr = lane & 15, G = lane >> 4;
    if (FULL) { const bf16* ct16 = (const bf16*)(F.ws + WS_CT16) + (size_t)(l * NG + g) * 2048;
#pragma unroll
        for (int q = 0; q < 4; ++q) cq[q] = *(const GAS bf16x8*)(ct16 + fr * 128 + q * 32 + 8 * G);
        dv = *(const GAS f32x4*)(A.in[I_SD] + l * DH + g * 16 + 4 * G); }
    bf16x8 af = *(const GAS bf16x8*)ap;
    for (int tb = 0; tb < 8; ++tb) {
        const bf16x8 afn = *(const GAS bf16x8*)(ap + (size_t)((tb < 7 ? tb + 1 : tb) * 16) * DH);
        v2u uwp[2] = {(v2u){0u, 0u}, (v2u){0u, 0u}};
        if (FULL) {
#pragma unroll
            for (int hb = 0; hb < 2; ++hb) uwp[hb] = *(const GAS v2u*)(US + ((size_t)(2 * bp + hb) * SEQ + ch * 128 + tb * 16 + fr) * DH + g * 16 + 4 * G); }
        f32x16 z;
#pragma unroll
        for (int i = 0; i < 16; ++i) z[i] = 0.f;
        f32x16 r0 = __builtin_amdgcn_mfma_f32_32x32x16_bf16(af, bq[0], z, 0, 0, 0);
        f32x16 r1 = __builtin_amdgcn_mfma_f32_32x32x16_bf16(af, bq[1], z, 0, 0, 0);
        f32x16 i0 = __builtin_amdgcn_mfma_f32_32x32x16_bf16(af, bq[2], z, 0, 0, 0);
        f32x16 i1 = __builtin_amdgcn_mfma_f32_32x32x16_bf16(af, bq[3], z, 0, 0, 0);
#pragma unroll
        for (int t = 0; t < 16; ++t) {
            float nr = a0r * x0r - a0i * x0i + r0[t], ni = a0r * x0i + a0i * x0r + i0[t]; x0r = nr; x0i = ni;
            nr = a1r * x1r - a1i * x1i + r1[t]; ni = a1r * x1i + a1i * x1r + i1[t]; x1r = nr; x1i = ni;
            if (FULL) { LAS unsigned* xr = (LAS unsigned*)(xt + (H * 16 + t) * XP) + s;
                unsigned p0 = pg8::cvt_pk_bf16_raw(x0r, x1r), p1 = pg8::cvt_pk_bf16_raw(x0i, x1i);
                asm volatile("s_nop 1" : "+v"(p0), "+v"(p1));
                xr[0] = p0; xr[32] = p1;
                asm volatile("s_nop 1" :: "v"(p0), "v"(p1) : "memory"); }
        }
        if (FULL) {
            LDS_WAIT(); asm volatile("" ::: "memory");
#pragma unroll
            for (int hb = 0; hb < 2; ++hb) {
                pg8::f32x4 y = (pg8::f32x4){0.f, 0.f, 0.f, 0.f};
#pragma unroll
                for (int q = 0; q < 4; ++q) { const bf16x8 xf = *(const LAS bf16x8*)(xt + (hb * 16 + fr) * XP + q * 64 + 16 * G); y = __builtin_amdgcn_mfma_f32_16x16x32_bf16(cq[q], xf, y, 0, 0, 0); }
                const size_t row = (size_t)(2 * bp + hb) * SEQ + ch * 128 + tb * 16 + fr;
                const v2u uw = uwp[hb];
                y[0] += dv.x * bflo(uw.x); y[1] += dv.y * bfhi(uw.x); y[2] += dv.z * bflo(uw.y); y[3] += dv.w * bfhi(uw.y);
                v2u o; o.x = pk2(gelu_tanh(y[0]), gelu_tanh(y[1])); o.y = pk2(gelu_tanh(y[2]), gelu_tanh(y[3]));
                *(GAS v2u*)((bf16*)(F.ws + WS_YG) + row * DH + g * 16 + 4 * G) = o;
            }
            LDS_WAIT(); asm volatile("" ::: "memory");
        }
        af = afn;
    }
    if (FULL && xcarry) { xcarry[0] = x0r; xcarry[1] = x0i; xcarry[2] = x1r; xcarry[3] = x1i; }
    if (!FULL) { float* est = (float*)(F.ws + WS_EST) + ((((size_t)b * NG + g) * NCH + ch) * NP) * 2;
        *(GAS f32x2_t*)(est + s * 2) = (f32x2_t){x0r, x0i}; *(GAS f32x2_t*)(est + (32 + s) * 2) = (f32x2_t){x1r, x1i}; }
}

__device__ __forceinline__ void ph_normb(Frame& F, const Args& A, int l) {
    bf16* MIX = (bf16*)(F.ws + WS_MIX);
    const float* ssp = (const float*)(F.ws + WS_SSP);
    const int gw = F.vcu * NWAVES + F.wave, NGW = F.G * NWAVES;
    for (int mb = gw; mb < M; mb += 8 * NGW) {
        f32x4 p0[8], p1[8]; v4u w[8];
#pragma unroll
        for (int j = 0; j < 8; ++j) { const int m = mb + j * NGW; if (m < M) { p0[j] = *(const GAS f32x4*)(ssp + (size_t)m * 8); p1[j] = *(const GAS f32x4*)(ssp + (size_t)m * 8 + 4); w[j] = *(const GAS v4u*)(MIX + (size_t)m * D + DH + 8 * F.lane); } }
#pragma unroll
        for (int j = 0; j < 8; ++j) { const int m = mb + j * NGW; if (m < M) {
            const float s = 1.0f / sqrtf((((p0[j].x + p0[j].y) + (p0[j].z + p0[j].w)) + ((p1[j].x + p1[j].y) + (p1[j].z + p1[j].w))) * (1.f / DH) + EPS);
            v4u o; o.x = pk2(bflo(w[j].x) * s, bfhi(w[j].x) * s); o.y = pk2(bflo(w[j].y) * s, bfhi(w[j].y) * s); o.z = pk2(bflo(w[j].z) * s, bfhi(w[j].z) * s); o.w = pk2(bflo(w[j].w) * s, bfhi(w[j].w) * s);
            *(GAS v4u*)(MIX + (size_t)m * D + DH + 8 * F.lane) = o; } }
    }
}

__device__ __forceinline__ void ph_route_mfma(Frame& F, const Args& A, int l, int cbank) {
    const bf16* XA = (const bf16*)(F.ws + WS_XA); float* RSE = (float*)(F.ws + WS_H2);
    int* RE = (int*)(F.ws + WS_RE); int* RK = (int*)(F.ws + WS_RK); float* GW = (float*)(F.ws + WS_GW);
    gu32* cnt = F.ctl + CW_CNT + cbank * NE;
    constexpr int WP = 2064, PL_OFF = 64 * WP, SSQ_OFF = PL_OFF + 2 * 64 * 32 * 4;
    static_assert(SSQ_OFF + 512 + 2048 <= LDSCTL_OFF, "route LDS map");
    LAS unsigned char* wt = F.lds + RING_OFF;
    LAS float* PL = (LAS float*)(F.lds + PL_OFF); LAS float* SSQ = (LAS float*)(F.lds + SSQ_OFF);
    LAS int* lcnt = (LAS int*)(F.lds + LDSCTL_OFF); LAS int* lbase = lcnt + 32;
    LAS int* as_e = (LAS int*)(F.lds + LDSCTL_OFF + 1024); LAS int* as_lr = as_e + 256; LAS float* as_g = (LAS float*)(as_lr + 256);
    LAS float* as_rs = (LAS float*)(F.lds + LDSCTL_OFF + 4096);
    const float* rb = A.in[I_RB] + l * NE;
    { const bf16* src = (const bf16*)(F.ws + WS_RWT) + (size_t)l * 2 * NE * D;
      v4u wv[16];
#pragma unroll
      for (int q = 0; q < 16; ++q) { const int i = F.tid + q * (NWAVES * 64), row = i >> 7, ch = i & 127; wv[q] = *(const GAS v4u*)(src + (size_t)row * D + ch * 8); }
#pragma unroll
      for (int q = 0; q < 16; ++q) { const int i = F.tid + q * (NWAVES * 64), row = i >> 7, ch = i & 127; *(LAS v4u*)(wt + row * WP + ch * 16) = wv[q]; } }
    const int fr = F.lane & 15, G = F.lane >> 4, rg = F.wave & 3;
    for (int blk = F.vcu; blk < M / 64; blk += F.G) {
        if (F.tid < 32) lcnt[F.tid] = 0;
        __syncthreads();
        if (F.wave < 4) {
            v4u xall[2][16];
#pragma unroll
            for (int kh = 0; kh < 2; ++kh) { const bf16* xp = XA + (size_t)(blk * 64 + rg * 16 + fr) * D + kh * 512 + 8 * G;
#pragma unroll
                for (int ks = 0; ks < 16; ++ks) xall[kh][ks] = *(const GAS v4u*)(xp + ks * 32); }
#pragma unroll
            for (int kh = 0; kh < 2; ++kh) {
                pg8::f32x4 a0 = (pg8::f32x4){0.f, 0.f, 0.f, 0.f}, a1 = a0; float ssq = 0.f;
                const LAS unsigned char* wp = wt + fr * WP + (kh * 512 + 8 * G) * 2;
#pragma unroll
                for (int ks = 0; ks < 16; ++ks) {
                    const v4u xw = xall[kh][ks]; const bf16x8 xb = __builtin_bit_cast(bf16x8, xw);
                    { const float x0 = bflo(xw.x), x1 = bfhi(xw.x), x2 = bflo(xw.y), x3 = bfhi(xw.y), x4 = bflo(xw.z), x5 = bfhi(xw.z), x6 = bflo(xw.w), x7 = bfhi(xw.w);
                      ssq += ((x0 * x0 + x1 * x1) + (x2 * x2 + x3 * x3)) + ((x4 * x4 + x5 * x5) + (x6 * x6 + x7 * x7)); }
                    const bf16x8 w0h = *(const LAS bf16x8*)(wp + ks * 64), w1h = *(const LAS bf16x8*)(wp + 16 * WP + ks * 64);
                    const bf16x8 w0l = *(const LAS bf16x8*)(wp + 32 * WP + ks * 64), w1l = *(const LAS bf16x8*)(wp + 48 * WP + ks * 64);
                    a0 = __builtin_amdgcn_mfma_f32_16x16x32_bf16(w0h, xb, a0, 0, 0, 0); a1 = __builtin_amdgcn_mfma_f32_16x16x32_bf16(w1h, xb, a1, 0, 0, 0);
                    a0 = __builtin_amdgcn_mfma_f32_16x16x32_bf16(w0l, xb, a0, 0, 0, 0); a1 = __builtin_amdgcn_mfma_f32_16x16x32_bf16(w1l, xb, a1, 0, 0, 0);
                }
                ssq += __shfl_xor(ssq, 16); ssq += __shfl_xor(ssq, 32);
                LAS float* pl = PL + ((kh * 64 + rg * 16 + fr) * 32);
                *(LAS pg8::f32x4*)(pl + 4 * G) = a0; *(LAS pg8::f32x4*)(pl + 16 + 4 * G) = a1;
                if (G == 0) SSQ[kh * 64 + rg * 16 + fr] = ssq;
            }
        }
        __syncthreads();
#pragma unroll 1
        for (int rr = 0; rr < 8; rr += 2) {
            const int L = F.lane, e = L >> 1;
            int lr[2]; float rs[2], val[2], mx[2], ex[2], den[2]; int rank[2]; bool win[2];
#pragma unroll
            for (int u = 0; u < 2; ++u) lr[u] = F.wave * 8 + rr + u;
#pragma unroll
            for (int u = 0; u < 2; ++u) { rs[u] = 1.0f / sqrtf((SSQ[lr[u]] + SSQ[64 + lr[u]]) * (1.f / D) + EPS);
                val[u] = (PL[lr[u] * 32 + e] + PL[(64 + lr[u]) * 32 + e]) * rs[u] + rb[e];
                LAS float* lrow = (LAS float*)(F.lds + SSQ_OFF + 512) + (F.wave * 2 + u) * 32;
                if ((L & 1) == 0) lrow[e] = val[u]; }
            LDS_WAIT(); asm volatile("" ::: "memory");
#pragma unroll
            for (int u = 0; u < 2; ++u) { const LAS float* lrow = (const LAS float*)(F.lds + SSQ_OFF + 512) + (F.wave * 2 + u) * 32; const float v = val[u]; int rk = 0;
#pragma unroll
                for (int q = 0; q < 8; ++q) { const f32x4 o = *(const LAS f32x4*)(lrow + 4 * q);
                    rk += (o.x > v || (o.x == v && 4 * q + 0 < e)) ? 1 : 0; rk += (o.y > v || (o.y == v && 4 * q + 1 < e)) ? 1 : 0;
                    rk += (o.z > v || (o.z == v && 4 * q + 2 < e)) ? 1 : 0; rk += (o.w > v || (o.w == v && 4 * q + 3 < e)) ? 1 : 0; }
                rank[u] = rk; mx[u] = v; }
            asm volatile("" ::: "memory");
#pragma unroll
            for (int o = 2; o < 64; o <<= 1) { mx[0] = fmaxf(mx[0], __shfl_xor(mx[0], o)); mx[1] = fmaxf(mx[1], __shfl_xor(mx[1], o)); }
#pragma unroll
            for (int u = 0; u < 2; ++u) { win[u] = (rank[u] < 4) && ((L & 1) == 0); ex[u] = win[u] ? __expf(val[u] - mx[u]) : 0.f; den[u] = ex[u]; }
#pragma unroll
            for (int o = 1; o < 64; o <<= 1) { den[0] += __shfl_xor(den[0], o); den[1] += __shfl_xor(den[1], o); }
#pragma unroll
            for (int u = 0; u < 2; ++u) {
                if (L == 0) as_rs[lr[u]] = rs[u];
                if (win[u]) { const int slr = __hip_atomic_fetch_add(lcnt + e, 1, __ATOMIC_RELAXED, __HIP_MEMORY_SCOPE_WORKGROUP);
                    const int ix = lr[u] * 4 + rank[u]; as_e[ix] = e; as_lr[ix] = slr; as_g[ix] = ex[u] / den[u]; } }
            LDS_WAIT(); asm volatile("" ::: "memory");
        }
        __syncthreads();
        if (F.tid < 32) lbase[F.tid] = (int)__hip_atomic_fetch_add(cnt + F.tid, (unsigned)lcnt[F.tid], RLX_AGENT);
        __syncthreads();
        if (F.tid < 256) { const int a = blk * 256 + F.tid, e = as_e[F.tid], rk = lbase[e] + as_lr[F.tid]; RE[a] = e; RK[a] = rk; GW[a] = as_g[F.tid]; ((int*)(F.ws + WS_XS))[e * NAS + rk] = a >> 2; RSE[e * NAS + rk] = as_rs[F.tid >> 2]; }
        __syncthreads();
    }
}

__device__ __forceinline__ int moe_tables(Frame& F, int l, int NT, int GS, bool build, bool fresh = true) {
    gu32* cnt = F.ctl + CW_CNT + l * NE;
    LAS int* offL = (LAS int*)(F.lds + TAB_OFF); LAS int* cntL = offL + 64; LAS unsigned* tab = (LAS unsigned*)(F.lds + TAB_OFF + 1024);
    if (fresh) {
    if (F.tid < NE) cntL[F.tid] = (int)__hip_atomic_load(cnt + F.tid, RLX_AGENT);
    __syncthreads();
    if (F.tid == 0) { int o = 0; for (int e = 0; e < NE; ++e) { offL[e] = o; o += (cntL[e] + 255) & ~255; } offL[NE] = o; }
    __syncthreads();
    }
    if (build && F.tid < NE) { const int e = F.tid, t0 = offL[e] >> 8, mt = (offL[e + 1] - offL[e]) >> 8;
        int idx = t0 * NT;
        for (int pg = 0; pg * GS < mt; ++pg) { const int gs = (mt - pg * GS) < GS ? (mt - pg * GS) : GS;
            for (int pn = 0; pn < NT; ++pn) for (int pi = 0; pi < gs; ++pi) { tab[idx] = (unsigned)(t0 + pg * GS + pi) | ((unsigned)(e * NT + pn) << 12); ++idx; } } }
    __syncthreads();
    return (offL[NE] >> 8) * NT;
}

__device__ __forceinline__ void ph_combine(Frame& F, const Args& A, int l) {
    const bf16* XA = (const bf16*)(F.ws + WS_XA); bf16* XC = (bf16*)(F.ws + WS_XC); float* RSI = (float*)(F.ws + WS_RSI) + M;
    const bf16* YB = (const bf16*)(F.ws + WS_YB); const int* RE = (const int*)(F.ws + WS_RE); const int* RK = (const int*)(F.ws + WS_RK); const float* GW = (const float*)(F.ws + WS_GW);
    (void)moe_tables(F, l, 4, 8, false, false);
    const LAS int* offL = (const LAS int*)(F.lds + TAB_OFF);
    const int gw = F.vcu * NWAVES + F.wave, NGW = F.G * NWAVES;
    const bool last = (l == DEPTH - 1);
    for (int jb = 0; gw + jb * NGW < M; jb += 16) {
        int slot_l = 0; float g_l = 0.f;
        { const int ml = gw + (jb + (F.lane >> 2)) * NGW;
          if (ml < M) { const int a = ml * 4 + (F.lane & 3); slot_l = offL[__hip_atomic_load(RE + a, RLX_AGENT)] + __hip_atomic_load(RK + a, RLX_AGENT); g_l = __hip_atomic_load(GW + a, RLX_AGENT); } }
        v2u xa[4], ya[4][4], xb[4], yb[4][4];
#define COMB_LOAD(X, Y, J) do { const int m_ = gw + (jb + (J)) * NGW; const GAS v2u* xr_ = (const GAS v2u*)(XA + (size_t)m_ * D) + F.lane; \
            _Pragma("unroll") for (int q = 0; q < 4; ++q) (X)[q] = xr_[64 * q]; \
            _Pragma("unroll") for (int k = 0; k < 4; ++k) { const int slot_ = __builtin_amdgcn_readlane(slot_l, 4 * (J) + k); const GAS v2u* yp_ = (const GAS v2u*)(YB + (size_t)slot_ * D) + F.lane; \
                _Pragma("unroll") for (int q = 0; q < 4; ++q) (Y)[k][q] = yp_[64 * q]; } } while (0)
        COMB_LOAD(xa, ya, 0);
#pragma unroll 1
        for (int jj = 0; jj < 16; ++jj) {
            const int m = gw + (jb + jj) * NGW;
            if (m >= M) break;
            const bool more = (jj < 15) && (m + NGW < M);
            if (more) COMB_LOAD(xb, yb, jj + 1);
            f32x4 v[4];
#pragma unroll
            for (int q = 0; q < 4; ++q) v[q] = (f32x4){bflo(xa[q].x), bfhi(xa[q].x), bflo(xa[q].y), bfhi(xa[q].y)};
#pragma unroll
            for (int k = 0; k < 4; ++k) { const float g = __builtin_bit_cast(float, __builtin_amdgcn_readlane(__builtin_bit_cast(int, g_l), 4 * jj + k));
#pragma unroll
                for (int q = 0; q < 4; ++q) { const v2u w = ya[k][q]; v[q].x += g * bflo(w.x); v[q].y += g * bfhi(w.x); v[q].z += g * bflo(w.y); v[q].w += g * bfhi(w.y); } }
            float sq = 0.f;
#pragma unroll
            for (int q = 0; q < 4; ++q) sq += (v[q].x * v[q].x + v[q].y * v[q].y) + (v[q].z * v[q].z + v[q].w * v[q].w);
            const float rs = 1.0f / sqrtf(wave_sum(sq) * (1.f / D) + EPS);
            if (!last) {
                GAS unsigned long long* o8 = (GAS unsigned long long*)(XC + (size_t)m * D) + F.lane;
#pragma unroll
                for (int q = 0; q < 4; ++q) o8[64 * q] = (unsigned long long)pk2(v[q].x, v[q].y) | ((unsigned long long)pk2(v[q].z, v[q].w) << 32);
                if (F.lane == 0) RSI[m] = rs;
            } else {
                GAS f32x4* oo = (GAS f32x4*)(A.out + (size_t)m * D) + F.lane; const GAS f32x4* fw = (const GAS f32x4*)A.in[I_FINW] + F.lane;
#pragma unroll
                for (int q = 0; q < 4; ++q) { const f32x4 w = fw[64 * q]; oo[64 * q] = v[q] * rs * w; }
            }
            if (more) {
#pragma unroll
                for (int q = 0; q < 4; ++q) { xa[q] = xb[q];
#pragma unroll
                    for (int k = 0; k < 4; ++k) ya[k][q] = yb[k][q]; } }
        }
#undef COMB_LOAD
    }
}
template <class Epi, class Sched>
__device__ __forceinline__ void run_gemm(Frame& F, const pg8::Gemm& g, const Sched& S, const Epi& E) {
    pg8::gemm_phase<Epi, Sched, true>(F.lds + RING_OFF, g, S, E);
}
__global__ void __launch_bounds__(NWAVES * 64, 2) mk_fwd(Args args) {
    extern __shared__ __attribute__((aligned(16))) unsigned char lds[];
    Frame F;
    F.lds = (LAS unsigned char*)lds;
    F.MISC = (volatile LAS unsigned*)(F.lds + MISC_OFF);
    F.tid = threadIdx.x; F.lane = F.tid & 63; F.wave = __builtin_amdgcn_readfirstlane(F.tid >> 6);
    F.G = gridDim.x; { const int bx = blockIdx.x; F.vcu = (F.G % 8 == 0) ? (bx % 8) * (F.G / 8) + bx / 8 : bx; }
    F.ws = args.ws; F.ctl = (gu32*)(args.ws + WS_CTL);
    for (int u = F.tid; u < (LDS_BYTES - LDSCTL_OFF) / 4; u += NWAVES * 64) ((LAS unsigned*)(F.lds + LDSCTL_OFF))[u] = 0u;
    __syncthreads();
#if N_LAUNCH_MODE == 1
    XcdBarrier bar = xcd_barrier_post((unsigned*)(F.ctl + CW_BAR), F.MISC + 8);
#define GRID_BAR() xcd_barrier(bar)
#else
#define GRID_BAR() do { } while (0)
#endif
    const int lo = args.ph_lo, hi = args.ph_hi;
#define IN(k) (lo <= (k) && (k) < hi)
#define SEAM(k) do { if (IN(k) && IN((k) + 1)) GRID_BAR(); } while (0)

#ifndef PH_MASK
#define PH_MASK 0xfff
#endif
#define PHX(k) (((PH_MASK) >> (k)) & 1)
#ifndef DUP_MASK
#define DUP_MASK 0
#endif
#define REPS(k) (1 + (((DUP_MASK) >> (k)) & 1))
    if (PHX(11) && IN(0)) { for (int rep = 0; rep < REPS(11); ++rep) { if (rep) GRID_BAR(); ph_prep(F, args); __syncthreads(); conv_pull(F, args, 1 << 20, QN); }     SEAM(0); }

#define LAUNDER() do { asm volatile("" : "+v"(F.tid)); F.lane = F.tid & 63; F.wave = __builtin_amdgcn_readfirstlane(F.tid >> 6); } while (0)
    for (int l = 0; l < DEPTH; ++l) {
        const int pb = 1 + l * PH_PER_LAYER;
        unsigned char* wb = F.ws + WS_W + (size_t)l * W_STRIDE;
        const bf16* xin = (l == 0) ? (const bf16*)(F.ws + WS_XB) : (const bf16*)(F.ws + WS_XC);
        if (PHX(0) && IN(pb + 0)) { for (int rep = 0; rep < REPS(0); ++rep) { if (rep) GRID_BAR();
            pg8::Gemm g{xin, (const bf16*)(wb + W_IN), M, NPROJ, D}; pg8::StaticOrder S; S.init(M, NPROJ, F.G, (int)blockIdx.x);
            EpiInProj E{(bf16*)(F.ws + WS_P), (const float*)(F.ws + WS_RSI) + (size_t)l * M};
            run_gemm(F, g, S, E);
            } SEAM(pb + 0);
        }
        if (PHX(1) && IN(pb + 1)) { for (int rep = 0; rep < REPS(1); ++rep) { if (rep) GRID_BAR(); LAUNDER();
            for (int bi = (int)blockIdx.x; bi < 256; bi += F.G) { const int wi = bi * 8 + F.wave; ssm_item<false>(F, args, l, wi >> 6, (wi >> 5) & 1, wi & 31); }
            } SEAM(pb + 1);
        }
        if (PHX(2) && IN(pb + 2)) { for (int rep = 0; rep < REPS(2); ++rep) { if (rep) GRID_BAR(); LAUNDER();
            for (int bi = (int)blockIdx.x; bi < 256; bi += F.G) { if (F.wave < 4) { float xs[4]; const int wi = bi * 8 + 2 * F.wave;
                ssm_item<true>(F, args, l, wi >> 6, (wi >> 5) & 1, wi & 31, xs, false); ssm_item<true>(F, args, l, wi >> 6, (wi >> 5) & 1, (wi & 31) + 1, xs, true); } }
            } SEAM(pb + 2);
        }
        if (PHX(3) && IN(pb + 3)) { for (int rep = 0; rep < REPS(3); ++rep) { if (rep) GRID_BAR();
            pg8::Gemm g{(const bf16*)(F.ws + WS_YG), (const bf16*)(wb + W_GLU), M, DH, DH}; pg8::StaticOrder S; S.init(M, DH, F.G, (int)blockIdx.x);
            EpiGlu E{(const bf16*)(F.ws + WS_YG), (bf16*)(F.ws + WS_MIX), args.in[I_GLUB] + l * DH, (float*)(F.ws + WS_SSP)};
            run_gemm(F, g, S, E);
            LAUNDER();
            if (F.G >= 256) { for (int c = (int)blockIdx.x - 128; c >= 0 && c < 128; c += F.G) sgu_chunk_mfma(F, args, l, c); }
            else { for (int c = (int)blockIdx.x; c < 128; c += F.G) sgu_chunk_mfma(F, args, l, c); }
            } SEAM(pb + 3);
        }
        if (PHX(4) && IN(pb + 4)) { for (int rep = 0; rep < REPS(4); ++rep) { if (rep) GRID_BAR(); LAUNDER(); ph_normb(F, args, l); } SEAM(pb + 4); }
        if (PHX(5) && IN(pb + 5)) { for (int rep = 0; rep < REPS(5); ++rep) { if (rep) GRID_BAR();
            pg8::Gemm g{(const bf16*)(F.ws + WS_MIX), (const bf16*)(wb + W_OUT), M, D, D}; pg8::StaticOrder S; S.init(M, D, F.G, (int)blockIdx.x);
            EpiResid E{xin, (bf16*)(F.ws + WS_XA)};
            run_gemm(F, g, S, E);
            } SEAM(pb + 5);
        }
        if (PHX(6) && IN(pb + 6)) { for (int rep = 0; rep < REPS(6); ++rep) { if (rep) GRID_BAR(); LAUNDER(); ph_route_mfma(F, args, l, (REPS(6) == 2 && rep == 0) ? 2 + l : l); } SEAM(pb + 6); }
        if (PHX(7) && IN(pb + 7)) { for (int rep = 0; rep < REPS(7); ++rep) { if (rep) GRID_BAR();
            const int n = moe_tables(F, l, 8, 4, true);
            pg8::Gemm g{(const bf16*)(F.ws + WS_XA), (const bf16*)(wb + W_GU), M, NE * 2048, D};
            LdsOrder<true> S{(const LAS unsigned*)(F.lds + TAB_OFF + 1024), n, F.G, (int)blockIdx.x, (const LAS int*)(F.lds + TAB_OFF), (const LAS int*)(F.lds + TAB_OFF) + 64, (const int*)(F.ws + WS_XS), (const LAS unsigned*)(F.lds + TAB_OFF + 10240)};
            EpiSwiglu E{(bf16*)(F.ws + WS_ACT), args.in[I_BGU] + (size_t)l * NE * 2048, (const float*)(F.ws + WS_H2), (const LAS int*)(F.lds + TAB_OFF), (const LAS int*)(F.lds + TAB_OFF) + 64};
            S.fill_rows((LAS unsigned*)(F.lds + TAB_OFF + 10240), F.tid); __syncthreads();
            run_gemm(F, g, S, E);
            } SEAM(pb + 7);
        }
        if (PHX(8) && IN(pb + 8)) { for (int rep = 0; rep < REPS(8); ++rep) { if (rep) GRID_BAR();
            const int n = moe_tables(F, l, 4, 8, true, REPS(8) == 2 || REPS(9) == 2);
            pg8::Gemm g{(const bf16*)(F.ws + WS_ACT), (const bf16*)(wb + W_DN), SLOTS, NE * D, D};
            LdsOrder<false> S{(const LAS unsigned*)(F.lds + TAB_OFF + 1024), n, F.G, (int)blockIdx.x, (const LAS int*)(F.lds + TAB_OFF), (const LAS int*)(F.lds + TAB_OFF) + 64, (const int*)(F.ws + WS_XS), (const LAS unsigned*)(F.lds + TAB_OFF + 10240)};
            EpiDown E{(bf16*)(F.ws + WS_YB), args.in[I_BDN] + (size_t)l * NE * D};
            run_gemm(F, g, S, E);
            } SEAM(pb + 8);
        }
        if (PHX(9) && IN(pb + 9)) { for (int rep = 0; rep < REPS(9); ++rep) { if (rep) GRID_BAR(); LAUNDER(); ph_combine(F, args, l); } SEAM(pb + 9); }
    }
#undef IN
#undef SEAM
}

extern "C" void kernel_launch(void* const* d_in, const int* in_sizes, int n_in, void* d_out, int out_size, void* d_ws, size_t ws_size, hipStream_t stream) {
    static int grid = 0;
    if (grid == 0) {
        if (n_in != 28 || in_sizes[0] != M * D || out_size != M * D || ws_size < WS_END) { fprintf(stderr, "kernel_launch: unexpected shapes (n_in %d, in0 %d, out %d, ws %zu < %zu); nothing launched\n", n_in, n_in > 0 ? in_sizes[0] : -1, out_size, ws_size, (size_t)WS_END); grid = -1; return; }
        int dev = 0, cus = 0, per_cu = 0;
        if (hipGetDevice(&dev) != hipSuccess || hipDeviceGetAttribute(&cus, hipDeviceAttributeMultiprocessorCount, dev) != hipSuccess) { grid = -1; return; }
        if (hipFuncSetAttribute((const void*)mk_fwd, hipFuncAttributeMaxDynamicSharedMemorySize, LDS_BYTES) != hipSuccess) { fprintf(stderr, "kernel_launch: hipFuncSetAttribute failed\n"); grid = -1; return; }
        if (hipOccupancyMaxActiveBlocksPerMultiprocessor(&per_cu, (const void*)mk_fwd, NWAVES * 64, LDS_BYTES) != hipSuccess || per_cu < 1) { fprintf(stderr, "kernel_launch: occupancy query reports %d workgroups per CU\n", per_cu); }
        (void)hipGetLastError();
        grid = cus;
        if (grid % 8 != 0 || grid < 8) { fprintf(stderr, "kernel_launch: %d CUs: unsupported\n", grid); grid = -1; return; }
    }
    if (grid < 0) return;
    if (hipMemsetAsync((char*)d_ws + WS_CTL, 0, CTL_ZERO_BYTES, stream) != hipSuccess) return;
    Args a{};
    for (int i = 0; i < 28; ++i) a.in[i] = (const float*)d_in[i];
    a.out = (float*)d_out; a.ws = (unsigned char*)d_ws;
#if N_LAUNCH_MODE == 1
    a.ph_lo = 0; a.ph_hi = N_PHASES;
    hipLaunchKernelGGL(mk_fwd, dim3(grid), dim3(NWAVES * 64), LDS_BYTES, stream, a);
#else
    for (int p = 0; p < N_PHASES; ++p) { a.ph_lo = p; a.ph_hi = p + 1; hipLaunchKernelGGL(mk_fwd, dim3(grid), dim3(NWAVES * 64), LDS_BYTES, stream, a); }
#endif
}
```
